# Optimizing an MI355X kernel written in HIP

```python
import math
import jax
import jax.numpy as jnp
from jax import lax
import numpy as np

D_MODEL = 1024
BATCH = 8
SEQ = 4096
DEPTH = 4

GRID_W = 64
CTX_LEN = 256
N_EVEN = (DEPTH + 1) // 2
N_ODD = DEPTH // 2
EPS = 1e-6
ROPE_BASE = 10000.0
Q_BLOCK = 128
FFN_HIDDEN = ((8 * D_MODEL + 3 * 256 - 1) // (3 * 256)) * 256

HG_WIDTH = D_MODEL // 2
HG_HEAD_DIM = 128
HG_HEADS = HG_WIDTH // HG_HEAD_DIM
HG_CHUNK = 64
HY_WIDTH = D_MODEL - HG_WIDTH
HY_BANDS = 16
HY_EMB = 2 * HY_BANDS + 1
HY_FILTER_DIM = 64
HY_TARGET = 1e-2
HY_STEEP_PCT = 0.3
HY_GENTLE_PCT = 1.5
EVEN_IN = 5 * HG_WIDTH + 3 * HY_WIDTH
EVEN_OUT = HG_WIDTH + HY_WIDTH
DA_WIDTH = D_MODEL // 2
DA_HEAD_DIM = 64
DA_HEADS = DA_WIDTH // (2 * DA_HEAD_DIM)
DA_V_DIM = 2 * DA_HEAD_DIM
MLA_HEADS = 4
MLA_NOPE = 64
MLA_ROPE = 32
MLA_V = 128
MLA_Q_RANK = D_MODEL // 4
MLA_KV_RANK = D_MODEL // 8
ODD_IN = 3 * DA_WIDTH + MLA_Q_RANK + MLA_KV_RANK + MLA_ROPE
ODD_OUT = DA_HEADS * DA_V_DIM + MLA_HEADS * MLA_V

kernel_name = 'hybrid_hgrn2_hyena_diffattn_mla_dit'


def rms_norm(x, g):
    xf = x.astype(jnp.float32)
    y = xf * lax.rsqrt(jnp.mean(xf * xf, axis=-1, keepdims=True) + EPS)
    return (y * g.astype(jnp.float32)).astype(x.dtype)


def modulate(h, shift, scale):
    return h * (1 + scale) + shift


def swiglu(h, w_gu, w_down):
    g, u = jnp.split(h @ w_gu, 2, axis=-1)
    return (jax.nn.silu(g) * u) @ w_down


def rope_1d(x, pos):
    half = x.shape[-1] // 2
    inv = ROPE_BASE ** (-jnp.arange(half, dtype=jnp.float32) / half)
    ang = pos.astype(jnp.float32)[:, None] * inv
    cos, sin = jnp.cos(ang), jnp.sin(ang)
    xf = x.astype(jnp.float32)
    x1, x2 = xf[..., :half], xf[..., half:]
    return jnp.concatenate([x1 * cos - x2 * sin, x2 * cos + x1 * sin], axis=-1).astype(x.dtype)


def rope_2d(x, row, col):
    h = x.shape[-1] // 2
    return jnp.concatenate([rope_1d(x[..., :h], row), rope_1d(x[..., h:], col)], axis=-1)


def heads_to_tokens(o):
    b_, h_, l_, d_ = o.shape
    return o.transpose(0, 2, 1, 3).reshape(b_, l_, h_ * d_)


def block_attention(q, k, v, scale):
    b_, h_, lq, dq = q.shape
    nb = lq // Q_BLOCK
    qb = q.reshape(b_, h_, nb, Q_BLOCK, dq).transpose(2, 0, 1, 3, 4)

    def one(qi):
        s = jnp.einsum('bhqd,bhkd->bhqk', qi, k, preferred_element_type=jnp.float32) * scale
        p = jax.nn.softmax(s, axis=-1)
        return jnp.einsum('bhqk,bhkd->bhqd', p.astype(v.dtype), v)

    o = lax.map(one, qb)
    return o.transpose(1, 2, 0, 3, 4).reshape(b_, h_, lq, v.shape[-1])


def chunk_scan(q, k, v, log_f, s0):
    b_, h_, length, _ = q.shape
    dv = v.shape[-1]
    n = length // HG_CHUNK

    def chunks(t):
        return t.reshape(b_, h_, n, HG_CHUNK, t.shape[-1]).transpose(2, 0, 1, 3, 4)

    mask = jnp.tril(jnp.ones((HG_CHUNK, HG_CHUNK), dtype=bool))[:, :, None]

    def step(s, inp):
        qc, kc, vc, gc = inp
        cum = jnp.cumsum(gc, axis=-2)
        rel = cum[..., :, None, :] - cum[..., None, :, :]
        dec = jnp.exp(jnp.where(mask, rel, -jnp.inf))
        attn = jnp.einsum('bhtd,bhsd,bhtsd->bhts', qc, kc, dec)
        o = jnp.einsum('bhtd,bhde->bhte', qc * jnp.exp(cum), s) + jnp.einsum('bhts,bhse->bhte', attn, vc)
        last = cum[..., -1:, :]
        s = jnp.exp(last[..., 0, :])[..., None] * s + jnp.einsum('bhsd,bhse->bhde', kc * jnp.exp(last - cum), vc)
        return s, o

    s_fin, o = lax.scan(step, s0, (chunks(q), chunks(k), chunks(v), chunks(log_f)))
    return o.transpose(1, 2, 0, 3, 4).reshape(b_, h_, length, dv), s_fin


def hgrn2_mixer(z_lat, z_ctx, lb, out_norm_g):
    def split_heads(t):
        b_, l_, _ = t.shape
        return t.astype(jnp.float32).reshape(b_, l_, HG_HEADS, HG_HEAD_DIM).transpose(0, 2, 1, 3)

    def prep(z):
        q, ff, fb, i, g = jnp.split(z, 5, axis=-1)
        return split_heads(q), split_heads(ff), split_heads(fb), split_heads(i), g

    def gate(zf, lbd):
        lbh = lbd.reshape(HG_HEADS, 1, HG_HEAD_DIM)
        f = lbh + (1.0 - lbh) * jax.nn.sigmoid(zf)
        return jnp.log(f), 1.0 - f

    def flip(t):
        return jnp.flip(t, axis=2)

    def bidir(q, ff, fb, i, s_f, s_b):
        lf, kf = gate(ff, lb[0])
        lbk, kb = gate(fb, lb[1])
        o_f, s_f = chunk_scan(q, kf, i, lf, s_f)
        o_b, s_b = chunk_scan(flip(q), flip(kb), flip(i), flip(lbk), s_b)
        return o_f + flip(o_b), s_f, s_b

    def readout(o, g):
        o = heads_to_tokens(rms_norm(o, out_norm_g))
        return (o * jax.nn.silu(g.astype(jnp.float32))).astype(g.dtype)

    qc, ffc, fbc, ic, gc = prep(z_ctx)
    s0 = jnp.zeros((z_ctx.shape[0], HG_HEADS, HG_HEAD_DIM, HG_HEAD_DIM), jnp.float32)
    o_c, s_f, s_b = bidir(qc, ffc, fbc, ic, s0, s0)
    ql, ffl, fbl, il, gl = prep(z_lat)
    o_l, _, _ = bidir(ql, ffl, fbl, il, s_f, s_b)
    return readout(o_l, gl), readout(o_c, gc)


def hyena_filter(length, w1, b1, fr1, w2, b2, fr2, w3):
    f32 = jnp.float32
    t = jnp.linspace(0.0, 1.0, length, dtype=f32)[:, None]
    w = 2.0 * math.pi * jnp.arange(length, dtype=f32)[:, None] / length
    bands = jnp.linspace(1e-4, HY_BANDS - 1, HY_BANDS, dtype=f32)[None, :]
    z = jnp.concatenate([t, jnp.cos(bands * w), -jnp.sin(bands * w)], axis=-1)
    h = jnp.sin(fr1.astype(f32) * (z @ w1.astype(f32) + b1.astype(f32)))
    h = jnp.sin(fr2.astype(f32) * (h @ w2.astype(f32) + b2.astype(f32)))
    h = (h @ w3.astype(f32)).reshape(length, 2, HY_WIDTH)
    d_lo = -math.log(HY_TARGET) / HY_GENTLE_PCT
    d_hi = -math.log(HY_TARGET) / HY_STEEP_PCT
    deltas = jnp.linspace(d_lo, d_hi, HY_WIDTH, dtype=f32)
    h = h * jnp.exp(-t * deltas)[:, None, :]
    h_fwd, h_bwd = h[:, 0], h[:, 1]
    filt = jnp.concatenate([h_fwd, jnp.zeros((1, HY_WIDTH), f32), h_bwd[: length - 1][::-1]], axis=0)
    return filt / jnp.sum(jnp.abs(filt), axis=0, keepdims=True)


def hyena_mixer(z, short_w, short_b, filt, skip):
    length = z.shape[1]
    zp = jnp.pad(z, ((0, 0), (1, 1), (0, 0)))
    zc = zp[:, :-2] * short_w[0] + zp[:, 1:-1] * short_w[1] + zp[:, 2:] * short_w[2] + short_b
    x0, x1, v = jnp.split(zc, 3, axis=-1)
    u = (x1 * v).astype(jnp.float32)
    uf = jnp.fft.rfft(u, n=2 * length, axis=1)
    ff = jnp.fft.rfft(filt, n=2 * length, axis=0)
    y = jnp.fft.irfft(uf * ff[None], n=2 * length, axis=1)[:, :length]
    y = y + skip.astype(jnp.float32) * u
    return (x0.astype(jnp.float32) * y).astype(z.dtype)


def even_mixer(h_lat, h_ctx, w_in, w_out, lb, out_norm_g, short_w, short_b, filt_params, skip, need_ctx):
    z_lat = h_lat @ w_in
    z_ctx = h_ctx @ w_in
    na = 5 * HG_WIDTH
    a_lat, a_ctx = hgrn2_mixer(z_lat[..., :na], z_ctx[..., :na], lb, out_norm_g)
    b_lat = hyena_mixer(z_lat[..., na:], short_w, short_b, hyena_filter(h_lat.shape[1], *filt_params), skip)
    y_lat = jnp.concatenate([a_lat, b_lat], axis=-1) @ w_out
    if not need_ctx:
        return y_lat, None
    b_ctx = hyena_mixer(z_ctx[..., na:], short_w, short_b, hyena_filter(h_ctx.shape[1], *filt_params), skip)
    y_ctx = jnp.concatenate([a_ctx, b_ctx], axis=-1) @ w_out
    return y_lat, y_ctx


def diff_heads(z, row, col, rotate):
    b_, l_, _ = z.shape
    q, k, v = jnp.split(z, 3, axis=-1)

    def qk(t):
        t = t.reshape(b_, l_, DA_HEADS, 2, DA_HEAD_DIM).transpose(0, 3, 2, 1, 4).reshape(b_, 2 * DA_HEADS, l_, DA_HEAD_DIM)
        return rope_2d(t, row, col) if rotate else t

    v = v.reshape(b_, l_, DA_HEADS, DA_V_DIM).transpose(0, 2, 1, 3)
    return qk(q), qk(k), jnp.concatenate([v, v], axis=1)


def diff_readout(o, lam, lam_init, subln_g):
    b_, _, l_, _ = o.shape
    o = o.reshape(b_, 2, DA_HEADS, l_, DA_V_DIM)
    o = o[:, 0] - lam.astype(o.dtype) * o[:, 1]
    o = rms_norm(o, subln_g) * (1.0 - lam_init)
    return heads_to_tokens(o)


def mla_heads(z, q_norm_g, w_uq, kv_norm_g, w_ukv, row, col, rotate):
    b_, l_, _ = z.shape
    cq = z[..., :MLA_Q_RANK]
    ckv = z[..., MLA_Q_RANK:MLA_Q_RANK + MLA_KV_RANK]
    kr = z[..., MLA_Q_RANK + MLA_KV_RANK:][:, None]
    q = (rms_norm(cq, q_norm_g) @ w_uq).reshape(b_, l_, MLA_HEADS, MLA_NOPE + MLA_ROPE).transpose(0, 2, 1, 3)
    kv = (rms_norm(ckv, kv_norm_g) @ w_ukv).reshape(b_, l_, MLA_HEADS, MLA_NOPE + MLA_V).transpose(0, 2, 1, 3)
    q_nope, q_rope = q[..., :MLA_NOPE], q[..., MLA_NOPE:]
    k_nope, v = kv[..., :MLA_NOPE], kv[..., MLA_NOPE:]
    if rotate:
        q_rope = rope_2d(q_rope, row, col)
        kr = rope_2d(kr, row, col)
    q = jnp.concatenate([q_nope, q_rope], axis=-1)
    k = jnp.concatenate([k_nope, jnp.broadcast_to(kr, (b_, MLA_HEADS, l_, MLA_ROPE))], axis=-1)
    return q, k, v


def odd_mixer(h_lat, h_ctx, row, col, w_in, w_out, lam_p, lam_init, subln_g, q_norm_g, w_uq, kv_norm_g, w_ukv, need_ctx):
    z_lat = h_lat @ w_in
    z_ctx = h_ctx @ w_in
    nc = 3 * DA_WIDTH
    lp = lam_p.astype(jnp.float32)
    lam = jnp.exp(jnp.sum(lp[0] * lp[1])) - jnp.exp(jnp.sum(lp[2] * lp[3])) + lam_init
    qa, ka, va = diff_heads(z_lat[..., :nc], row, col, True)
    qa_c, ka_c, va_c = diff_heads(z_ctx[..., :nc], row, col, False)
    qm, km, vm = mla_heads(z_lat[..., nc:], q_norm_g, w_uq, kv_norm_g, w_ukv, row, col, True)
    qm_c, km_c, vm_c = mla_heads(z_ctx[..., nc:], q_norm_g, w_uq, kv_norm_g, w_ukv, row, col, False)
    sa = DA_HEAD_DIM ** -0.5
    sm = (MLA_NOPE + MLA_ROPE) ** -0.5
    oa = block_attention(qa, jnp.concatenate([ka, ka_c], axis=2), jnp.concatenate([va, va_c], axis=2), sa)
    om = block_attention(qm, jnp.concatenate([km, km_c], axis=2), jnp.concatenate([vm, vm_c], axis=2), sm)
    y_lat = jnp.concatenate([diff_readout(oa, lam, lam_init, subln_g), heads_to_tokens(om)], axis=-1) @ w_out
    if not need_ctx:
        return y_lat, None
    oa_c = block_attention(qa_c, ka_c, va_c, sa)
    om_c = block_attention(qm_c, km_c, vm_c, sm)
    y_ctx = jnp.concatenate([diff_readout(oa_c, lam, lam_init, subln_g), heads_to_tokens(om_c)], axis=-1) @ w_out
    return y_lat, y_ctx


def setup_inputs(seed: int = 0) -> dict:
    key = jax.random.key(seed)
    keys = iter(jax.random.split(key, 64))

    def nrm(shape, scale):
        return scale * jax.random.normal(next(keys), shape, jnp.float32)

    def gain(shape):
        return 1.0 + nrm(shape, 0.02)

    D = D_MODEL
    return {
        'x': nrm((BATCH, SEQ, D), 1.0),
        'c': nrm((BATCH, D), 1.0),
        'ctx': nrm((BATCH, CTX_LEN, D), 1.0),
        'c_ctx': nrm((D,), 1.0),
        'ada_w': nrm((DEPTH, D, 6 * D), 0.5 * D ** -0.5),
        'ada_b': nrm((DEPTH, 6 * D), 0.02),
        'norm_mix_g': gain((DEPTH, D)),
        'norm_ffn_g': gain((DEPTH, D)),
        'ffn_w_gu': nrm((DEPTH, D, 2 * FFN_HIDDEN), D ** -0.5),
        'ffn_w_down': nrm((DEPTH, FFN_HIDDEN, D), FFN_HIDDEN ** -0.5),
        'ev_w_in': nrm((N_EVEN, D, EVEN_IN), D ** -0.5),
        'ev_w_out': nrm((N_EVEN, EVEN_OUT, D), EVEN_OUT ** -0.5),
        'hg_lower_bound': nrm((N_EVEN, 2, HG_WIDTH), 1.0),
        'hg_out_norm_g': gain((N_EVEN, HG_HEAD_DIM)),
        'hy_short_w': nrm((N_EVEN, 3, 3 * HY_WIDTH), 3 ** -0.5),
        'hy_short_b': nrm((N_EVEN, 3 * HY_WIDTH), 0.02),
        'hy_filt_w1': nrm((N_EVEN, HY_EMB, HY_FILTER_DIM), HY_EMB ** -0.5),
        'hy_filt_b1': nrm((N_EVEN, HY_FILTER_DIM), 0.02),
        'hy_filt_freq1': 1.0 + nrm((N_EVEN, HY_FILTER_DIM), 0.1),
        'hy_filt_w2': nrm((N_EVEN, HY_FILTER_DIM, HY_FILTER_DIM), HY_FILTER_DIM ** -0.5),
        'hy_filt_b2': nrm((N_EVEN, HY_FILTER_DIM), 0.02),
        'hy_filt_freq2': 1.0 + nrm((N_EVEN, HY_FILTER_DIM), 0.1),
        'hy_filt_w3': nrm((N_EVEN, HY_FILTER_DIM, 2 * HY_WIDTH), HY_FILTER_DIM ** -0.5),
        'hy_skip': nrm((N_EVEN, HY_WIDTH), 0.5),
        'od_w_in': nrm((N_ODD, D, ODD_IN), D ** -0.5),
        'od_w_out': nrm((N_ODD, ODD_OUT, D), ODD_OUT ** -0.5),
        'da_lambda': nrm((N_ODD, 4, DA_HEAD_DIM), 0.1),
        'da_subln_g': gain((N_ODD, DA_V_DIM)),
        'mla_q_norm_g': gain((N_ODD, MLA_Q_RANK)),
        'mla_w_uq': nrm((N_ODD, MLA_Q_RANK, MLA_HEADS * (MLA_NOPE + MLA_ROPE)), MLA_Q_RANK ** -0.5),
        'mla_kv_norm_g': gain((N_ODD, MLA_KV_RANK)),
        'mla_w_ukv': nrm((N_ODD, MLA_KV_RANK, MLA_HEADS * (MLA_NOPE + MLA_V)), MLA_KV_RANK ** -0.5),
        'final_norm_g': gain((D,)),
    }


def reference(x, c, ctx, c_ctx, ada_w, ada_b, norm_mix_g, norm_ffn_g, ffn_w_gu, ffn_w_down, ev_w_in, ev_w_out, hg_lower_bound, hg_out_norm_g, hy_short_w, hy_short_b, hy_filt_w1, hy_filt_b1, hy_filt_freq1, hy_filt_w2, hy_filt_b2, hy_filt_freq2, hy_filt_w3, hy_skip, od_w_in, od_w_out, da_lambda, da_subln_g, mla_q_norm_g, mla_w_uq, mla_kv_norm_g, mla_w_ukv, final_norm_g):
    n_lat = x.shape[1]
    rows = n_lat // GRID_W
    tok = jnp.arange(rows * GRID_W)
    row = tok // GRID_W
    col = tok % GRID_W
    p_lb = jax.nn.softmax(hg_lower_bound.astype(jnp.float32), axis=0)
    lower_bounds = jnp.cumsum(p_lb, axis=0) - p_lb[0:1]
    sc = jax.nn.silu(c)
    scc = jax.nn.silu(c_ctx)
    h, hc = x, ctx
    for i in range(DEPTH):
        need_ctx = i < DEPTH - 1
        m = jnp.split(sc @ ada_w[i] + ada_b[i], 6, axis=-1)
        mc = jnp.split(scc @ ada_w[i] + ada_b[i], 6, axis=-1)
        hn = modulate(rms_norm(h, norm_mix_g[i]), m[0][:, None], m[1][:, None])
        hcn = modulate(rms_norm(hc, norm_mix_g[i]), mc[0], mc[1])
        if i % 2 == 0:
            e = i // 2
            filt_params = (hy_filt_w1[e], hy_filt_b1[e], hy_filt_freq1[e], hy_filt_w2[e], hy_filt_b2[e], hy_filt_freq2[e], hy_filt_w3[e])
            y, yc = even_mixer(hn, hcn, ev_w_in[e], ev_w_out[e], lower_bounds[e], hg_out_norm_g[e], hy_short_w[e], hy_short_b[e], filt_params, hy_skip[e], need_ctx)
        else:
            o = i // 2
            lam_init = 0.8 - 0.6 * math.exp(-0.3 * i)
            y, yc = odd_mixer(hn, hcn, row, col, od_w_in[o], od_w_out[o], da_lambda[o], lam_init, da_subln_g[o], mla_q_norm_g[o], mla_w_uq[o], mla_kv_norm_g[o], mla_w_ukv[o], need_ctx)
        h = h + m[2][:, None] * y
        h = h + m[5][:, None] * swiglu(modulate(rms_norm(h, norm_ffn_g[i]), m[3][:, None], m[4][:, None]), ffn_w_gu[i], ffn_w_down[i])
        if need_ctx:
            hc = hc + mc[2] * yc
            hc = hc + mc[5] * swiglu(modulate(rms_norm(hc, norm_ffn_g[i]), mc[3], mc[4]), ffn_w_gu[i], ffn_w_down[i])
    return rms_norm(h, final_norm_g)
```

```cpp
#include <hip/hip_runtime.h>
#include <hip/hip_cooperative_groups.h>
#include <cstdio>
#include <cstdint>
namespace cg = cooperative_groups;

#ifndef MK_PER_PHASE
#define MK_PER_PHASE 0
#endif
#ifndef DBG_ONLY
#define DBG_ONLY -1
#endif
constexpr bool en(int t) { return DBG_ONLY < 0 || DBG_ONLY == t; }
#ifndef PROBE_DBL
#define PROBE_DBL 0
#endif
constexpr bool dbl(int t) { return ((PROBE_DBL >> t) & 1) != 0; }

#define DI __device__ __forceinline__
typedef unsigned short u16;
using bf16x8 = __attribute__((ext_vector_type(8))) short;
using s16x4  = __attribute__((ext_vector_type(4))) short;
using f32x16 = __attribute__((ext_vector_type(16))) float;
using u32x4  = __attribute__((ext_vector_type(4))) unsigned;
typedef float f32x4_t __attribute__((ext_vector_type(4)));
#define MFMA32(a, b, c) __builtin_amdgcn_mfma_f32_32x32x16_bf16((a), (b), (c), 0, 0, 0)

constexpr int D = 1024, NB = 8, SEQ = 4096, CTX = 256;
constexpr int TL = NB * SEQ, TC = NB * CTX, TA = TL + TC;
constexpr int FF = 2816, KPOS = SEQ + CTX;
constexpr int LDS_BYTES = 77824;
constexpr int NPH_LAYER = 11;
constexpr int NPHASES = 1 + (11 + 10 + 11 + 10) + 1;

constexpr size_t OFF_HCTX = 0;
constexpr size_t OFF_MOD  = OFF_HCTX + (size_t)TC * D * 4;
constexpr size_t OFF_RSQ  = OFF_MOD + 4 * 9 * 6144 * 4;
constexpr size_t OFF_RSKV = OFF_RSQ + (size_t)TA * 4;
constexpr size_t OFF_PSUM = OFF_RSKV + (size_t)TA * 4;
constexpr size_t OFF_DBUF = OFF_PSUM + 272 * 1024 * 4;
constexpr size_t OFF_WIN  = OFF_DBUF + 64 * 68 * 128 * 4;
constexpr size_t OFF_WOUT = OFF_WIN + 4096 * 1024 * 2;
constexpr size_t OFF_WGU  = OFF_WOUT + 1024 * 1024 * 2;
constexpr size_t OFF_WDN  = OFF_WGU + 5632 * 1024 * 2;
constexpr size_t OFF_WUQ  = OFF_WDN + 1024 * 2816 * 2;
constexpr size_t OFF_WUKV = OFF_WUQ + 384 * 256 * 2;
constexpr size_t OFF_FR0  = OFF_WUKV + 768 * 128 * 2;
constexpr size_t OFF_FR1  = OFF_FR0 + 512 * 8192 * 2;
constexpr size_t OFF_FCTX = OFF_FR1 + 512 * 8192 * 2;
constexpr size_t OFF_ZA   = OFF_FCTX + 512 * 512 * 2;
constexpr size_t SZ_ZHG   = (size_t)TA * 2560 * 2;
constexpr size_t OFF_ZHY  = OFF_ZA + SZ_ZHG;
constexpr size_t SZ_ZA    = (size_t)TA * 4096 * 2;
constexpr size_t OFF_HN   = OFF_ZA + SZ_ZA;
constexpr size_t SZ_HN    = (size_t)TA * 1024 * 2;
constexpr size_t OFF_UT   = OFF_HN;
constexpr size_t OFF_UTC  = OFF_UT + (size_t)8 * 512 * 4096 * 2;
constexpr size_t OFF_X0T  = OFF_UTC + (size_t)8 * 512 * 256 * 2;
constexpr size_t OFF_X0TC = OFF_X0T + (size_t)8 * 512 * 4096 * 2;
constexpr size_t OFF_ST   = OFF_HN;
constexpr size_t SZ_ST    = (size_t)64 * 68 * 16384 * 2;
constexpr size_t OFF_MIXE = OFF_ZHY;
constexpr size_t OFF_YT   = OFF_ZHY + SZ_HN;
constexpr size_t OFF_YTC  = OFF_YT + (size_t)8 * 512 * 4096 * 2;
static_assert(OFF_YTC + (size_t)8 * 512 * 256 * 2 <= OFF_ZHY + (size_t)TA * 1536 * 2, "yt overflows z_hy");
constexpr size_t OFF_ZO   = OFF_ZA;
constexpr size_t OFF_UPQ  = OFF_ZA + (size_t)TA * 1952 * 2;
constexpr size_t OFF_UPKV = OFF_UPQ + (size_t)TA * 384 * 2;
constexpr size_t OFF_QA   = OFF_UPKV + (size_t)TA * 768 * 2;
constexpr size_t OFF_QAC  = OFF_QA + (size_t)8 * 8 * 4096 * 64 * 2;
constexpr size_t OFF_QM   = OFF_QAC + (size_t)8 * 8 * 256 * 64 * 2;
constexpr size_t OFF_QMC  = OFF_QM + (size_t)8 * 4 * 4096 * 96 * 2;
constexpr size_t OFF_QEND = OFF_QMC + (size_t)8 * 4 * 256 * 96 * 2;
static_assert(OFF_QEND <= OFF_HN, "odd-layer q buffers overflow region A");
constexpr size_t OFF_KA   = OFF_HN;
constexpr size_t OFF_VTA  = OFF_KA + (size_t)8 * 8 * KPOS * 64 * 2;
constexpr size_t OFF_KM   = OFF_VTA + (size_t)8 * 4 * 128 * KPOS * 2;
constexpr size_t OFF_VTM  = OFF_KM + (size_t)8 * 4 * KPOS * 96 * 2;
constexpr size_t OFF_OA   = OFF_ZA;
constexpr size_t OFF_MIXO = OFF_ZA + SZ_HN;
constexpr size_t OFF_ACT  = OFF_ZA;
constexpr size_t OFF_BAR  = OFF_HN + SZ_ST;
constexpr size_t OFF_W2   = OFF_BAR + 16384;
constexpr size_t W2_DELTA = OFF_W2 - OFF_WIN;
constexpr size_t OFF_ROPE = OFF_W2 + (OFF_ZA - OFF_WIN);
constexpr size_t WS_END   = OFF_ROPE + 2 * 1024 * 4;
static_assert(WS_END <= (size_t)536870912, "workspace too large");

struct Params {
  const float* in[33];
  float* out;
  char* ws;
  int ph_lo, ph_hi;
};

__device__ __forceinline__ size_t wofs(int layer) { return (layer & 1) ? W2_DELTA : (size_t)0; }
DI int tid_l() { int t = threadIdx.x; asm volatile("" : "+v"(t)); return t; }
DI int bid_l() { int t = blockIdx.x; asm volatile("" : "+s"(t)); return t; }
typedef __bf16 bf2_t __attribute__((ext_vector_type(2)));
typedef float f2_t __attribute__((ext_vector_type(2)));
DI unsigned pack2(float a, float b) { f2_t v = {a, b}; return __builtin_bit_cast(unsigned, __builtin_convertvector(v, bf2_t)); }
DI u16 f2bf(float x) { return (u16)(pack2(x, x) & 0xffffu); }
DI float bf2f(u16 v) { return __uint_as_float(((unsigned)v) << 16); }
DI float bflo(unsigned w) { return __uint_as_float(w << 16); }
DI float bfhi(unsigned w) { return __uint_as_float(w & 0xffff0000u); }
DI float wave_sum(float v) { for (int o = 32; o > 0; o >>= 1) v += __shfl_xor(v, o); return v; }
DI float sigm(float x) { return __builtin_amdgcn_rcpf(1.f + __expf(-x)); }
DI float siluf(float x) { return x * __builtin_amdgcn_rcpf(1.f + __expf(-x)); }
DI int crow(int r, int h) { return (r & 3) + 8 * (r >> 2) + 4 * h; }
DI int modrow(int row) { return row < TL ? (row >> 12) : 8; }
DI bf16x8 pack8(const f32x16& x, const int s) {
  u32x4 q = {pack2(x[8 * s], x[8 * s + 1]), pack2(x[8 * s + 2], x[8 * s + 3]), pack2(x[8 * s + 4], x[8 * s + 5]), pack2(x[8 * s + 6], x[8 * s + 7])};
  return __builtin_bit_cast(bf16x8, q);
}
DI int slot_of(int e32) { return ((e32 >> 2) & 3) * 8 + (e32 >> 4) * 4 + (e32 & 3); }
DI int elem_of(int slot) { return ((slot >> 2) & 1) * 16 + (slot >> 3) * 4 + (slot & 3); }
DI f32x16 zero16() { f32x16 z; for (int i = 0; i < 16; ++i) z[i] = 0.f; return z; }


#define XB_TMO      128
#define XB_XCNT(j)  (256  + 64 * (j))
#define XB_XSUB(j)  (1280 + 64 * (j))
#define XB_XGEN(j)  (2304 + 64 * (j))
#define XB_TOP      3328
#define XB_TOPGEN   3392
#define XCD_BAR_WORDS 3456
#define XB_SPIN_CAP (1u << 20)
#define LAS __attribute__((address_space(3)))
DI unsigned xb_ld(unsigned* p) { return __hip_atomic_load(p, __ATOMIC_RELAXED, __HIP_MEMORY_SCOPE_AGENT); }
DI unsigned xb_add(unsigned* p, unsigned v) { return __hip_atomic_fetch_add(p, v, __ATOMIC_RELAXED, __HIP_MEMORY_SCOPE_AGENT); }
DI unsigned xb_xcc_id() { return (unsigned)__builtin_amdgcn_s_getreg((3 << 11) | 20) & 0xFu; }
#define XB_SPIN(cond, bar) do { unsigned _sp = 0; while (cond) { __builtin_amdgcn_s_sleep(1); \
    if ((++_sp & 255u) == 0u) { if (xb_ld(&(bar)[XB_TMO])) break; if (_sp > XB_SPIN_CAP) { atomicAdd(&(bar)[XB_TMO], 1u); break; } } } } while (0)
struct XcdBarrier { unsigned* bar; unsigned x; volatile LAS unsigned* st; };
DI XcdBarrier xcd_barrier_post(unsigned* bar, volatile LAS unsigned* st) {
  XcdBarrier b; b.bar = bar; b.x = xb_xcc_id(); b.st = st;
  if (threadIdx.x == 0) (void)xb_add(&bar[XB_XCNT(b.x)], 1u);
  return b;
}
DI void xcd_barrier_complete(unsigned* bar, unsigned x, unsigned& nloc, unsigned& nx) {
  const unsigned G = gridDim.x * gridDim.y * gridDim.z;
  unsigned sum, cnt, mine, sp = 0u;
  for (;;) {
    sum = 0u; cnt = 0u; mine = 0u;
#pragma unroll
    for (unsigned j = 0; j < 16; ++j) { const unsigned c = xb_ld(&bar[XB_XCNT(j)]); sum += c; cnt += (c > 0u) ? 1u : 0u; mine = (j == x) ? c : mine; }
    if (sum == G) break;
    __builtin_amdgcn_s_sleep(1);
    if ((++sp & 255u) == 0u) { if (xb_ld(&bar[XB_TMO])) break; if (sp > XB_SPIN_CAP) { atomicAdd(&bar[XB_TMO], 1u); break; } }
  }
  nloc = mine > 0u ? mine : 1u; nx = cnt > 0u ? cnt : 1u;
}
DI void xcd_barrier(const XcdBarrier& b) {
  asm volatile("s_waitcnt vmcnt(0)" ::: "memory");
  __syncthreads();
  if (threadIdx.x == 0) {
    unsigned* bar = b.bar;
    __builtin_amdgcn_s_waitcnt(0);
    unsigned nloc = b.st[0], nx = b.st[1];
    if (nloc == 0u) { xcd_barrier_complete(bar, b.x, nloc, nx); b.st[0] = nloc; b.st[1] = nx; }
    const unsigned old = xb_add(&bar[XB_XSUB(b.x)], 1u);
    const unsigned gen = old / nloc;
    if (old + 1u == (gen + 1u) * nloc) {
      __builtin_amdgcn_fence(__ATOMIC_RELEASE, "agent");
      asm volatile("s_waitcnt vmcnt(0)" ::: "memory");
      const unsigned og = xb_add(&bar[XB_TOP], 1u);
      const unsigned tg = og / nx;
      if (og + 1u == (tg + 1u) * nx) xb_add(&bar[XB_TOPGEN], 1u);
      else XB_SPIN(xb_ld(&bar[XB_TOPGEN]) == tg, bar);
      __builtin_amdgcn_fence(__ATOMIC_ACQUIRE, "agent");
      xb_add(&bar[XB_XGEN(b.x)], 1u);
      asm volatile("s_waitcnt vmcnt(0)" ::: "memory");
    } else {
      XB_SPIN(xb_ld(&bar[XB_XGEN(b.x)]) == gen, bar);
      __builtin_amdgcn_fence(__ATOMIC_ACQUIRE, "agent");
      asm volatile("s_waitcnt vmcnt(0)" ::: "memory");
    }
  }
  __syncthreads();
}

struct GemmDesc { const u16* A; int lda; const u16* Bt; int ldb; int M; int Npad; int K; int mbase = 0; };

template <int MF, int BK, class Epi>
DI void gemm_phase_t(char* lds, const GemmDesc g, const Epi epi) {
  constexpr int BM = MF * 64, LS = BK + 8, CPR = BK / 8, RSTEP = 256 / CPR;
  constexpr int APT = BM * CPR / 256, BPT = 128 * CPR / 256, STG = (BM + 128) * LS, NKK = BK / 16;
  u16* sbase = (u16*)lds;
  const int tid = tid_l(), lane = tid & 63, w = tid >> 6, wm = w >> 1, wn = w & 1, l31 = lane & 31, h = lane >> 5;
  const int ntn = g.Npad / 128, ntm = g.M / BM, ntiles = ntm * ntn, nk = g.K / BK;
  const int lr = tid / CPR, lc = tid % CPR;
  for (int t = bid_l(); t < ntiles; t += gridDim.x) {
    const int tn = t % ntn, tm = t / ntn;
    const int m0 = tm * BM, n0 = tn * 128;
    const u16* Ap = g.A + (size_t)(m0 + lr) * g.lda + lc * 8;
    const u16* Bp = g.Bt + (size_t)(n0 + lr) * g.ldb + lc * 8;
    u32x4 ra[APT], rb[BPT];
#pragma unroll
    for (int j = 0; j < APT; ++j) ra[j] = *(const u32x4*)(Ap + (size_t)j * RSTEP * g.lda);
#pragma unroll
    for (int j = 0; j < BPT; ++j) rb[j] = *(const u32x4*)(Bp + (size_t)j * RSTEP * g.ldb);
#pragma unroll
    for (int j = 0; j < APT; ++j) *(u32x4*)(sbase + (lr + RSTEP * j) * LS + lc * 8) = ra[j];
#pragma unroll
    for (int j = 0; j < BPT; ++j) *(u32x4*)(sbase + BM * LS + (lr + RSTEP * j) * LS + lc * 8) = rb[j];
    if (nk > 1) {
#pragma unroll
      for (int j = 0; j < APT; ++j) ra[j] = *(const u32x4*)(Ap + (size_t)j * RSTEP * g.lda + BK);
#pragma unroll
      for (int j = 0; j < BPT; ++j) rb[j] = *(const u32x4*)(Bp + (size_t)j * RSTEP * g.ldb + BK);
    }
    f32x16 acc[MF][2];
#pragma unroll
    for (int i = 0; i < MF; ++i)
#pragma unroll
      for (int j = 0; j < 2; ++j) acc[i][j] = zero16();
    for (int kt = 0; kt < nk; ++kt) {
      __syncthreads();
      const u16* sA = sbase + (kt & 1) * STG;
      const u16* sB = sA + BM * LS;
      if (kt + 1 < nk) {
        u16* nA = sbase + ((kt + 1) & 1) * STG;
#pragma unroll
        for (int j = 0; j < APT; ++j) *(u32x4*)(nA + (lr + RSTEP * j) * LS + lc * 8) = ra[j];
#pragma unroll
        for (int j = 0; j < BPT; ++j) *(u32x4*)(nA + BM * LS + (lr + RSTEP * j) * LS + lc * 8) = rb[j];
        if (kt + 2 < nk) {
#pragma unroll
          for (int j = 0; j < APT; ++j) ra[j] = *(const u32x4*)(Ap + (size_t)j * RSTEP * g.lda + (kt + 2) * BK);
#pragma unroll
          for (int j = 0; j < BPT; ++j) rb[j] = *(const u32x4*)(Bp + (size_t)j * RSTEP * g.ldb + (kt + 2) * BK);
        }
      }
      bf16x8 af[NKK][MF], bfr[NKK][2];
#pragma unroll
      for (int kk = 0; kk < NKK; ++kk) {
#pragma unroll
        for (int ni = 0; ni < 2; ++ni) bfr[kk][ni] = *(const bf16x8*)(sB + (wn * 64 + ni * 32 + l31) * LS + kk * 16 + h * 8);
#pragma unroll
        for (int mi = 0; mi < MF; ++mi) af[kk][mi] = *(const bf16x8*)(sA + (wm * (MF * 32) + mi * 32 + l31) * LS + kk * 16 + h * 8);
      }
      __builtin_amdgcn_sched_barrier(0);
#pragma unroll
      for (int kk = 0; kk < NKK; ++kk)
#pragma unroll
        for (int mi = 0; mi < MF; ++mi)
#pragma unroll
          for (int ni = 0; ni < 2; ++ni) acc[mi][ni] = MFMA32(bfr[kk][ni], af[kk][mi], acc[mi][ni]);
    }
    epi(acc, g.mbase + m0 + wm * (MF * 32), n0 + wn * 64, l31, h);
  }
  __syncthreads();
}
template <class Epi>
DI void gemm_phase(char* lds, const GemmDesc g, const Epi epi) { gemm_phase_t<2, 64, Epi>(lds, g, epi); }

struct EpiStore {
  u16* C; int ldc; int N;
  template <int MF> DI void operator()(f32x16 (&acc)[MF][2], int mb, int nb, int l31, int h) const {
#pragma unroll
    for (int mi = 0; mi < MF; ++mi) {
      const int row = mb + mi * 32 + l31;
#pragma unroll
      for (int g4 = 0; g4 < 4; ++g4) {
        const int col0 = nb + 16 * g4 + 8 * h;
        if (col0 < N) *(u32x4*)(C + (size_t)row * ldc + col0) = (u32x4){pack2(acc[mi][0][4 * g4], acc[mi][0][4 * g4 + 1]), pack2(acc[mi][0][4 * g4 + 2], acc[mi][0][4 * g4 + 3]),
                                                                        pack2(acc[mi][1][4 * g4], acc[mi][1][4 * g4 + 1]), pack2(acc[mi][1][4 * g4 + 2], acc[mi][1][4 * g4 + 3])};
      }
    }
  }
};
struct EpiOddIn {
  u16* z; u16* Qa; u16* Qac; u16* Ka; const float* rope;
  template <int MF> DI void operator()(f32x16 (&acc)[MF][2], int mb, int nb, int l31, int h) const {
    if (nb >= 1024) {
#pragma unroll
      for (int mi = 0; mi < MF; ++mi) {
        const int row = mb + mi * 32 + l31;
#pragma unroll
        for (int g4 = 0; g4 < 4; ++g4) {
          const int col0 = nb + 16 * g4 + 8 * h;
          if (col0 < 1952) *(u32x4*)(z + (size_t)row * 1952 + col0) = (u32x4){pack2(acc[mi][0][4 * g4], acc[mi][0][4 * g4 + 1]), pack2(acc[mi][0][4 * g4 + 2], acc[mi][0][4 * g4 + 3]),
                                                                                pack2(acc[mi][1][4 * g4], acc[mi][1][4 * g4 + 1]), pack2(acc[mi][1][4 * g4 + 2], acc[mi][1][4 * g4 + 3])};
        }
      }
      return;
    }
    const int which = nb >> 9, head = ((nb >> 6) & 1) * 4 + ((nb >> 7) & 3);
#pragma unroll
    for (int mi = 0; mi < MF; ++mi) {
      const int row = mb + mi * 32 + l31;
      const bool isl = row < TL;
      const int b = isl ? row >> 12 : (row - TL) >> 8;
      const int t = isl ? row & 4095 : (row - TL) & 255;
      float x[4][8];
#pragma unroll
      for (int g4 = 0; g4 < 4; ++g4)
#pragma unroll
        for (int k = 0; k < 4; ++k) { x[g4][k] = acc[mi][0][4 * g4 + k]; x[g4][4 + k] = acc[mi][1][4 * g4 + k]; }
      if (isl) {
        const float* sr = rope + (t >> 6) * 16 + 8 * h; const float* sc = rope + (t & 63) * 16 + 8 * h;
        const float4 s1a = *(const float4*)(sr), s1b = *(const float4*)(sr + 4), c1a = *(const float4*)(sr + 1024), c1b = *(const float4*)(sr + 1028);
        const float4 s2a = *(const float4*)(sc), s2b = *(const float4*)(sc + 4), c2a = *(const float4*)(sc + 1024), c2b = *(const float4*)(sc + 1028);
        const float s1[8] = {s1a.x, s1a.y, s1a.z, s1a.w, s1b.x, s1b.y, s1b.z, s1b.w}, c1[8] = {c1a.x, c1a.y, c1a.z, c1a.w, c1b.x, c1b.y, c1b.z, c1b.w};
        const float s2[8] = {s2a.x, s2a.y, s2a.z, s2a.w, s2b.x, s2b.y, s2b.z, s2b.w}, c2[8] = {c2a.x, c2a.y, c2a.z, c2a.w, c2b.x, c2b.y, c2b.z, c2b.w};
#pragma unroll
        for (int k = 0; k < 8; ++k) {
          const float a = x[0][k], bq = x[1][k], cq = x[2][k], dq = x[3][k];
          x[0][k] = a * c1[k] - bq * s1[k]; x[1][k] = bq * c1[k] + a * s1[k];
          x[2][k] = cq * c2[k] - dq * s2[k]; x[3][k] = dq * c2[k] + cq * s2[k];
        }
      }
      u16* dst;
      if (which == 0) dst = isl ? Qa + ((size_t)(b * 8 + head) * 4096 + t) * 64 : Qac + ((size_t)(b * 8 + head) * 256 + t) * 64;
      else dst = Ka + ((size_t)(b * 8 + head) * KPOS + (isl ? t : 4096 + t)) * 64;
      dst += 8 * h;
#pragma unroll
      for (int g4 = 0; g4 < 4; ++g4)
        *(u32x4*)(dst + 16 * g4) = (u32x4){pack2(x[g4][0], x[g4][1]), pack2(x[g4][2], x[g4][3]), pack2(x[g4][4], x[g4][5]), pack2(x[g4][6], x[g4][7])};
    }
  }
};
struct EpiSplitEven {
  u16* zhg; u16* zhy;
  template <int MF> DI void operator()(f32x16 (&acc)[MF][2], int mb, int nb, int l31, int h) const {
#pragma unroll
    for (int mi = 0; mi < MF; ++mi) {
      const int row = mb + mi * 32 + l31;
#pragma unroll
      for (int g4 = 0; g4 < 4; ++g4) {
        const int col0 = nb + 16 * g4 + 8 * h;
        u16* dst = (col0 < 2560) ? zhg + (size_t)row * 2560 + col0 : zhy + (size_t)row * 1536 + (col0 - 2560);
        *(u32x4*)dst = (u32x4){pack2(acc[mi][0][4 * g4], acc[mi][0][4 * g4 + 1]), pack2(acc[mi][0][4 * g4 + 2], acc[mi][0][4 * g4 + 3]),
                               pack2(acc[mi][1][4 * g4], acc[mi][1][4 * g4 + 1]), pack2(acc[mi][1][4 * g4 + 2], acc[mi][1][4 * g4 + 3])};
      }
    }
  }
};
struct EpiResid {
  const float* res_lat; const float* res_ctx; float* out_lat; float* out_ctx; const float* gate;
  template <int MF> DI void operator()(f32x16 (&acc)[MF][2], int mb, int nb, int l31, int h) const {
#pragma unroll
    for (int mi = 0; mi < MF; ++mi) {
      const int row = mb + mi * 32 + l31;
      const float* gr = gate + (size_t)modrow(row) * 6144;
      const float* rp = row < TL ? res_lat + (size_t)row * D : res_ctx + (size_t)(row - TL) * D;
      float* op = row < TL ? out_lat + (size_t)row * D : out_ctx + (size_t)(row - TL) * D;
#pragma unroll
      for (int g4 = 0; g4 < 4; ++g4)
#pragma unroll
        for (int ni = 0; ni < 2; ++ni) {
          const int col0 = nb + 16 * g4 + 8 * h + 4 * ni;
          const float4 gt = *(const float4*)(gr + col0);
          const float4 rv = *(const float4*)(rp + col0);
          *(float4*)(op + col0) = make_float4(rv.x + gt.x * acc[mi][ni][4 * g4], rv.y + gt.y * acc[mi][ni][4 * g4 + 1], rv.z + gt.z * acc[mi][ni][4 * g4 + 2], rv.w + gt.w * acc[mi][ni][4 * g4 + 3]);
        }
    }
  }
};
struct EpiSwiglu {
  u16* act;
  template <int MF> DI void operator()(f32x16 (&acc)[MF][2], int mb, int nb, int l31, int h) const {
#pragma unroll
    for (int mi = 0; mi < MF; ++mi) {
      const int row = mb + mi * 32 + l31;
#pragma unroll
      for (int gp = 0; gp < 2; ++gp) {
        const int j0 = (nb >> 1) + 16 * h + 8 * gp;
        float v[8];
#pragma unroll
        for (int i = 0; i < 8; ++i) v[i] = siluf(acc[mi][0][8 * gp + i]) * acc[mi][1][8 * gp + i];
        *(u32x4*)(act + (size_t)row * FF + j0) = (u32x4){pack2(v[0], v[1]), pack2(v[2], v[3]), pack2(v[4], v[5]), pack2(v[6], v[7])};
      }
    }
  }
};

DI void ph_ada(const Params& p, char* lds) {
  float* sS = (float*)lds;
  float* sR = sS + 9 * 1024;
  const int tid = tid_l();
  const float* c = p.in[1]; const float* cc = p.in[3];
  for (int i = tid; i < 9 * 1024; i += 256) {
    const int r = i >> 10, k = i & 1023;
    const float v = r < 8 ? c[r * 1024 + k] : cc[k];
    sS[i] = v / (1.f + expf(-v));
  }
  __syncthreads();
  float* mod = (float*)(p.ws + OFF_MOD);
  for (int item = bid_l(); item < 4 * 96; item += gridDim.x) {
    const int l = item / 96, n0 = (item % 96) * 64, cq = (tid & 15) * 4, ks = tid >> 4;
    float acc[9][4];
#pragma unroll
    for (int r = 0; r < 9; ++r)
#pragma unroll
      for (int j = 0; j < 4; ++j) acc[r][j] = 0.f;
    const float* W = p.in[4] + (size_t)l * 1024 * 6144 + n0 + cq;
#pragma unroll 4
    for (int k = ks * 64; k < ks * 64 + 64; ++k) {
      const float4 wv = *(const float4*)(W + (size_t)k * 6144);
#pragma unroll
      for (int r = 0; r < 9; ++r) {
        const float sv = sS[r * 1024 + k];
        acc[r][0] += sv * wv.x; acc[r][1] += sv * wv.y; acc[r][2] += sv * wv.z; acc[r][3] += sv * wv.w;
      }
    }
#pragma unroll
    for (int r = 0; r < 9; ++r) *(float4*)(sR + (ks * 9 + r) * 64 + cq) = make_float4(acc[r][0], acc[r][1], acc[r][2], acc[r][3]);
    __syncthreads();
    for (int o = tid; o < 576; o += 256) {
      const int r = o >> 6, c2 = o & 63;
      float t = p.in[5][l * 6144 + n0 + c2];
#pragma unroll
      for (int q = 0; q < 16; ++q) t += sR[(q * 9 + r) * 64 + c2];
      mod[(size_t)(l * 9 + r) * 6144 + n0 + c2] = t;
    }
    __syncthreads();
  }
}

DI void convT_tile(char* lds, const float* src, int K, int Nsrc, u16* dst, int tk, int tn, int mode, const float* kscale) {
  float* sT = (float*)lds;
  const int tid = tid_l();
  const int k0 = tk * 64, n0 = tn * 64;
  {
    const int kk = tid >> 2, c16 = (tid & 3) * 16;
    int sc0 = n0 + c16;
    if (mode == 1) { const int blk = n0 >> 6; sc0 = (c16 < 32) ? (blk * 32 + c16) : (2816 + blk * 32 + (c16 - 32)); }
    const float ks = kscale ? kscale[k0 + kk] : 1.f;
    const bool ok = (mode == 1) || (n0 + c16 < Nsrc);
    const float* sp = src + (size_t)(k0 + kk) * Nsrc + sc0;
#pragma unroll
    for (int q = 0; q < 4; ++q) {
      float4 v = ok ? *(const float4*)(sp + q * 4) : make_float4(0.f, 0.f, 0.f, 0.f);
      sT[kk * 65 + c16 + q * 4 + 0] = v.x * ks; sT[kk * 65 + c16 + q * 4 + 1] = v.y * ks;
      sT[kk * 65 + c16 + q * 4 + 2] = v.z * ks; sT[kk * 65 + c16 + q * 4 + 3] = v.w * ks;
    }
  }
  __syncthreads();
  {
    const int n = tid >> 2, kq = (tid & 3) * 16;
    const int sg4 = (n >> 3) & 3, sh = (n >> 2) & 1, si = n & 3, sni = n >> 5;
    const int cs = (mode == 1) ? (n & 32) + 16 * sh + 4 * sg4 + si : 16 * sg4 + 8 * sh + 4 * sni + si;
    unsigned o[8];
#pragma unroll
    for (int q = 0; q < 8; ++q) o[q] = pack2(sT[(kq + 2 * q) * 65 + cs], sT[(kq + 2 * q + 1) * 65 + cs]);
    uint4* dp = (uint4*)(dst + (size_t)(n0 + n) * K + k0 + kq);
    dp[0] = make_uint4(o[0], o[1], o[2], o[3]);
    dp[1] = make_uint4(o[4], o[5], o[6], o[7]);
  }
  __syncthreads();
}

DI void filt_item(const Params& p, char* lds, int e, int idx, size_t wo) {
  float* zf = (float*)lds;
  float* h1 = zf + 16 * 33;
  float* h2 = h1 + 16 * 64;
  const int tid = tid_l();
  const bool lat = idx < 256;
  const int L = lat ? 4096 : 256;
  const int p0 = (lat ? idx : idx - 256) * 16;
  const float* w1 = p.in[16] + (size_t)e * 33 * 64; const float* b1 = p.in[17] + e * 64; const float* fr1 = p.in[18] + e * 64;
  const float* w2 = p.in[19] + (size_t)e * 64 * 64; const float* b2 = p.in[20] + e * 64; const float* fr2 = p.in[21] + e * 64;
  const float* w3 = p.in[22] + (size_t)e * 64 * 1024;
  for (int i = tid; i < 16 * 33; i += 256) {
    const int pp = i / 33, f = i % 33;
    const int pos = p0 + pp;
    const float tt = (float)pos / (float)(L - 1);
    const float wv = (6.283185307179586f * (float)pos) / (float)L;
    float v;
    if (f == 0) v = tt;
    else {
      const int j = (f - 1) & 15;
      const float band = 1e-4f + (float)j * ((15.f - 1e-4f) / 15.f);
      v = (f <= 16) ? cosf(band * wv) : -sinf(band * wv);
    }
    zf[i] = v;
  }
  __syncthreads();
  for (int i = tid; i < 1024; i += 256) {
    const int pp = i >> 6, j = i & 63;
    float s = b1[j];
#pragma unroll 3
    for (int f = 0; f < 33; ++f) s += zf[pp * 33 + f] * w1[f * 64 + j];
    h1[i] = sinf(fr1[j] * s);
  }
  __syncthreads();
  for (int i = tid; i < 1024; i += 256) {
    const int pp = i >> 6, j = i & 63;
    float s = b2[j];
#pragma unroll 4
    for (int k = 0; k < 64; ++k) s += h1[pp * 64 + k] * w2[k * 64 + j];
    h2[i] = sinf(fr2[j] * s);
  }
  __syncthreads();
  u16* R0 = (u16*)(p.ws + wo + OFF_FR0); u16* R1 = (u16*)(p.ws + wo + OFF_FR1); u16* FC = (u16*)(p.ws + wo + OFF_FCTX);
  float* psum = (float*)(p.ws + OFF_PSUM);
  const float d_lo = 4.605170185988091f / 1.5f, d_hi = 4.605170185988091f / 0.3f;
#pragma unroll 1
  for (int q = 0; q < 4; ++q) {
    const int n = tid + 256 * q;
    float acc[16];
#pragma unroll
    for (int pp = 0; pp < 16; ++pp) acc[pp] = 0.f;
#pragma unroll 2
    for (int k = 0; k < 64; ++k) {
      const float wv = w3[k * 1024 + n];
#pragma unroll
      for (int pp = 0; pp < 16; ++pp) acc[pp] += h2[pp * 64 + k] * wv;
    }
    const int ch = n & 511;
    const bool bwd = n >= 512;
    const float delta = d_lo + (float)ch * ((d_hi - d_lo) / 511.f);
    float asum = 0.f;
#pragma unroll
    for (int pp = 0; pp < 16; ++pp) {
      const int pos = p0 + pp;
      const float tt = (float)pos / (float)(L - 1);
      const float val = acc[pp] * expf(-tt * delta);
      const int lag = bwd ? -(pos + 1) : pos;
      const bool valid = !bwd || (pos <= L - 2);
      if (valid) {
        asum += fabsf(val);
        const u16 bv = f2bf(val);
        if (lat) {
          const int m = 8191 - (4096 + lag);
          R0[(size_t)ch * 8192 + m] = bv;
          if (m >= 1) R1[(size_t)ch * 8192 + m - 1] = bv;
        } else {
          FC[(size_t)ch * 512 + 256 + lag] = bv;
        }
      }
    }
    if (lat && bwd && p0 == 0) {   }
    psum[(size_t)idx * 1024 + n] = asum;
  }
  if (lat && p0 == 0) {
    for (int ch = tid; ch < 512; ch += 256) { R0[(size_t)ch * 8192 + 8191] = 0; R1[(size_t)ch * 8192 + 8191] = 0; R1[(size_t)ch * 8192 + 8190] = 0; }
  }
  if (!lat && p0 == 0) { for (int ch = tid; ch < 512; ch += 256) FC[(size_t)ch * 512] = 0; }
  __syncthreads();
}

DI void ph_norm(const float* src_lat, const float* src_ctx, int rows, const float* g, const float* modl, int i_shift, int i_scale, u16* dst) {
  const int lane = tid_l() & 63;
  const int wid = bid_l() * 4 + (tid_l() >> 6), nw = gridDim.x * 4;
  const int per = (rows + nw - 1) / nw;
  const int r0 = wid * per, r1 = (r0 + per < rows) ? r0 + per : rows;
  float gs[16], sh[16];
  int cur = -1;
  for (int row = r0; row < r1; ++row) {
    const int mrow = modrow(row);
    if (mrow != cur) {
      cur = mrow;
      const float* mr = modl + (size_t)mrow * 6144;
#pragma unroll
      for (int j = 0; j < 4; ++j) {
        const int c0 = lane * 4 + 256 * j;
        const float4 gg = *(const float4*)(g + c0);
        const float4 sc = *(const float4*)(mr + i_scale * 1024 + c0);
        const float4 s4 = *(const float4*)(mr + i_shift * 1024 + c0);
        gs[4 * j] = gg.x * (1.f + sc.x); gs[4 * j + 1] = gg.y * (1.f + sc.y); gs[4 * j + 2] = gg.z * (1.f + sc.z); gs[4 * j + 3] = gg.w * (1.f + sc.w);
        sh[4 * j] = s4.x; sh[4 * j + 1] = s4.y; sh[4 * j + 2] = s4.z; sh[4 * j + 3] = s4.w;
      }
    }
    const float* src = row < TL ? src_lat + (size_t)row * D : src_ctx + (size_t)(row - TL) * D;
    float4 v[4]; float ss = 0.f;
#pragma unroll
    for (int j = 0; j < 4; ++j) { v[j] = *(const float4*)(src + lane * 4 + 256 * j); ss += v[j].x * v[j].x + v[j].y * v[j].y + v[j].z * v[j].z + v[j].w * v[j].w; }
    ss = wave_sum(ss);
    const float rs = rsqrtf(ss * (1.f / 1024.f) + 1e-6f);
#pragma unroll
    for (int j = 0; j < 4; ++j) {
      const int c0 = lane * 4 + 256 * j;
      *(uint2*)(dst + (size_t)row * D + c0) = make_uint2(pack2(v[j].x * rs * gs[4 * j] + sh[4 * j], v[j].y * rs * gs[4 * j + 1] + sh[4 * j + 1]),
                                                         pack2(v[j].z * rs * gs[4 * j + 2] + sh[4 * j + 2], v[j].w * rs * gs[4 * j + 3] + sh[4 * j + 3]));
    }
  }
}

DI void ph_convert(const Params& p, char* lds, int layer, int b0) {
  const bool even = (layer & 1) == 0;
  const int e = layer >> 1;
  char* ws = p.ws + wofs(layer);
  const float* w_in  = even ? p.in[10] + (size_t)e * 1024 * 4096 : p.in[24] + (size_t)e * 1024 * 1952;
  const int n_in = even ? 4096 : 1952, n_in_pad = even ? 4096 : 2048;
  const float* w_out = even ? p.in[11] + (size_t)e * 1024 * 1024 : p.in[25] + (size_t)e * 1024 * 1024;
  const float* w_gu = p.in[8] + (size_t)layer * 1024 * 5632;
  const float* w_dn = p.in[9] + (size_t)layer * 2816 * 1024;
  const int s0 = 16 * (n_in_pad / 64);
  const int s1 = s0 + 16 * 16;
  const int s2 = s1 + 16 * 88;
  const int s3 = s2 + 44 * 16;
  const int s4 = s3 + (even ? 0 : 4 * 6);
  const int s5 = s4 + (even ? 0 : 2 * 12);
  const int s6 = s5 + (even ? 272 : 0);
  const int bid = bid_l();
  if (bid < b0) return;
  for (int it0 = bid - b0; it0 < s6; it0 += (int)gridDim.x - b0) {
    const int it = (it0 < s6 - s5) ? s5 + it0 : it0 - (s6 - s5);
    if (it >= s5) { filt_item(p, lds, e, it - s5, wofs(layer)); continue; }
    const float* src; int K, Nsrc, ntn, q, mode = 0; u16* dst; const float* ksc = nullptr;
    if (it < s0) { src = w_in; K = 1024; Nsrc = n_in; ntn = n_in_pad / 64; q = it; dst = (u16*)(ws + OFF_WIN); }
    else if (it < s1) { src = w_out; K = 1024; Nsrc = 1024; ntn = 16; q = it - s0; dst = (u16*)(ws + OFF_WOUT); }
    else if (it < s2) { src = w_gu; K = 1024; Nsrc = 5632; ntn = 88; q = it - s1; dst = (u16*)(ws + OFF_WGU); mode = 1; }
    else if (it < s3) { src = w_dn; K = 2816; Nsrc = 1024; ntn = 16; q = it - s2; dst = (u16*)(ws + OFF_WDN); }
    else if (it < s4) { src = p.in[29] + (size_t)e * 256 * 384; K = 256; Nsrc = 384; ntn = 6; q = it - s3; dst = (u16*)(ws + OFF_WUQ); ksc = p.in[28] + e * 256; }
    else { src = p.in[31] + (size_t)e * 128 * 768; K = 128; Nsrc = 768; ntn = 12; q = it - s4; dst = (u16*)(ws + OFF_WUKV); ksc = p.in[30] + e * 128; }
    convT_tile(lds, src, K, Nsrc, dst, q / ntn, q % ntn, mode, ksc);
  }
}
DI void ph_layer_start(const Params& p, char* lds, int layer) {
  char* ws = p.ws;
  const float* hl = layer == 0 ? p.in[0] : p.out;
  const float* hc = layer == 0 ? p.in[2] : (const float*)(ws + OFF_HCTX);
  ph_norm(hl, hc, TA, p.in[6] + layer * 1024, (const float*)(ws + OFF_MOD) + (size_t)layer * 9 * 6144, 0, 1, (u16*)(ws + OFF_HN));
}

DI void ph_hy_short(const Params& p, char* lds, int e) {
  u16* sU = (u16*)lds; u16* sX = sU + 64 * 72;
  const int tid = tid_l();
  const u16* zhy = (const u16*)(p.ws + OFF_ZHY);
  const float* sw = p.in[14] + (size_t)e * 3 * 1536; const float* sb = p.in[15] + e * 1536;
  const int cc = bid_l() & 7, rank = bid_l() >> 3, nbc = ((int)gridDim.x + 7 - cc) >> 3;
  float wa[3][8], wb[3][8], wc[3][8], bb[3][8];
#pragma unroll
  for (int sct = 0; sct < 3; ++sct) {
    const int col = sct * 512 + cc * 64 + (tid & 7) * 8;
#pragma unroll
    for (int q = 0; q < 2; ++q) {
      const float4 a = *(const float4*)(sw + col + 4 * q), b2 = *(const float4*)(sw + 1536 + col + 4 * q), c2 = *(const float4*)(sw + 3072 + col + 4 * q), d2 = *(const float4*)(sb + col + 4 * q);
      wa[sct][4 * q] = a.x; wa[sct][4 * q + 1] = a.y; wa[sct][4 * q + 2] = a.z; wa[sct][4 * q + 3] = a.w;
      wb[sct][4 * q] = b2.x; wb[sct][4 * q + 1] = b2.y; wb[sct][4 * q + 2] = b2.z; wb[sct][4 * q + 3] = b2.w;
      wc[sct][4 * q] = c2.x; wc[sct][4 * q + 1] = c2.y; wc[sct][4 * q + 2] = c2.z; wc[sct][4 * q + 3] = c2.w;
      bb[sct][4 * q] = d2.x; bb[sct][4 * q + 1] = d2.y; bb[sct][4 * q + 2] = d2.z; bb[sct][4 * q + 3] = d2.w;
    }
  }
  for (int jp = rank; jp < 512 + 32; jp += nbc) {
    int b, tt, L; size_t rowbase; u16 *ud, *xd;
    if (jp < 512) { b = jp >> 6; tt = jp & 63; L = 4096; rowbase = (size_t)b * 4096;
      ud = (u16*)(p.ws + OFF_UT) + (size_t)b * 512 * 4096; xd = (u16*)(p.ws + OFF_X0T) + (size_t)b * 512 * 4096; }
    else { const int q = jp - 512; b = q >> 2; tt = q & 3; L = 256; rowbase = (size_t)TL + (size_t)b * 256;
      ud = (u16*)(p.ws + OFF_UTC) + (size_t)b * 512 * 256; xd = (u16*)(p.ws + OFF_X0TC) + (size_t)b * 512 * 256; }
    {
      const int cg = tid & 7, tp = tid >> 3;
      const int ch0 = cc * 64 + cg * 8;
      const int t0 = tt * 64 + tp * 2;
      float zc[3][2][8];
#pragma unroll
      for (int sct = 0; sct < 3; ++sct) {
        const int col = sct * 512 + ch0;
        u32x4 zv[4];
#pragma unroll
        for (int k = 0; k < 4; ++k) {
          const int t = t0 - 1 + k;
          zv[k] = (t >= 0 && t < L) ? *(const u32x4*)(zhy + (rowbase + t) * 1536 + col) : (u32x4){0u, 0u, 0u, 0u};
        }
#pragma unroll
        for (int k = 0; k < 2; ++k)
#pragma unroll
          for (int i = 0; i < 8; ++i) {
            const float pv = (i & 1) ? bfhi(zv[k][i >> 1]) : bflo(zv[k][i >> 1]);
            const float cv = (i & 1) ? bfhi(zv[k + 1][i >> 1]) : bflo(zv[k + 1][i >> 1]);
            const float nv = (i & 1) ? bfhi(zv[k + 2][i >> 1]) : bflo(zv[k + 2][i >> 1]);
            zc[sct][k][i] = pv * wa[sct][i] + cv * wb[sct][i] + nv * wc[sct][i] + bb[sct][i];
          }
      }
#pragma unroll
      for (int k = 0; k < 2; ++k)
#pragma unroll
        for (int i = 0; i < 8; ++i) {
          sU[(cg * 8 + i) * 72 + tp * 2 + k] = f2bf(zc[1][k][i] * zc[2][k][i]);
          sX[(cg * 8 + i) * 72 + tp * 2 + k] = f2bf(zc[0][k][i]);
        }
    }
    __syncthreads();
    {
      const int cr = tid >> 2, tq2 = (tid & 3) * 16;
      const size_t o = (size_t)(cc * 64 + cr) * L + tt * 64 + tq2;
      const uint4* su = (const uint4*)(sU + cr * 72 + tq2); const uint4* sx = (const uint4*)(sX + cr * 72 + tq2);
      uint4* du = (uint4*)(ud + o); uint4* dx = (uint4*)(xd + o);
      du[0] = su[0]; du[1] = su[1]; dx[0] = sx[0]; dx[1] = sx[1];
    }
    __syncthreads();
  }
}

DI void ph_hy_long(const Params& p, char* lds, int e) {
  constexpr int UR = 5128;
  u16* sUu = (u16*)lds;
  u16* sF0 = sUu + 4 * UR;
  u16* sF1 = sF0 + 8224;
  float* sRed = (float*)(sF1 + 8200);
  const int tid = tid_l(), lane = tid & 63, w = tid >> 6, l31 = lane & 31, h = lane >> 5;
  const float* psum = (const float*)(p.ws + OFF_PSUM);
  const float* skip = p.in[23] + e * 512;
  {
    unsigned z0 = 0u;
    asm volatile("" : "+v"(z0));
    const u32x4 zz = {z0, z0, z0, z0};
    for (int i = tid; i < 4 * 129; i += 256) {
      const int b = i / 129, q = i % 129;
      const int off = q < 64 ? q * 8 : 512 + 4096 + (q - 64) * 8;
      *(u32x4*)(sUu + b * UR + off) = zz;
    }
  }
  __syncthreads();
  for (int it = bid_l(); it < 1024; it += gridDim.x) {
    const int c = it >> 1, bh = it & 1;
    {
      float v = psum[(size_t)tid * 1024 + c] + psum[(size_t)tid * 1024 + 512 + c];
      v = wave_sum(v);
      if (lane == 0) sRed[w] = v;
    }
    {
      const u16* ut = (const u16*)(p.ws + OFF_UT);
      for (int i = tid; i < 4 * 512; i += 256) {
        const int b = i >> 9, q = i & 511;
        *(u32x4*)(sUu + b * UR + 512 + q * 8) = *(const u32x4*)(ut + ((size_t)(bh * 4 + b) * 512 + c) * 4096 + q * 8);
      }
      const u16* R0 = (const u16*)(p.ws + OFF_FR0) + (size_t)c * 8192; const u16* R1 = (const u16*)(p.ws + OFF_FR1) + (size_t)c * 8192;
      for (int i = tid; i < 1024; i += 256) { *(u32x4*)(sF0 + i * 8) = *(const u32x4*)(R0 + i * 8); *(u32x4*)(sF1 + i * 8) = *(const u32x4*)(R1 + i * 8); }
    }
    __syncthreads();
    const float inv = 1.f / (sRed[0] + sRed[1] + sRed[2] + sRed[3]);
    f32x16 acc[2][2];
#pragma unroll
    for (int i = 0; i < 2; ++i)
#pragma unroll
      for (int j = 0; j < 2; ++j) acc[i][j] = zero16();
    const int ci = elem_of(l31);
    const int par = (4095 - ci) & 1;
    const u16* fl = (par ? sF1 : sF0) + (4095 - ci + 8 * h - par);
    const int Tl = l31 >> 2, bl = l31 & 3;
    const u16* ub = sUu + bl * UR + 512 + 64 * Tl + 8 * h;
    const int wsc = __builtin_amdgcn_readfirstlane(w);
#define HY_BODY(V0_, V1_)                                                                                      \
    {                                                                                                          \
      const u16* fd = fl - 64 * dl;                                                                            \
      const u16* u0 = ub + 64 * (16 * wsc - dl);                                                               \
      _Pragma("unroll") for (int kk = 0; kk < 4; ++kk) {                                                       \
        bf16x8 af[2];                                                                                          \
        _Pragma("unroll") for (int mi = 0; mi < 2; ++mi) {                                                     \
          const unsigned* fp = (const unsigned*)(fd - 32 * mi + 16 * kk);                                      \
          u32x4 q = {fp[0], fp[1], fp[2], fp[3]};                                                              \
          af[mi] = __builtin_bit_cast(bf16x8, q);                                                              \
        }                                                                                                      \
        if (V0_) { const bf16x8 bb = *(const bf16x8*)(u0 + kk * 16);       acc[0][0] = MFMA32(af[0], bb, acc[0][0]); acc[1][0] = MFMA32(af[1], bb, acc[1][0]); } \
        if (V1_) { const bf16x8 bb = *(const bf16x8*)(u0 + 512 + kk * 16); acc[0][1] = MFMA32(af[0], bb, acc[0][1]); acc[1][1] = MFMA32(af[1], bb, acc[1][1]); } \
      }                                                                                                        \
    }
    {
      const int a0 = 16 * wsc - 63 < -63 ? -63 : 16 * wsc - 63, a1 = 16 * wsc - 56;
      for (int dl = a0; dl <= a1; ++dl) HY_BODY(true, false)
      const int b0 = 16 * wsc - 55 < -63 ? -63 : 16 * wsc - 55, b1 = 16 * wsc + 7;
      for (int dl = b0; dl <= b1; ++dl) HY_BODY(true, true)
      const int c0 = 16 * wsc + 8, c1 = 16 * wsc + 15 > 63 ? 63 : 16 * wsc + 15;
      for (int dl = c0; dl <= c1; ++dl) HY_BODY(false, true)
    }
#undef HY_BODY
    int Tl_e = Tl, h_e = h;
    asm volatile("" : "+v"(Tl_e), "+v"(h_e));
    const float sk = skip[c];
    const int b = bh * 4 + bl;
    const u16* x0t = (const u16*)(p.ws + OFF_X0T) + ((size_t)b * 512 + c) * 4096;
    u16* ytp = (u16*)(p.ws + OFF_YT) + ((size_t)b * 512 + c) * 4096;
#pragma unroll
    for (int mi = 0; mi < 2; ++mi)
#pragma unroll
      for (int nf = 0; nf < 2; ++nf) {
        const int T = 16 * w + 8 * nf + Tl_e;
        asm volatile("" ::: "memory");
#pragma unroll
        for (int gp = 0; gp < 2; ++gp) {
          const int t = 64 * T + mi * 32 + 16 * h_e + 8 * gp;
          const u32x4 uu = *(const u32x4*)(sUu + bl * UR + 512 + t);
          const u32x4 xx = *(const u32x4*)(x0t + t);
          float y[8];
#pragma unroll
          for (int q = 0; q < 4; ++q) {
            y[2 * q] = bflo(xx[q]) * (acc[mi][nf][8 * gp + 2 * q] * inv + sk * bflo(uu[q]));
            y[2 * q + 1] = bfhi(xx[q]) * (acc[mi][nf][8 * gp + 2 * q + 1] * inv + sk * bfhi(uu[q]));
          }
          *(u32x4*)(ytp + t) = (u32x4){pack2(y[0], y[1]), pack2(y[2], y[3]), pack2(y[4], y[5]), pack2(y[6], y[7])};
        }
      }
    __syncthreads();
  }
  {
    const u16* FC = (const u16*)(p.ws + OFF_FCTX);
    const u16* utc = (const u16*)(p.ws + OFF_UTC); const u16* x0c = (const u16*)(p.ws + OFF_X0TC); u16* ytc = (u16*)(p.ws + OFF_YTC);
    const int total = 8 * 512 * 32;
    for (int i = bid_l() * 256 + tid; i < total; i += gridDim.x * 256) {
      const int tb = i & 31, c = (i >> 5) & 511, b = i >> 14;
      float nrm = 0.f;
#pragma unroll 4
      for (int q = 256; q < 272; ++q) nrm += psum[(size_t)q * 1024 + c] + psum[(size_t)q * 1024 + 512 + c];
      const u16* uu = utc + ((size_t)b * 512 + c) * 256;
      const u16* ff = FC + (size_t)c * 512;
      float y[8];
#pragma unroll
      for (int k = 0; k < 8; ++k) y[k] = 0.f;
      u32x4 hi = *(const u32x4*)(ff + (32 + tb) * 8);
      for (int sb = 0; sb < 32; ++sb) {
        const u32x4 lo = *(const u32x4*)(ff + (31 + tb - sb) * 8);
        const u32x4 uv = *(const u32x4*)(uu + sb * 8);
        float f[16], u8[8];
#pragma unroll
        for (int q = 0; q < 4; ++q) { f[2 * q] = bflo(lo[q]); f[2 * q + 1] = bfhi(lo[q]); f[8 + 2 * q] = bflo(hi[q]); f[9 + 2 * q] = bfhi(hi[q]); u8[2 * q] = bflo(uv[q]); u8[2 * q + 1] = bfhi(uv[q]); }
#pragma unroll
        for (int k = 0; k < 8; ++k)
#pragma unroll
          for (int j = 0; j < 8; ++j) y[k] += f[8 + k - j] * u8[j];
        hi = lo;
      }
      const float inv = 1.f / nrm, sk = skip[c];
      const u32x4 ut = *(const u32x4*)(uu + tb * 8);
      const u32x4 xv = *(const u32x4*)(x0c + ((size_t)b * 512 + c) * 256 + tb * 8);
      float o[8];
#pragma unroll
      for (int q = 0; q < 4; ++q) {
        o[2 * q] = bflo(xv[q]) * (y[2 * q] * inv + sk * bflo(ut[q]));
        o[2 * q + 1] = bfhi(xv[q]) * (y[2 * q + 1] * inv + sk * bfhi(ut[q]));
      }
      *(u32x4*)(ytc + ((size_t)b * 512 + c) * 256 + tb * 8) = (u32x4){pack2(o[0], o[1]), pack2(o[2], o[3]), pack2(o[4], o[5]), pack2(o[6], o[7])};
    }
  }
}

DI float hg_lb(const Params& p, int e, int dir, int j) {
  if (e == 0) return 0.f;
  const float a0 = p.in[12][(0 * 2 + dir) * 512 + j], a1 = p.in[12][(1 * 2 + dir) * 512 + j];
  return __builtin_amdgcn_rcpf(1.f + __expf(a0 - a1));
}
DI size_t hg_row(int b, int dir, int c, int s) {
  if (c < 4) { const int pp = 64 * c + s; return (size_t)TL + (size_t)b * 256 + (dir ? 255 - pp : pp); }
  const int pp = 64 * (c - 4) + s; return (size_t)b * 4096 + (dir ? 4095 - pp : pp);
}

DI void ph_hg1(const Params& p, char* lds, int e) {
  u16* sKe = (u16*)lds;
  u16* sVt = sKe + 128 * 72;
  u16* sF = sVt + 128 * 72;
  u16* sV = sF + 64 * 136;
  const int tid = tid_l(), lane = tid & 63, w = tid >> 6, l31 = lane & 31, h = lane >> 5;
  const u16* z = (const u16*)(p.ws + OFF_ZA);
  u16* st = (u16*)(p.ws + OFF_ST); float* dbuf = (float*)(p.ws + OFF_DBUF);
  {
    u16* sT = (u16*)lds;
    u16* mix = (u16*)(p.ws + OFF_MIXE);
    const int nlat = 8 * 64 * 8, nall = nlat + 8 * 4 * 8;
    for (int it = bid_l(); it < nall; it += gridDim.x) {
      int b, tt, cc, L; size_t rowbase; const u16* src;
      if (it < nlat) { b = it >> 9; tt = (it >> 3) & 63; cc = it & 7; L = 4096; rowbase = (size_t)b * 4096; src = (const u16*)(p.ws + OFF_YT) + (size_t)b * 512 * 4096; }
      else { const int q = it - nlat; b = q >> 5; tt = (q >> 3) & 3; cc = q & 7; L = 256; rowbase = (size_t)TL + (size_t)b * 256; src = (const u16*)(p.ws + OFF_YTC) + (size_t)b * 512 * 256; }
      {
        const int cr = tid >> 2, tq = (tid & 3) * 16;
        const u32x4* sp = (const u32x4*)(src + (size_t)(cc * 64 + cr) * L + tt * 64 + tq);
        *(u32x4*)(sT + cr * 72 + tq) = sp[0];
        *(u32x4*)(sT + cr * 72 + tq + 8) = sp[1];
      }
      __syncthreads();
      {
        const int t = tid >> 2, cq = (tid & 3) * 16;
        unsigned o[8];
#pragma unroll
        for (int q = 0; q < 8; ++q) o[q] = (unsigned)sT[(cq + 2 * q) * 72 + t] | ((unsigned)sT[(cq + 2 * q + 1) * 72 + t] << 16);
        u32x4* dp = (u32x4*)(mix + (rowbase + tt * 64 + t) * D + 512 + cc * 64 + cq);
        dp[0] = (u32x4){o[0], o[1], o[2], o[3]};
        dp[1] = (u32x4){o[4], o[5], o[6], o[7]};
      }
      __syncthreads();
    }
  }
  for (int it = bid_l(); it < 64 * 68; it += gridDim.x) {
    const int seq = it / 68, c = it % 68;
    const int dir = seq & 1, hh = (seq >> 1) & 3, b = seq >> 3;
#pragma unroll
    for (int j = 0; j < 4; ++j) {
      const int i = tid + 256 * j, r = i >> 4, ch = i & 15;
      const u16* zr = z + hg_row(b, dir, c, r) * 2560 + hh * 128 + ch * 8;
      *(u32x4*)(sF + r * 136 + ch * 8) = *(const u32x4*)(zr + 512 + dir * 512);
      *(u32x4*)(sV + r * 136 + ch * 8) = *(const u32x4*)(zr + 1536);
    }
    __syncthreads();
    if (tid < 128) {
      const int d = tid;
      const int dc = d & 63, dslot = (d & 64) + ((dc >> 2) & 1) * 32 + (dc >> 4) * 8 + ((dc >> 3) & 1) * 4 + (dc & 3);
      const float lb = hg_lb(p, e, dir, hh * 128 + d);
      float P = 1.f;
      for (int s = 63; s >= 0; --s) {
        const float zf = bf2f(sF[s * 136 + d]);
        const float f = lb + (1.f - lb) * sigm(zf);
        sKe[dslot * 72 + s] = f2bf((1.f - f) * P);
        P *= f;
      }
      dbuf[(size_t)(seq * 68 + c) * 128 + d] = P;
    } else {
      const int ee = tid - 128;
      for (int s = 0; s < 64; ++s) sVt[ee * 72 + s] = sV[s * 136 + ee];
    }
    __syncthreads();
    f32x16 acc[4];
#pragma unroll
    for (int i = 0; i < 4; ++i) acc[i] = zero16();
#pragma unroll
    for (int kk = 0; kk < 4; ++kk) {
      const bf16x8 af = *(const bf16x8*)(sVt + (32 * w + l31) * 72 + kk * 16 + 8 * h);
#pragma unroll
      for (int nf = 0; nf < 4; ++nf) {
        const bf16x8 bb = *(const bf16x8*)(sKe + (nf * 32 + l31) * 72 + kk * 16 + 8 * h);
        acc[nf] = MFMA32(bb, af, acc[nf]);
      }
    }
    u16* dst = st + (size_t)(seq * 68 + c) * 16384 + (32 * w + l31) * 128;
#pragma unroll
    for (int grp = 0; grp < 2; ++grp)
#pragma unroll
      for (int g4 = 0; g4 < 4; ++g4)
        *(u32x4*)(dst + grp * 64 + 16 * g4 + 8 * h) = (u32x4){pack2(acc[2 * grp][4 * g4], acc[2 * grp][4 * g4 + 1]), pack2(acc[2 * grp][4 * g4 + 2], acc[2 * grp][4 * g4 + 3]),
                                                              pack2(acc[2 * grp + 1][4 * g4], acc[2 * grp + 1][4 * g4 + 1]), pack2(acc[2 * grp + 1][4 * g4 + 2], acc[2 * grp + 1][4 * g4 + 3])};
    __syncthreads();
  }
}

DI void ph_hg2(const Params& p) {
  u16* st = (u16*)(p.ws + OFF_ST); const float* dbuf = (const float*)(p.ws + OFF_DBUF);
  for (int i = bid_l() * 256 + tid_l(); i < 64 * 128 * 16; i += gridDim.x * 256) {
    const int dg = i & 15, ee = (i >> 4) & 127, seq = i >> 11;
    float S[8];
#pragma unroll
    for (int j = 0; j < 8; ++j) S[j] = 0.f;
    u32x4* base = (u32x4*)(st + ((size_t)(seq * 68) * 128 + ee) * 128 + dg * 8);
    const float* dp = dbuf + (size_t)(seq * 68) * 128 + dg * 8;
    u32x4 l0 = base[0], l1 = base[2048], l2 = base[2 * 2048];
    for (int c = 0; c < 68; ++c) {
      u32x4 l3 = l2;
      if (c + 3 < 68) l3 = base[(size_t)(c + 3) * 2048];
      const float4 d0 = *(const float4*)(dp + c * 128);
      const float4 d1 = *(const float4*)(dp + c * 128 + 4);
      base[(size_t)c * 2048] = (u32x4){pack2(S[0], S[1]), pack2(S[2], S[3]), pack2(S[4], S[5]), pack2(S[6], S[7])};
      const float dd[8] = {d0.x, d0.y, d0.z, d0.w, d1.x, d1.y, d1.z, d1.w};
#pragma unroll
      for (int j = 0; j < 8; ++j) {
        const unsigned wv = l0[j >> 1];
        const float L = __uint_as_float((j & 1) ? (wv & 0xffff0000u) : (wv << 16));
        S[j] = dd[j] * S[j] + L;
      }
      l0 = l1; l1 = l2; l2 = l3;
    }
  }
}

DI void ph_hg3(const Params& p, char* lds, int e) {
  u16* sQx = (u16*)lds;
  u16* sKx = sQx + 64 * 136;
  u16* sQt = sKx + 64 * 136;
  u16* sVt = sQt + 64 * 136;
  float* sRef = (float*)(sVt + 128 * 72);
  float* sRed = sRef + 128;
  const int tid = tid_l(), lane = tid & 63, w = tid >> 6, l31 = lane & 31, h = lane >> 5;
  const u16* z = (const u16*)(p.ws + OFF_ZA);
  const u16* st = (const u16*)(p.ws + OFF_ST);
  u16* mix = (u16*)(p.ws + OFF_MIXE);
  const float* gn = p.in[13] + e * 128;
  for (int it = bid_l(); it < 8 * 4 * 68; it += gridDim.x) {
    const int tc = it % 68, hh = (it / 68) & 3, b = it / (68 * 4);
    const bool isl = tc < 64;
    const size_t rowbase = isl ? (size_t)b * 4096 + tc * 64 : (size_t)TL + (size_t)b * 256 + (tc - 64) * 64;
    {
#pragma unroll
      for (int j = 0; j < 4; ++j) {
        const int i = tid + 256 * j, r = i >> 4, ch = i & 15;
        *(u32x4*)(sQx + r * 136 + ch * 8) = *(const u32x4*)(z + (rowbase + r) * 2560 + 1536 + hh * 128 + ch * 8);
      }
      __syncthreads();
      const int ee = tid & 127, sh = tid >> 7;
      const int vslot = (ee & 96) + slot_of(ee & 31);
      for (int s = sh * 32; s < sh * 32 + 32; ++s) sVt[vslot * 72 + s] = sQx[s * 136 + ee];
      __syncthreads();
    }
    f32x16 o[2]; o[0] = zero16(); o[1] = zero16();
    for (int dir = 0; dir < 2; ++dir) {
      const int cs = isl ? (dir ? 4 + (63 - tc) : 4 + tc) : (dir ? 3 - (tc - 64) : (tc - 64));
      const int seq = (b * 4 + hh) * 2 + dir;
      const int d = tid & 127, part = tid >> 7;
      const float lb = hg_lb(p, e, dir, hh * 128 + d);
      const int fcol = 512 + dir * 512 + hh * 128 + d;
#pragma unroll
      for (int j = 0; j < 4; ++j) {
        const int i = tid + 256 * j, r = i >> 4, ch = i & 15;
        const u16* zr = z + (rowbase + r) * 2560 + hh * 128 + ch * 8;
        *(u32x4*)(sQx + r * 136 + ch * 8) = *(const u32x4*)(zr);
        *(u32x4*)(sKx + r * 136 + ch * 8) = *(const u32x4*)(zr + 512 + dir * 512);
      }
      __syncthreads();
      if (part == 0) {
        float x = 0.f;
        for (int pp = 31; pp >= 0; --pp) {
          const int t = dir ? 63 - pp : pp;
          const float f = lb + (1.f - lb) * sigm(bf2f(sKx[t * 136 + d]));
          const float xc = fminf(x, 80.f);
          const float q = bf2f(sQx[t * 136 + d]);
          sQx[t * 136 + d] = f2bf(q * __expf(xc));
          sKx[t * 136 + d] = f2bf((1.f - f) * __expf(-xc));
          x -= __logf(f);
        }
        sRef[d] = __expf(-x);
      } else {
        float run = 0.f;
        for (int pp = 32; pp < 64; ++pp) {
          const int t = dir ? 63 - pp : pp;
          const float f = lb + (1.f - lb) * sigm(bf2f(sKx[t * 136 + d]));
          run += __logf(f);
          const float xc = fmaxf(run, -80.f);
          const float q = bf2f(sQx[t * 136 + d]);
          sQx[t * 136 + d] = f2bf(q * __expf(xc));
          sKx[t * 136 + d] = f2bf((1.f - f) * __expf(-xc));
        }
      }
      __syncthreads();
      f32x16 at[2][2];
#pragma unroll
      for (int i = 0; i < 2; ++i)
#pragma unroll
        for (int j = 0; j < 2; ++j) at[i][j] = zero16();
#pragma unroll
      for (int kk = 0; kk < 8; ++kk) {
        bf16x8 ka[2], qb[2];
#pragma unroll
        for (int mf = 0; mf < 2; ++mf) ka[mf] = *(const bf16x8*)(sKx + (mf * 32 + l31) * 136 + kk * 16 + 8 * h);
#pragma unroll
        for (int nf = 0; nf < 2; ++nf) qb[nf] = *(const bf16x8*)(sQx + (nf * 32 + l31) * 136 + kk * 16 + 8 * h);
#pragma unroll
        for (int mf = 0; mf < 2; ++mf)
#pragma unroll
          for (int nf = 0; nf < 2; ++nf) at[mf][nf] = MFMA32(ka[mf], qb[nf], at[mf][nf]);
      }
#pragma unroll
      for (int mf = 0; mf < 2; ++mf)
#pragma unroll
        for (int nf = 0; nf < 2; ++nf)
#pragma unroll
          for (int r = 0; r < 16; ++r) {
            const int s = mf * 32 + crow(r, h), t = nf * 32 + l31;
            const bool valid = dir ? (s >= t) : (s <= t);
            at[mf][nf][r] = valid ? at[mf][nf][r] : 0.f;
          }
#pragma unroll
      for (int mf = 0; mf < 2; ++mf)
#pragma unroll
        for (int ks = 0; ks < 2; ++ks) {
          const int kb = mf * 32 + ks * 16 + 4 * h;
          const s16x4 lo = *(const s16x4*)(sVt + (32 * w + l31) * 72 + kb);
          const s16x4 hi = *(const s16x4*)(sVt + (32 * w + l31) * 72 + kb + 8);
          const bf16x8 vf = __builtin_shufflevector(lo, hi, 0, 1, 2, 3, 4, 5, 6, 7);
#pragma unroll
          for (int nf = 0; nf < 2; ++nf) o[nf] = MFMA32(vf, pack8(at[mf][nf], ks), o[nf]);
        }
      const u16* sp = st + ((size_t)(seq * 68 + cs) * 128 + 32 * w + elem_of(l31)) * 128 + 8 * h;
#pragma unroll
      for (int kk = 0; kk < 8; ++kk) {
        const u32x4 sraw = *(const u32x4*)(sp + kk * 16);
        const float4 e0 = *(const float4*)(sRef + kk * 16 + 8 * h), e1 = *(const float4*)(sRef + kk * 16 + 8 * h + 4);
        const u32x4 ssc = {pack2(bflo(sraw[0]) * e0.x, bfhi(sraw[0]) * e0.y), pack2(bflo(sraw[1]) * e0.z, bfhi(sraw[1]) * e0.w),
                           pack2(bflo(sraw[2]) * e1.x, bfhi(sraw[2]) * e1.y), pack2(bflo(sraw[3]) * e1.z, bfhi(sraw[3]) * e1.w)};
        const bf16x8 sf = __builtin_bit_cast(bf16x8, ssc);
#pragma unroll
        for (int nf = 0; nf < 2; ++nf) {
          const bf16x8 qb = *(const bf16x8*)(sQx + (nf * 32 + l31) * 136 + kk * 16 + 8 * h);
          o[nf] = MFMA32(sf, qb, o[nf]);
        }
      }
      __syncthreads();
    }
#pragma unroll
    for (int nf = 0; nf < 2; ++nf) {
      float ss = 0.f;
#pragma unroll
      for (int r = 0; r < 16; ++r) ss += o[nf][r] * o[nf][r];
      ss += __shfl_xor(ss, 32);
      if (h == 0) sRed[w * 64 + nf * 32 + l31] = ss;
    }
    __syncthreads();
#pragma unroll
    for (int nf = 0; nf < 2; ++nf) {
      const int t = nf * 32 + l31;
      const float tot = sRed[t] + sRed[64 + t] + sRed[128 + t] + sRed[192 + t];
      const float rs = rsqrtf(tot * (1.f / 128.f) + 1e-6f);
      const size_t row = rowbase + t;
#pragma unroll
      for (int gp = 0; gp < 2; ++gp) {
        const int e0 = 32 * w + 16 * h + 8 * gp;
        const u32x4 gz = *(const u32x4*)(z + row * 2560 + 2048 + hh * 128 + e0);
        const float4 na = *(const float4*)(gn + e0), nb4 = *(const float4*)(gn + e0 + 4);
        const float nv[8] = {na.x, na.y, na.z, na.w, nb4.x, nb4.y, nb4.z, nb4.w};
        float v[8];
#pragma unroll
        for (int q = 0; q < 4; ++q) {
          v[2 * q] = o[nf][8 * gp + 2 * q] * rs * nv[2 * q] * siluf(bflo(gz[q]));
          v[2 * q + 1] = o[nf][8 * gp + 2 * q + 1] * rs * nv[2 * q + 1] * siluf(bfhi(gz[q]));
        }
        *(u32x4*)(mix + row * D + hh * 128 + e0) = (u32x4){pack2(v[0], v[1]), pack2(v[2], v[3]), pack2(v[4], v[5]), pack2(v[6], v[7])};
      }
    }
    __syncthreads();
  }
}

DI void vt_tile(u16* sT, const u16* src, int ld, const float* rscale, u16* dst) {
  const int tid = tid_l();
#pragma unroll
  for (int j = 0; j < 4; ++j) {
    const int i = tid + 256 * j, r = i >> 4, ch = i & 15;
    u32x4 v = *(const u32x4*)(src + (size_t)r * ld + ch * 8);
    if (rscale) {
      const float sc = rscale[r];
      v = (u32x4){pack2(bflo(v[0]) * sc, bfhi(v[0]) * sc), pack2(bflo(v[1]) * sc, bfhi(v[1]) * sc), pack2(bflo(v[2]) * sc, bfhi(v[2]) * sc), pack2(bflo(v[3]) * sc, bfhi(v[3]) * sc)};
    }
    *(u32x4*)(sT + r * 136 + ch * 8) = v;
  }
  __syncthreads();
  {
    const int ee = tid >> 1, ph = tid & 1;
    unsigned o[16];
#pragma unroll
    for (int q = 0; q < 16; ++q) o[q] = (unsigned)sT[(ph * 32 + 2 * q) * 136 + ee] | ((unsigned)sT[(ph * 32 + 2 * q + 1) * 136 + ee] << 16);
    u32x4* dp = (u32x4*)(dst + (size_t)ee * KPOS + ph * 32);
#pragma unroll
    for (int q = 0; q < 4; ++q) dp[q] = (u32x4){o[4 * q], o[4 * q + 1], o[4 * q + 2], o[4 * q + 3]};
  }
  __syncthreads();
}

DI void ph_odd_prepA(const Params& p, char* lds) {
  const int tid = tid_l(), lane = tid & 63;
  float* tS = (float*)lds;
  float* tC = tS + 1024;
  u16* sT = (u16*)(tC + 1024);
  const u16* z = (const u16*)(p.ws + OFF_ZO);
  u16* Qa = (u16*)(p.ws + OFF_QA); u16* Qac = (u16*)(p.ws + OFF_QAC); u16* Ka = (u16*)(p.ws + OFF_KA);
  float* rsq = (float*)(p.ws + OFF_RSQ); float* rskv = (float*)(p.ws + OFF_RSKV);
  {
    const int wid = bid_l() * 4 + (tid >> 6), nw = gridDim.x * 4;
    for (int row = wid; row < TA; row += nw) {
      const u16* zr = z + (size_t)row * 1952;
      const uint2 v = *(const uint2*)(zr + 1536 + lane * 4);
      const unsigned v2 = *(const unsigned*)(zr + 1792 + lane * 2);
      const float a0 = bflo(v.x), a1 = bfhi(v.x), a2 = bflo(v.y), a3 = bfhi(v.y), c0 = bflo(v2), c1 = bfhi(v2);
      const float sq = wave_sum(a0 * a0 + a1 * a1 + a2 * a2 + a3 * a3);
      const float sk = wave_sum(c0 * c0 + c1 * c1);
      if (lane == 0) { rsq[row] = rsqrtf(sq * (1.f / 256.f) + 1e-6f); rskv[row] = rsqrtf(sk * (1.f / 128.f) + 1e-6f); }
    }
  }
  {
    u16* Vta = (u16*)(p.ws + OFF_VTA);
    for (int it = bid_l(); it < 8 * 4 * 68; it += gridDim.x) {
      const int pt = it % 68, bh = it / 68, b = bh >> 2, hh = bh & 3;
      const int pos0 = pt * 64;
      const size_t rb = pos0 < 4096 ? (size_t)b * 4096 + pos0 : (size_t)TL + (size_t)b * 256 + (pos0 - 4096);
      vt_tile(sT, z + rb * 1952 + 1024 + hh * 128, 1952, nullptr, Vta + (size_t)bh * 128 * KPOS + pos0);
    }
  }
  {
    GemmDesc g1{z + 1536, 1952, (const u16*)(p.ws + W2_DELTA + OFF_WUQ), 256, TA, 384, 256};
    gemm_phase(lds, g1, EpiStore{(u16*)(p.ws + OFF_UPQ), 384, 384});
    GemmDesc g2{z + 1792, 1952, (const u16*)(p.ws + W2_DELTA + OFF_WUKV), 128, TA, 768, 128};
    gemm_phase(lds, g2, EpiStore{(u16*)(p.ws + OFF_UPKV), 768, 768});
  }
}

DI void ph_odd_prepB(const Params& p, char* lds) {
  const int tid = tid_l();
  float* tS = (float*)lds;
  float* tC = tS + 512;
  u16* sT = (u16*)(tC + 512);
  const u16* z = (const u16*)(p.ws + OFF_ZO);
  const u16* upq = (const u16*)(p.ws + OFF_UPQ); const u16* upkv = (const u16*)(p.ws + OFF_UPKV);
  const float* rsq = (const float*)(p.ws + OFF_RSQ); const float* rskv = (const float*)(p.ws + OFF_RSKV);
  u16* Qm = (u16*)(p.ws + OFF_QM); u16* Qmc = (u16*)(p.ws + OFF_QMC); u16* Km = (u16*)(p.ws + OFF_KM); u16* Vtm = (u16*)(p.ws + OFF_VTM);
  for (int i = tid; i < 512; i += 256) {
    const float inv = exp2f(-(float)(i & 7) * (13.287712379549449f / 8.f));
    const float a = (float)(i >> 3) * inv;
    tS[i] = sinf(a); tC[i] = cosf(a);
  }
  __syncthreads();
  for (int u = bid_l() * 256 + tid; u < TA * 96; u += gridDim.x * 256) {
    const int row = u / 96, chunk = u - row * 96;
    const bool isk = chunk >= 48;
    const int c2 = isk ? chunk - 48 : chunk;
    const int hm = c2 / 12, cc = c2 - hm * 12;
    const bool isl = row < TL;
    const int b = isl ? row >> 12 : (row - TL) >> 8;
    const int t = isl ? row & 4095 : (row - TL) & 255;
    const float rsel = isk ? rskv[row] : rsq[row];
    u32x4 o;
    if (cc < 8) {
      const u32x4 v = isk ? *(const u32x4*)(upkv + (size_t)row * 768 + hm * 192 + cc * 8) : *(const u32x4*)(upq + (size_t)row * 384 + hm * 96 + cc * 8);
      const float sc = rsel;
#pragma unroll
      for (int q = 0; q < 4; ++q) o[q] = pack2(bflo(v[q]) * sc, bfhi(v[q]) * sc);
    } else {
      const int rc = cc - 8, grp = rc >> 1, second = rc & 1;
      u32x4 x1, x2; float sc;
      if (isk) { const u16* kr = z + (size_t)row * 1952 + 1920 + grp * 16; x1 = *(const u32x4*)(kr); x2 = *(const u32x4*)(kr + 8); sc = 1.f; }
      else { const u16* qr = upq + (size_t)row * 384 + hm * 96 + 64 + grp * 16; x1 = *(const u32x4*)(qr); x2 = *(const u32x4*)(qr + 8); sc = rsel; }
      if (isl) {
        const int pos = grp ? (t & 63) : (t >> 6);
        const f32x4_t spa = *(const f32x4_t*)(tS + pos * 8), spb = *(const f32x4_t*)(tS + pos * 8 + 4), cpa = *(const f32x4_t*)(tC + pos * 8), cpb = *(const f32x4_t*)(tC + pos * 8 + 4);
        const float sp[8] = {spa[0], spa[1], spa[2], spa[3], spb[0], spb[1], spb[2], spb[3]}, cp[8] = {cpa[0], cpa[1], cpa[2], cpa[3], cpb[0], cpb[1], cpb[2], cpb[3]};
#pragma unroll
        for (int q = 0; q < 4; ++q) {
          const float a0 = bflo(x1[q]) * sc, a1 = bfhi(x1[q]) * sc, b0 = bflo(x2[q]) * sc, b1 = bfhi(x2[q]) * sc;
          const float s0 = sp[2 * q], s1 = sp[2 * q + 1], c0 = cp[2 * q], c1 = cp[2 * q + 1];
          o[q] = second ? pack2(b0 * c0 + a0 * s0, b1 * c1 + a1 * s1) : pack2(a0 * c0 - b0 * s0, a1 * c1 - b1 * s1);
        }
      } else {
        const u32x4 xs = second ? x2 : x1;
#pragma unroll
        for (int q = 0; q < 4; ++q) o[q] = pack2(bflo(xs[q]) * sc, bfhi(xs[q]) * sc);
      }
    }
    u16* dst;
    if (isk) dst = Km + ((size_t)(b * 4 + hm) * KPOS + (isl ? t : 4096 + t)) * 96 + cc * 8;
    else dst = isl ? Qm + ((size_t)(b * 4 + hm) * 4096 + t) * 96 + cc * 8 : Qmc + ((size_t)(b * 4 + hm) * 256 + t) * 96 + cc * 8;
    *(u32x4*)dst = o;
  }
  for (int it = bid_l(); it < 8 * 4 * 68; it += gridDim.x) {
    const int pt = it % 68, bh = it / 68, b = bh >> 2, hm = bh & 3;
    const int pos0 = pt * 64;
    const size_t rb = pos0 < 4096 ? (size_t)b * 4096 + pos0 : (size_t)TL + (size_t)b * 256 + (pos0 - 4096);
    vt_tile(sT, upkv + rb * 768 + hm * 192 + 64, 768, rskv + rb, Vtm + (size_t)bh * 128 * KPOS + pos0);
  }
}

template <int DQ>
DI void attn_item(char* lds, const u16* __restrict__ Qb, const u16* __restrict__ Kb, const u16* __restrict__ Vtb,
                  int q0, int kt_lo, int kt_hi, float sc, u16* __restrict__ Ob, int ldo) {
  constexpr int KS = DQ + 8, KCH = DQ / 8, KPT = 64 * KCH / 256, NKK = DQ / 16;
  u16* sK = (u16*)lds;
  u16* sV = sK + 64 * KS;
  const int tid = tid_l(), lane = tid & 63, w = tid >> 6, l31 = lane & 31, h = lane >> 5;
  bf16x8 qf[NKK];
  {
    const u16* qrow = Qb + (size_t)(q0 + w * 32 + l31) * DQ + h * 8;
#pragma unroll
    for (int kk = 0; kk < NKK; ++kk) qf[kk] = *(const bf16x8*)(qrow + kk * 16);
  }
  u32x4 rk[KPT], rv[4];
#define ATT_LOAD(kt_)                                                                                   \
  {                                                                                                     \
    _Pragma("unroll") for (int j = 0; j < KPT; ++j) {                                                   \
      const int idx = tid + 256 * j; const int r = idx / KCH, cch = idx % KCH;                          \
      rk[j] = *(const u32x4*)(Kb + (size_t)((kt_) * 64 + r) * DQ + cch * 8);                            \
    }                                                                                                   \
    _Pragma("unroll") for (int j = 0; j < 4; ++j) {                                                     \
      const int idx = tid + 256 * j; const int ee = idx >> 3, cch = idx & 7;                            \
      rv[j] = *(const u32x4*)(Vtb + (size_t)ee * KPOS + (kt_) * 64 + cch * 8);                          \
    }                                                                                                   \
  }
  f32x16 o[4];
#pragma unroll
  for (int i = 0; i < 4; ++i) o[i] = zero16();
  float m_run = -INFINITY, l_run = 0.f;
  constexpr int STG = 64 * KS + 128 * 72;
#define ATT_STORE(st_)                                                                                  \
  {                                                                                                     \
    u16* dK = (u16*)lds + (st_) * STG; u16* dV = dK + 64 * KS;                                          \
    _Pragma("unroll") for (int j = 0; j < KPT; ++j) { const int idx = tid + 256 * j; const int r = idx / KCH, cch = idx % KCH; *(u32x4*)(dK + r * KS + cch * 8) = rk[j]; } \
    _Pragma("unroll") for (int j = 0; j < 4; ++j) { const int idx = tid + 256 * j; const int ee = idx >> 3, cch = idx & 7; *(u32x4*)(dV + ((ee & 96) + slot_of(ee & 31)) * 72 + cch * 8) = rv[j]; } \
  }
  ATT_LOAD(kt_lo)
  ATT_STORE(0)
  if (kt_lo + 1 < kt_hi) ATT_LOAD(kt_lo + 1)
  for (int kt = kt_lo; kt < kt_hi; ++kt) {
    __syncthreads();
    const int cur = (kt - kt_lo) & 1;
    sK = (u16*)lds + cur * STG; sV = sK + 64 * KS;
    if (kt + 1 < kt_hi) {
      ATT_STORE(cur ^ 1)
      if (kt + 2 < kt_hi) ATT_LOAD(kt + 2)
    }
    f32x16 s0 = zero16(), s1 = zero16();
#pragma unroll
    for (int kk = 0; kk < NKK; ++kk) {
      const bf16x8 k0 = *(const bf16x8*)(sK + l31 * KS + kk * 16 + h * 8);
      const bf16x8 k1 = *(const bf16x8*)(sK + (32 + l31) * KS + kk * 16 + h * 8);
      s0 = MFMA32(k0, qf[kk], s0);
      s1 = MFMA32(k1, qf[kk], s1);
    }
    float mx = fmaxf(fmaxf(s0[0], s0[1]), s0[2]);
#pragma unroll
    for (int r = 3; r < 15; r += 2) mx = fmaxf(fmaxf(mx, s0[r]), s0[r + 1]);
    mx = fmaxf(fmaxf(mx, s0[15]), s1[0]);
#pragma unroll
    for (int r = 1; r < 15; r += 2) mx = fmaxf(fmaxf(mx, s1[r]), s1[r + 1]);
    mx = fmaxf(mx, s1[15]);
    mx = fmaxf(mx, __shfl_xor(mx, 32));
    const float m_new = fmaxf(m_run, mx * sc);
    if (__builtin_amdgcn_ballot_w64(m_new > m_run) != 0ull) {
      const float alpha = __builtin_amdgcn_exp2f(m_run - m_new);
      m_run = m_new;
      l_run *= alpha;
#pragma unroll
      for (int ef = 0; ef < 4; ++ef) o[ef] = o[ef] * alpha;
    }
    s0 = s0 * sc - m_new;
    s1 = s1 * sc - m_new;
#pragma unroll
    for (int r = 0; r < 16; ++r) { s0[r] = __builtin_amdgcn_exp2f(s0[r]); s1[r] = __builtin_amdgcn_exp2f(s1[r]); }
    const f32x16 sp = s0 + s1;
    const float ps = ((sp[0] + sp[1]) + (sp[2] + sp[3])) + ((sp[4] + sp[5]) + (sp[6] + sp[7])) + ((sp[8] + sp[9]) + (sp[10] + sp[11])) + ((sp[12] + sp[13]) + (sp[14] + sp[15]));
    l_run += ps;
#pragma unroll
    for (int mf = 0; mf < 2; ++mf)
#pragma unroll
      for (int ks = 0; ks < 2; ++ks) {
        const bf16x8 pb = mf ? pack8(s1, ks) : pack8(s0, ks);
        const int kb = mf * 32 + ks * 16 + 4 * h;
#pragma unroll
        for (int ef = 0; ef < 4; ++ef) {
          const s16x4 lo = *(const s16x4*)(sV + (ef * 32 + l31) * 72 + kb);
          const s16x4 hi = *(const s16x4*)(sV + (ef * 32 + l31) * 72 + kb + 8);
          const bf16x8 vf = __builtin_shufflevector(lo, hi, 0, 1, 2, 3, 4, 5, 6, 7);
          o[ef] = MFMA32(vf, pb, o[ef]);
        }
      }
  }
#undef ATT_LOAD
#undef ATT_STORE
  const float lt = l_run + __shfl_xor(l_run, 32);
  const float inv = 1.f / lt;
  u16* orow = Ob + (size_t)(q0 + w * 32 + l31) * ldo;
#pragma unroll
  for (int ef = 0; ef < 4; ++ef)
#pragma unroll
    for (int gp = 0; gp < 2; ++gp) {
      const int e0 = ef * 32 + 16 * h + 8 * gp;
      *(u32x4*)(orow + e0) = (u32x4){pack2(o[ef][8 * gp] * inv, o[ef][8 * gp + 1] * inv), pack2(o[ef][8 * gp + 2] * inv, o[ef][8 * gp + 3] * inv),
                                     pack2(o[ef][8 * gp + 4] * inv, o[ef][8 * gp + 5] * inv), pack2(o[ef][8 * gp + 6] * inv, o[ef][8 * gp + 7] * inv)};
    }
  __syncthreads();
}

DI void ph_attn(const Params& p, char* lds, bool need_ctx) {
  char* ws = p.ws;
  u16* oa = (u16*)(ws + OFF_OA); u16* mix = (u16*)(ws + OFF_MIXO);
  const int n_lat = 8 * 12 * 32, n_all = n_lat + (need_ctx ? 8 * 12 * 2 : 0);
  const float sa = 0.125f * 1.4426950408889634f;
  const float sm = 0.10206207261596575f * 1.4426950408889634f;
  for (int it = bid_l(); it < n_all; it += gridDim.x) {
    int b, head, qb; bool isl;
    if (it < n_lat) {
      isl = true;
      int pr;
      if (gridDim.x == 512) {
        const int bid = it & 511, rnd = it >> 9, xcd = bid & 7, slot = bid >> 3;
        pr = rnd * 16 + xcd * 2 + (slot >> 5); qb = slot & 31;
      } else { qb = it & 31; pr = it >> 5; }
      head = 11 - (pr % 12); b = pr / 12;
    }
    else { isl = false; const int q = it - n_lat; qb = q & 1; const int r = q >> 1; head = 11 - (r % 12); b = r / 12; }
    const int kt_lo = isl ? 0 : 64, kt_hi = 68;
    const size_t orow0 = isl ? (size_t)b * 4096 : (size_t)TL + (size_t)b * 256;
    if (head >= 8) {
      const int hm = head - 8;
      const u16* Q = isl ? (const u16*)(ws + OFF_QM) + (size_t)(b * 4 + hm) * 4096 * 96 : (const u16*)(ws + OFF_QMC) + (size_t)(b * 4 + hm) * 256 * 96;
      const u16* K = (const u16*)(ws + OFF_KM) + (size_t)(b * 4 + hm) * KPOS * 96;
      const u16* V = (const u16*)(ws + OFF_VTM) + (size_t)(b * 4 + hm) * 128 * KPOS;
      attn_item<96>(lds, Q, K, V, qb * 128, kt_lo, kt_hi, sm, mix + orow0 * D + 512 + hm * 128, D);
    } else {
      const u16* Q = isl ? (const u16*)(ws + OFF_QA) + (size_t)(b * 8 + head) * 4096 * 64 : (const u16*)(ws + OFF_QAC) + (size_t)(b * 8 + head) * 256 * 64;
      const u16* K = (const u16*)(ws + OFF_KA) + (size_t)(b * 8 + head) * KPOS * 64;
      const u16* V = (const u16*)(ws + OFF_VTA) + (size_t)(b * 4 + (head & 3)) * 128 * KPOS;
      attn_item<64>(lds, Q, K, V, qb * 128, kt_lo, kt_hi, sa, oa + orow0 * D + head * 128, D);
    }
  }
}

DI void ph_da_readout(const Params& p, int layer, int rows) {
  const int o = layer >> 1;
  const int lane = tid_l() & 63;
  const int wid = bid_l() * 4 + (tid_l() >> 6), nw = gridDim.x * 4;
  const float* lp = p.in[26] + o * 256;
  const float lam_init = 0.8f - 0.6f * expf(-0.3f * (float)layer);
  const float d1 = wave_sum(lp[lane] * lp[64 + lane]), d2 = wave_sum(lp[128 + lane] * lp[192 + lane]);
  const float lam = expf(d1) - expf(d2) + lam_init;
  const int hh = lane >> 4, e0 = (lane & 15) * 8;
  const float* sg = p.in[27] + o * 128 + e0;
  const float4 ga = *(const float4*)(sg), gb = *(const float4*)(sg + 4);
  const float gv[8] = {ga.x, ga.y, ga.z, ga.w, gb.x, gb.y, gb.z, gb.w};
  const u16* oa = (const u16*)(p.ws + OFF_OA); u16* mix = (u16*)(p.ws + OFF_MIXO);
  const float post = 1.f - lam_init;
  for (int row = wid; row < rows; row += nw) {
    const u32x4 a = *(const u32x4*)(oa + (size_t)row * D + hh * 128 + e0);
    const u32x4 bq = *(const u32x4*)(oa + (size_t)row * D + (4 + hh) * 128 + e0);
    float x[8]; float ss = 0.f;
#pragma unroll
    for (int q = 0; q < 4; ++q) {
      x[2 * q] = bflo(a[q]) - lam * bflo(bq[q]);
      x[2 * q + 1] = bfhi(a[q]) - lam * bfhi(bq[q]);
      ss += x[2 * q] * x[2 * q] + x[2 * q + 1] * x[2 * q + 1];
    }
    ss += __shfl_xor(ss, 1); ss += __shfl_xor(ss, 2); ss += __shfl_xor(ss, 4); ss += __shfl_xor(ss, 8);
    const float rs = rsqrtf(ss * (1.f / 128.f) + 1e-6f) * post;
    *(u32x4*)(mix + (size_t)row * D + hh * 128 + e0) = (u32x4){pack2(x[0] * rs * gv[0], x[1] * rs * gv[1]), pack2(x[2] * rs * gv[2], x[3] * rs * gv[3]),
                                                              pack2(x[4] * rs * gv[4], x[5] * rs * gv[5]), pack2(x[6] * rs * gv[6], x[7] * rs * gv[7])};
  }
}

DI void ph_final(const Params& p) {
  const int lane = tid_l() & 63;
  const int wid = bid_l() * 4 + (tid_l() >> 6), nw = gridDim.x * 4;
  const float* g = p.in[32];
  float4 gq[4];
#pragma unroll
  for (int j = 0; j < 4; ++j) gq[j] = *(const float4*)(g + lane * 4 + 256 * j);
  for (int row = wid; row < TL; row += nw) {
    float* src = p.out + (size_t)row * D;
    float4 v[4]; float ss = 0.f;
#pragma unroll
    for (int j = 0; j < 4; ++j) { v[j] = *(const float4*)(src + lane * 4 + 256 * j); ss += v[j].x * v[j].x + v[j].y * v[j].y + v[j].z * v[j].z + v[j].w * v[j].w; }
    ss = wave_sum(ss);
    const float rs = rsqrtf(ss * (1.f / 1024.f) + 1e-6f);
#pragma unroll
    for (int j = 0; j < 4; ++j) {
      const float4 gg = gq[j];
      *(float4*)(src + lane * 4 + 256 * j) = make_float4(v[j].x * rs * gg.x, v[j].y * rs * gg.y, v[j].z * rs * gg.z, v[j].w * rs * gg.w);
    }
  }
}

DI void run_phase(const Params& p, char* lds, int ph) {
  char* ws = p.ws;
  if (ph == 0) { if (en(0)) {
      if (bid_l() == 0) { float* rt = (float*)(ws + OFF_ROPE);
        for (int i = tid_l(); i < 1024; i += 256) { const float inv = exp2f(-(float)(i & 15) * (13.287712379549449f / 16.f)); const float a = (float)(i >> 4) * inv; rt[i] = sinf(a); rt[1024 + i] = cosf(a); } }
      ph_ada(p, lds); ph_convert(p, lds, 0, 0); } return; }
  if (ph == NPHASES - 1) { if (en(17)) ph_final(p); return; }
  int layer, sub;
  { const int q = ph - 1;
    if (q < 11) { layer = 0; sub = q; } else if (q < 21) { layer = 1; sub = q - 11; } else if (q < 32) { layer = 2; sub = q - 21; } else { layer = 3; sub = q - 32; }
    if ((layer & 1) && sub >= 6) sub += 1; }
  const bool even = (layer & 1) == 0;
  const int e = layer >> 1;
  const bool need_ctx = layer < 3;
  const int rows = need_ctx ? TA : TL;
  const float* modl = (const float*)(ws + OFF_MOD) + (size_t)layer * 9 * 6144;
  const float* res_lat = layer == 0 ? p.in[0] : p.out;
  const float* res_ctx = layer == 0 ? p.in[2] : (const float*)(ws + OFF_HCTX);
  switch (sub) {
    case 0: if (en(1)) { ph_layer_start(p, lds, layer); if (dbl(1)) ph_layer_start(p, lds, layer); } break;
    case 1:
      if (even) { if (en(2)) { GemmDesc g{(const u16*)(ws + OFF_HN), 1024, (const u16*)(ws + wofs(layer) + OFF_WIN), 1024, TA, 4096, 1024};
        gemm_phase_t<4, 32>(lds, g, EpiSplitEven{(u16*)(ws + OFF_ZA), (u16*)(ws + OFF_ZHY)}); } }
      else { if (en(3)) { GemmDesc g{(const u16*)(ws + OFF_HN), 1024, (const u16*)(ws + wofs(layer) + OFF_WIN), 1024, TA, 2048, 1024};
        gemm_phase(lds, g, EpiOddIn{(u16*)(ws + OFF_ZO), (u16*)(ws + OFF_QA), (u16*)(ws + OFF_QAC), (u16*)(ws + OFF_KA), (const float*)(ws + OFF_ROPE)}); } }
      break;
    case 2: if (even) { if (en(4)) { ph_hy_short(p, lds, e); if (dbl(4)) ph_hy_short(p, lds, e); } } else { if (en(5)) { ph_odd_prepA(p, lds); if (dbl(5)) ph_odd_prepA(p, lds); } } break;
    case 3: if (even) { if (en(6)) { ph_hy_long(p, lds, e); if (dbl(6)) ph_hy_long(p, lds, e); } } else { if (en(7)) { ph_odd_prepB(p, lds); if (dbl(7)) ph_odd_prepB(p, lds); } } break;
    case 4: if (even) { if (en(8)) { ph_hg1(p, lds, e); if (dbl(8)) ph_hg1(p, lds, e); } } else { if (en(9)) { ph_attn(p, lds, need_ctx); if (dbl(9)) ph_attn(p, lds, need_ctx); } } break;
    case 5: if (even) { if (en(10)) ph_hg2(p); } else { if (en(11)) { ph_da_readout(p, layer, rows); if (dbl(11)) ph_da_readout(p, layer, rows); } } break;
    case 6: if (even) { if (en(12)) { ph_hg3(p, lds, e); if (dbl(12)) ph_hg3(p, lds, e); } } break;
    case 7: if (en(13)) {
      const u16* Amix = (const u16*)(ws + (even ? OFF_MIXE : OFF_MIXO));
      const EpiResid ep{res_lat, res_ctx, p.out, (float*)(ws + OFF_HCTX), modl + 2 * 1024};
      GemmDesc g{Amix, 1024, (const u16*)(ws + wofs(layer) + OFF_WOUT), 1024, TL, 1024, 1024};
      gemm_phase(lds, g, ep);
      if (need_ctx) {
        GemmDesc gc{Amix + (size_t)TL * 1024, 1024, (const u16*)(ws + wofs(layer) + OFF_WOUT), 1024, TC, 1024, 1024, TL};
        gemm_phase_t<1, 64>(lds, gc, ep);
      }
    } break;
    case 8: if (en(14)) ph_norm(p.out, (const float*)(ws + OFF_HCTX), rows, p.in[7] + layer * 1024, modl, 3, 4, (u16*)(ws + OFF_HN)); break;
    case 9: if (en(15)) {
      GemmDesc g{(const u16*)(ws + OFF_HN), 1024, (const u16*)(ws + wofs(layer) + OFF_WGU), 1024, rows, 5632, 1024};
      gemm_phase_t<4, 32>(lds, g, EpiSwiglu{(u16*)(ws + OFF_ACT)});
    } break;
    case 10: if (en(16)) {
      const EpiResid ep{p.out, (const float*)(ws + OFF_HCTX), p.out, (float*)(ws + OFF_HCTX), modl + 5 * 1024};
      GemmDesc g{(const u16*)(ws + OFF_ACT), FF, (const u16*)(ws + wofs(layer) + OFF_WDN), FF, TL, 1024, FF};
      gemm_phase(lds, g, ep);
      if (need_ctx) {
        GemmDesc gc{(const u16*)(ws + OFF_ACT) + (size_t)TL * FF, FF, (const u16*)(ws + wofs(layer) + OFF_WDN), FF, TC, 1024, FF, TL};
        gemm_phase_t<1, 64>(lds, gc, ep);
      }
      if (layer < 3) {
        const int nt = ((TC / 64) * 8) % (int)gridDim.x;
        ph_convert(p, lds, layer + 1, nt);
      }
    } break;
  }
}

__global__ void __launch_bounds__(256, 2) mega(Params p) {
  __shared__ __attribute__((aligned(16))) char lds[LDS_BYTES];
  __shared__ uint4 xb_words;
  cg::grid_group grid = cg::this_grid();
  if (threadIdx.x == 0) xb_words = make_uint4(0u, 0u, 0u, 0u);
  __syncthreads();
  const XcdBarrier xb = xcd_barrier_post((unsigned*)(p.ws + OFF_BAR), (volatile LAS unsigned*)&xb_words);
  const int ph_lo = p.ph_lo, ph_hi = p.ph_hi;
  for (int ph = ph_lo; ph < ph_hi; ++ph) {
    const __attribute__((address_space(4))) Params* pp = (const __attribute__((address_space(4))) Params*)__builtin_amdgcn_kernarg_segment_ptr();
    asm volatile("" : "+s"(pp));
    Params q;
    q.out = pp->out; q.ws = pp->ws; q.ph_lo = ph_lo; q.ph_hi = ph_hi;
#pragma unroll
    for (int i = 0; i < 33; ++i) q.in[i] = pp->in[i];
    run_phase(q, lds, ph);
    if (ph + 1 < ph_hi) { if (ph == ph_lo) grid.sync(); else xcd_barrier(xb); }
  }
}

extern "C" void kernel_launch(void* const* d_in, const int* in_sizes, int n_in, void* d_out, int out_size, void* d_ws, size_t ws_size, hipStream_t stream) {
  static int grid_blocks = 0;
  if (!grid_blocks) {
    int dev = 0, cus = 0, per_cu = 0;
    (void)hipGetDevice(&dev);
    (void)hipDeviceGetAttribute(&cus, hipDeviceAttributeMultiprocessorCount, dev);
    (void)hipOccupancyMaxActiveBlocksPerMultiprocessor(&per_cu, mega, 256, 0);
    if (per_cu < 1) per_cu = 1;
    if (per_cu > 2) per_cu = 2;
    grid_blocks = cus * per_cu;
    if (n_in != 33 || ws_size < WS_END) { fprintf(stderr, "kernel_launch: bad inputs n_in %d ws %zu need %zu\n", n_in, ws_size, (size_t)WS_END); }
  }
  (void)hipMemsetAsync((char*)d_ws + OFF_BAR, 0, 16384, stream);
  Params p{};
  for (int i = 0; i < 33; ++i) p.in[i] = (const float*)d_in[i];
  p.out = (float*)d_out; p.ws = (char*)d_ws;
#if MK_PER_PHASE
  for (int ph = 0; ph < NPHASES; ++ph) {
    p.ph_lo = ph; p.ph_hi = ph + 1;
    hipLaunchKernelGGL(mega, dim3(grid_blocks), dim3(256), 0, stream, p);
  }
#else
  p.ph_lo = 0; p.ph_hi = NPHASES;
  void* args[] = {&p};
  hipError_t e = hipLaunchCooperativeKernel((void*)mega, dim3(grid_blocks), dim3(256), args, 0, stream);
  if (e != hipSuccess) fprintf(stderr, "cooperative launch failed: %s (grid %d)\n", hipGetErrorString(e), grid_blocks);
#endif
}
```

```cpp
#include <hip/hip_runtime.h>
#include <hip/hip_cooperative_groups.h>
#include <cstdio>
#include <cstdint>
namespace cg = cooperative_groups;

#ifndef MK_PER_PHASE
#define MK_PER_PHASE 0
#endif
#ifndef DBG_ONLY
#define DBG_ONLY -1
#endif
constexpr bool en(int t) { return DBG_ONLY < 0 || DBG_ONLY == t; }
#ifndef PROBE_DBL
#define PROBE_DBL 0
#endif
constexpr bool dbl(int t) { return ((PROBE_DBL >> t) & 1) != 0; }

#define DI __device__ __forceinline__
typedef unsigned short u16;
using bf16x8 = __attribute__((ext_vector_type(8))) short;
using s16x4  = __attribute__((ext_vector_type(4))) short;
using f32x16 = __attribute__((ext_vector_type(16))) float;
using u32x4  = __attribute__((ext_vector_type(4))) unsigned;
#define MFMA32(a, b, c) __builtin_amdgcn_mfma_f32_32x32x16_bf16((a), (b), (c), 0, 0, 0)

constexpr int D = 1024, NB = 8, SEQ = 4096, CTX = 256;
constexpr int TL = NB * SEQ, TC = NB * CTX, TA = TL + TC;
constexpr int FF = 2816, KPOS = SEQ + CTX;
constexpr int LDS_BYTES = 77824;
constexpr int NPH_LAYER = 11;
constexpr int NPHASES = 1 + (11 + 10 + 11 + 10) + 1;

constexpr size_t OFF_HCTX = 0;
constexpr size_t OFF_MOD  = OFF_HCTX + (size_t)TC * D * 4;
constexpr size_t OFF_RSQ  = OFF_MOD + 4 * 9 * 6144 * 4;
constexpr size_t OFF_RSKV = OFF_RSQ + (size_t)TA * 4;
constexpr size_t OFF_PSUM = OFF_RSKV + (size_t)TA * 4;
constexpr size_t OFF_DBUF = OFF_PSUM + 272 * 1024 * 4;
constexpr size_t OFF_WIN  = OFF_DBUF + 64 * 68 * 128 * 4;
constexpr size_t OFF_WOUT = OFF_WIN + 4096 * 1024 * 2;
constexpr size_t OFF_WGU  = OFF_WOUT + 1024 * 1024 * 2;
constexpr size_t OFF_WDN  = OFF_WGU + 5632 * 1024 * 2;
constexpr size_t OFF_WUQ  = OFF_WDN + 1024 * 2816 * 2;
constexpr size_t OFF_WUKV = OFF_WUQ + 384 * 256 * 2;
constexpr size_t OFF_FR0  = OFF_WUKV + 768 * 128 * 2;
constexpr size_t OFF_FR1  = OFF_FR0 + 512 * 8192 * 2;
constexpr size_t OFF_FCTX = OFF_FR1 + 512 * 8192 * 2;
constexpr size_t OFF_ZA   = OFF_FCTX + 512 * 512 * 2;
constexpr size_t SZ_ZHG   = (size_t)TA * 2560 * 2;
constexpr size_t OFF_ZHY  = OFF_ZA + SZ_ZHG;
constexpr size_t SZ_ZA    = (size_t)TA * 4096 * 2;
constexpr size_t OFF_HN   = OFF_ZA + SZ_ZA;
constexpr size_t SZ_HN    = (size_t)TA * 1024 * 2;
constexpr size_t OFF_UT   = OFF_HN;
constexpr size_t OFF_UTC  = OFF_UT + (size_t)8 * 512 * 4096 * 2;
constexpr size_t OFF_X0T  = OFF_UTC + (size_t)8 * 512 * 256 * 2;
constexpr size_t OFF_X0TC = OFF_X0T + (size_t)8 * 512 * 4096 * 2;
constexpr size_t OFF_ST   = OFF_HN;
constexpr size_t SZ_ST    = (size_t)64 * 68 * 16384 * 2;
constexpr size_t OFF_MIXE = OFF_ZHY;
constexpr size_t OFF_YT   = OFF_ZHY + SZ_HN;
constexpr size_t OFF_YTC  = OFF_YT + (size_t)8 * 512 * 4096 * 2;
static_assert(OFF_YTC + (size_t)8 * 512 * 256 * 2 <= OFF_ZHY + (size_t)TA * 1536 * 2, "yt overflows z_hy");
constexpr size_t OFF_ZO   = OFF_ZA;
constexpr size_t OFF_UPQ  = OFF_ZA + (size_t)TA * 1952 * 2;
constexpr size_t OFF_UPKV = OFF_UPQ + (size_t)TA * 384 * 2;
constexpr size_t OFF_QA   = OFF_UPKV + (size_t)TA * 768 * 2;
constexpr size_t OFF_QAC  = OFF_QA + (size_t)8 * 8 * 4096 * 64 * 2;
constexpr size_t OFF_QM   = OFF_QAC + (size_t)8 * 8 * 256 * 64 * 2;
constexpr size_t OFF_QMC  = OFF_QM + (size_t)8 * 4 * 4096 * 96 * 2;
constexpr size_t OFF_QEND = OFF_QMC + (size_t)8 * 4 * 256 * 96 * 2;
static_assert(OFF_QEND <= OFF_HN, "odd-layer q buffers overflow region A");
constexpr size_t OFF_KA   = OFF_HN;
constexpr size_t OFF_VTA  = OFF_KA + (size_t)8 * 8 * KPOS * 64 * 2;
constexpr size_t OFF_KM   = OFF_VTA + (size_t)8 * 4 * 128 * KPOS * 2;
constexpr size_t OFF_VTM  = OFF_KM + (size_t)8 * 4 * KPOS * 96 * 2;
constexpr size_t OFF_OA   = OFF_ZA;
constexpr size_t OFF_MIXO = OFF_ZA + SZ_HN;
constexpr size_t OFF_ACT  = OFF_ZA;
constexpr size_t OFF_BAR  = OFF_HN + SZ_ST;
constexpr size_t OFF_W2   = OFF_BAR + 16384;
constexpr size_t W2_DELTA = OFF_W2 - OFF_WIN;
constexpr size_t OFF_ROPE = OFF_W2 + (OFF_ZA - OFF_WIN);
constexpr size_t WS_END   = OFF_ROPE + 2 * 1024 * 4;
static_assert(WS_END <= (size_t)536870912, "workspace too large");

struct Params {
  const float* in[33];
  float* out;
  char* ws;
  int ph_lo, ph_hi;
};

__device__ __forceinline__ size_t wofs(int layer) { return (layer & 1) ? W2_DELTA : (size_t)0; }
DI int tid_l() { int t = threadIdx.x; asm volatile("" : "+v"(t)); return t; }
DI int bid_l() { int t = blockIdx.x; asm volatile("" : "+s"(t)); return t; }
typedef __bf16 bf2_t __attribute__((ext_vector_type(2)));
typedef float f2_t __attribute__((ext_vector_type(2)));
DI unsigned pack2(float a, float b) { f2_t v = {a, b}; return __builtin_bit_cast(unsigned, __builtin_convertvector(v, bf2_t)); }
DI u16 f2bf(float x) { return (u16)(pack2(x, x) & 0xffffu); }
DI float bf2f(u16 v) { return __uint_as_float(((unsigned)v) << 16); }
DI float bflo(unsigned w) { return __uint_as_float(w << 16); }
DI float bfhi(unsigned w) { return __uint_as_float(w & 0xffff0000u); }
DI float wave_sum(float v) { for (int o = 32; o > 0; o >>= 1) v += __shfl_xor(v, o); return v; }
DI float sigm(float x) { return __builtin_amdgcn_rcpf(1.f + __expf(-x)); }
DI float siluf(float x) { return x * __builtin_amdgcn_rcpf(1.f + __expf(-x)); }
DI int crow(int r, int h) { return (r & 3) + 8 * (r >> 2) + 4 * h; }
DI int modrow(int row) { return row < TL ? (row >> 12) : 8; }
DI bf16x8 pack8(const f32x16& x, const int s) {
  u32x4 q = {pack2(x[8 * s], x[8 * s + 1]), pack2(x[8 * s + 2], x[8 * s + 3]), pack2(x[8 * s + 4], x[8 * s + 5]), pack2(x[8 * s + 6], x[8 * s + 7])};
  return __builtin_bit_cast(bf16x8, q);
}
DI int slot_of(int e32) { return ((e32 >> 2) & 3) * 8 + (e32 >> 4) * 4 + (e32 & 3); }
DI int elem_of(int slot) { return ((slot >> 2) & 1) * 16 + (slot >> 3) * 4 + (slot & 3); }
DI f32x16 zero16() { f32x16 z; for (int i = 0; i < 16; ++i) z[i] = 0.f; return z; }


#define XB_TMO      128
#define XB_XCNT(j)  (256  + 64 * (j))
#define XB_XSUB(j)  (1280 + 64 * (j))
#define XB_XGEN(j)  (2304 + 64 * (j))
#define XB_TOP      3328
#define XB_TOPGEN   3392
#define XCD_BAR_WORDS 3456
#define XB_SPIN_CAP (1u << 20)
#define LAS __attribute__((address_space(3)))
DI unsigned xb_ld(unsigned* p) { return __hip_atomic_load(p, __ATOMIC_RELAXED, __HIP_MEMORY_SCOPE_AGENT); }
DI unsigned xb_add(unsigned* p, unsigned v) { return __hip_atomic_fetch_add(p, v, __ATOMIC_RELAXED, __HIP_MEMORY_SCOPE_AGENT); }
DI unsigned xb_xcc_id() { return (unsigned)__builtin_amdgcn_s_getreg((3 << 11) | 20) & 0xFu; }
#define XB_SPIN(cond, bar) do { unsigned _sp = 0; while (cond) { __builtin_amdgcn_s_sleep(1); \
    if ((++_sp & 255u) == 0u) { if (xb_ld(&(bar)[XB_TMO])) break; if (_sp > XB_SPIN_CAP) { atomicAdd(&(bar)[XB_TMO], 1u); break; } } } } while (0)
struct XcdBarrier { unsigned* bar; unsigned x; volatile LAS unsigned* st; };
DI XcdBarrier xcd_barrier_post(unsigned* bar, volatile LAS unsigned* st) {
  XcdBarrier b; b.bar = bar; b.x = xb_xcc_id(); b.st = st;
  if (threadIdx.x == 0) (void)xb_add(&bar[XB_XCNT(b.x)], 1u);
  return b;
}
DI void xcd_barrier_complete(unsigned* bar, unsigned x, unsigned& nloc, unsigned& nx) {
  const unsigned G = gridDim.x * gridDim.y * gridDim.z;
  unsigned sum, cnt, mine, sp = 0u;
  for (;;) {
    sum = 0u; cnt = 0u; mine = 0u;
#pragma unroll
    for (unsigned j = 0; j < 16; ++j) { const unsigned c = xb_ld(&bar[XB_XCNT(j)]); sum += c; cnt += (c > 0u) ? 1u : 0u; mine = (j == x) ? c : mine; }
    if (sum == G) break;
    __builtin_amdgcn_s_sleep(1);
    if ((++sp & 255u) == 0u) { if (xb_ld(&bar[XB_TMO])) break; if (sp > XB_SPIN_CAP) { atomicAdd(&bar[XB_TMO], 1u); break; } }
  }
  nloc = mine > 0u ? mine : 1u; nx = cnt > 0u ? cnt : 1u;
}
DI void xcd_barrier(const XcdBarrier& b) {
  asm volatile("s_waitcnt vmcnt(0)" ::: "memory");
  __syncthreads();
  if (threadIdx.x == 0) {
    unsigned* bar = b.bar;
    __builtin_amdgcn_s_waitcnt(0);
    unsigned nloc = b.st[0], nx = b.st[1];
    if (nloc == 0u) { xcd_barrier_complete(bar, b.x, nloc, nx); b.st[0] = nloc; b.st[1] = nx; }
    const unsigned old = xb_add(&bar[XB_XSUB(b.x)], 1u);
    const unsigned gen = old / nloc;
    if (old + 1u == (gen + 1u) * nloc) {
      __builtin_amdgcn_fence(__ATOMIC_RELEASE, "agent");
      asm volatile("s_waitcnt vmcnt(0)" ::: "memory");
      const unsigned og = xb_add(&bar[XB_TOP], 1u);
      const unsigned tg = og / nx;
      if (og + 1u == (tg + 1u) * nx) xb_add(&bar[XB_TOPGEN], 1u);
      else XB_SPIN(xb_ld(&bar[XB_TOPGEN]) == tg, bar);
      __builtin_amdgcn_fence(__ATOMIC_ACQUIRE, "agent");
      xb_add(&bar[XB_XGEN(b.x)], 1u);
      asm volatile("s_waitcnt vmcnt(0)" ::: "memory");
    } else {
      XB_SPIN(xb_ld(&bar[XB_XGEN(b.x)]) == gen, bar);
      __builtin_amdgcn_fence(__ATOMIC_ACQUIRE, "agent");
      asm volatile("s_waitcnt vmcnt(0)" ::: "memory");
    }
  }
  __syncthreads();
}

struct GemmDesc { const u16* A; int lda; const u16* Bt; int ldb; int M; int Npad; int K; int mbase = 0; };

template <int MF, int BK, class Epi>
DI void gemm_phase_t(char* lds, const GemmDesc g, const Epi epi) {
  constexpr int BM = MF * 64, LS = BK + 8, CPR = BK / 8, RSTEP = 256 / CPR;
  constexpr int APT = BM * CPR / 256, BPT = 128 * CPR / 256, STG = (BM + 128) * LS, NKK = BK / 16;
  u16* sbase = (u16*)lds;
  const int tid = tid_l(), lane = tid & 63, w = tid >> 6, wm = w >> 1, wn = w & 1, l31 = lane & 31, h = lane >> 5;
  const int ntn = g.Npad / 128, ntm = g.M / BM, ntiles = ntm * ntn, nk = g.K / BK;
  const int lr = tid / CPR, lc = tid % CPR;
  for (int t = bid_l(); t < ntiles; t += gridDim.x) {
    const int tn = t % ntn, tm = t / ntn;
    const int m0 = tm * BM, n0 = tn * 128;
    const u16* Ap = g.A + (size_t)(m0 + lr) * g.lda + lc * 8;
    const u16* Bp = g.Bt + (size_t)(n0 + lr) * g.ldb + lc * 8;
    u32x4 ra[APT], rb[BPT];
#pragma unroll
    for (int j = 0; j < APT; ++j) ra[j] = *(const u32x4*)(Ap + (size_t)j * RSTEP * g.lda);
#pragma unroll
    for (int j = 0; j < BPT; ++j) rb[j] = *(const u32x4*)(Bp + (size_t)j * RSTEP * g.ldb);
#pragma unroll
    for (int j = 0; j < APT; ++j) *(u32x4*)(sbase + (lr + RSTEP * j) * LS + lc * 8) = ra[j];
#pragma unroll
    for (int j = 0; j < BPT; ++j) *(u32x4*)(sbase + BM * LS + (lr + RSTEP * j) * LS + lc * 8) = rb[j];
    if (nk > 1) {
#pragma unroll
      for (int j = 0; j < APT; ++j) ra[j] = *(const u32x4*)(Ap + (size_t)j * RSTEP * g.lda + BK);
#pragma unroll
      for (int j = 0; j < BPT; ++j) rb[j] = *(const u32x4*)(Bp + (size_t)j * RSTEP * g.ldb + BK);
    }
    f32x16 acc[MF][2];
#pragma unroll
    for (int i = 0; i < MF; ++i)
#pragma unroll
      for (int j = 0; j < 2; ++j) acc[i][j] = zero16();
    for (int kt = 0; kt < nk; ++kt) {
      __syncthreads();
      const u16* sA = sbase + (kt & 1) * STG;
      const u16* sB = sA + BM * LS;
      if (kt + 1 < nk) {
        u16* nA = sbase + ((kt + 1) & 1) * STG;
#pragma unroll
        for (int j = 0; j < APT; ++j) *(u32x4*)(nA + (lr + RSTEP * j) * LS + lc * 8) = ra[j];
#pragma unroll
        for (int j = 0; j < BPT; ++j) *(u32x4*)(nA + BM * LS + (lr + RSTEP * j) * LS + lc * 8) = rb[j];
        if (kt + 2 < nk) {
#pragma unroll
          for (int j = 0; j < APT; ++j) ra[j] = *(const u32x4*)(Ap + (size_t)j * RSTEP * g.lda + (kt + 2) * BK);
#pragma unroll
          for (int j = 0; j < BPT; ++j) rb[j] = *(const u32x4*)(Bp + (size_t)j * RSTEP * g.ldb + (kt + 2) * BK);
        }
      }
      bf16x8 af[NKK][MF], bfr[NKK][2];
#pragma unroll
      for (int kk = 0; kk < NKK; ++kk) {
#pragma unroll
        for (int ni = 0; ni < 2; ++ni) bfr[kk][ni] = *(const bf16x8*)(sB + (wn * 64 + ni * 32 + l31) * LS + kk * 16 + h * 8);
#pragma unroll
        for (int mi = 0; mi < MF; ++mi) af[kk][mi] = *(const bf16x8*)(sA + (wm * (MF * 32) + mi * 32 + l31) * LS + kk * 16 + h * 8);
      }
      __builtin_amdgcn_sched_barrier(0);
#pragma unroll
      for (int kk = 0; kk < NKK; ++kk)
#pragma unroll
        for (int mi = 0; mi < MF; ++mi)
#pragma unroll
          for (int ni = 0; ni < 2; ++ni) acc[mi][ni] = MFMA32(bfr[kk][ni], af[kk][mi], acc[mi][ni]);
    }
    epi(acc, g.mbase + m0 + wm * (MF * 32), n0 + wn * 64, l31, h);
  }
  __syncthreads();
}
template <class Epi>
DI void gemm_phase(char* lds, const GemmDesc g, const Epi epi) { gemm_phase_t<2, 64, Epi>(lds, g, epi); }

struct EpiStore {
  u16* C; int ldc; int N;
  template <int MF> DI void operator()(f32x16 (&acc)[MF][2], int mb, int nb, int l31, int h) const {
#pragma unroll
    for (int mi = 0; mi < MF; ++mi) {
      const int row = mb + mi * 32 + l31;
#pragma unroll
      for (int g4 = 0; g4 < 4; ++g4) {
        const int col0 = nb + 16 * g4 + 8 * h;
        if (col0 < N) *(u32x4*)(C + (size_t)row * ldc + col0) = (u32x4){pack2(acc[mi][0][4 * g4], acc[mi][0][4 * g4 + 1]), pack2(acc[mi][0][4 * g4 + 2], acc[mi][0][4 * g4 + 3]),
                                                                        pack2(acc[mi][1][4 * g4], acc[mi][1][4 * g4 + 1]), pack2(acc[mi][1][4 * g4 + 2], acc[mi][1][4 * g4 + 3])};
      }
    }
  }
};
struct EpiOddIn {
  u16* z; u16* Qa; u16* Qac; u16* Ka; const float* rope;
  template <int MF> DI void operator()(f32x16 (&acc)[MF][2], int mb, int nb, int l31, int h) const {
    if (nb >= 1024) {
#pragma unroll
      for (int mi = 0; mi < MF; ++mi) {
        const int row = mb + mi * 32 + l31;
#pragma unroll
        for (int g4 = 0; g4 < 4; ++g4) {
          const int col0 = nb + 16 * g4 + 8 * h;
          if (col0 < 1952) *(u32x4*)(z + (size_t)row * 1952 + col0) = (u32x4){pack2(acc[mi][0][4 * g4], acc[mi][0][4 * g4 + 1]), pack2(acc[mi][0][4 * g4 + 2], acc[mi][0][4 * g4 + 3]),
                                                                                pack2(acc[mi][1][4 * g4], acc[mi][1][4 * g4 + 1]), pack2(acc[mi][1][4 * g4 + 2], acc[mi][1][4 * g4 + 3])};
        }
      }
      return;
    }
    const int which = nb >> 9, head = ((nb >> 6) & 1) * 4 + ((nb >> 7) & 3);
#pragma unroll
    for (int mi = 0; mi < MF; ++mi) {
      const int row = mb + mi * 32 + l31;
      const bool isl = row < TL;
      const int b = isl ? row >> 12 : (row - TL) >> 8;
      const int t = isl ? row & 4095 : (row - TL) & 255;
      float x[4][8];
#pragma unroll
      for (int g4 = 0; g4 < 4; ++g4)
#pragma unroll
        for (int k = 0; k < 4; ++k) { x[g4][k] = acc[mi][0][4 * g4 + k]; x[g4][4 + k] = acc[mi][1][4 * g4 + k]; }
      if (isl) {
        const float* sr = rope + (t >> 6) * 16 + 8 * h; const float* sc = rope + (t & 63) * 16 + 8 * h;
        const float4 s1a = *(const float4*)(sr), s1b = *(const float4*)(sr + 4), c1a = *(const float4*)(sr + 1024), c1b = *(const float4*)(sr + 1028);
        const float4 s2a = *(const float4*)(sc), s2b = *(const float4*)(sc + 4), c2a = *(const float4*)(sc + 1024), c2b = *(const float4*)(sc + 1028);
        const float s1[8] = {s1a.x, s1a.y, s1a.z, s1a.w, s1b.x, s1b.y, s1b.z, s1b.w}, c1[8] = {c1a.x, c1a.y, c1a.z, c1a.w, c1b.x, c1b.y, c1b.z, c1b.w};
        const float s2[8] = {s2a.x, s2a.y, s2a.z, s2a.w, s2b.x, s2b.y, s2b.z, s2b.w}, c2[8] = {c2a.x, c2a.y, c2a.z, c2a.w, c2b.x, c2b.y, c2b.z, c2b.w};
#pragma unroll
        for (int k = 0; k < 8; ++k) {
          const float a = x[0][k], bq = x[1][k], cq = x[2][k], dq = x[3][k];
          x[0][k] = a * c1[k] - bq * s1[k]; x[1][k] = bq * c1[k] + a * s1[k];
          x[2][k] = cq * c2[k] - dq * s2[k]; x[3][k] = dq * c2[k] + cq * s2[k];
        }
      }
      u16* dst;
      if (which == 0) dst = isl ? Qa + ((size_t)(b * 8 + head) * 4096 + t) * 64 : Qac + ((size_t)(b * 8 + head) * 256 + t) * 64;
      else dst = Ka + ((size_t)(b * 8 + head) * KPOS + (isl ? t : 4096 + t)) * 64;
      dst += 8 * h;
#pragma unroll
      for (int g4 = 0; g4 < 4; ++g4)
        *(u32x4*)(dst + 16 * g4) = (u32x4){pack2(x[g4][0], x[g4][1]), pack2(x[g4][2], x[g4][3]), pack2(x[g4][4], x[g4][5]), pack2(x[g4][6], x[g4][7])};
    }
  }
};
struct EpiSplitEven {
  u16* zhg; u16* zhy;
  template <int MF> DI void operator()(f32x16 (&acc)[MF][2], int mb, int nb, int l31, int h) const {
#pragma unroll
    for (int mi = 0; mi < MF; ++mi) {
      const int row = mb + mi * 32 + l31;
#pragma unroll
      for (int g4 = 0; g4 < 4; ++g4) {
        const int col0 = nb + 16 * g4 + 8 * h;
        u16* dst = (col0 < 2560) ? zhg + (size_t)row * 2560 + col0 : zhy + (size_t)row * 1536 + (col0 - 2560);
        *(u32x4*)dst = (u32x4){pack2(acc[mi][0][4 * g4], acc[mi][0][4 * g4 + 1]), pack2(acc[mi][0][4 * g4 + 2], acc[mi][0][4 * g4 + 3]),
                               pack2(acc[mi][1][4 * g4], acc[mi][1][4 * g4 + 1]), pack2(acc[mi][1][4 * g4 + 2], acc[mi][1][4 * g4 + 3])};
      }
    }
  }
};
struct EpiResid {
  const float* res_lat; const float* res_ctx; float* out_lat; float* out_ctx; const float* gate;
  template <int MF> DI void operator()(f32x16 (&acc)[MF][2], int mb, int nb, int l31, int h) const {
#pragma unroll
    for (int mi = 0; mi < MF; ++mi) {
      const int row = mb + mi * 32 + l31;
      const float* gr = gate + (size_t)modrow(row) * 6144;
      const float* rp = row < TL ? res_lat + (size_t)row * D : res_ctx + (size_t)(row - TL) * D;
      float* op = row < TL ? out_lat + (size_t)row * D : out_ctx + (size_t)(row - TL) * D;
#pragma unroll
      for (int g4 = 0; g4 < 4; ++g4)
#pragma unroll
        for (int ni = 0; ni < 2; ++ni) {
          const int col0 = nb + 16 * g4 + 8 * h + 4 * ni;
          const float4 gt = *(const float4*)(gr + col0);
          const float4 rv = *(const float4*)(rp + col0);
          *(float4*)(op + col0) = make_float4(rv.x + gt.x * acc[mi][ni][4 * g4], rv.y + gt.y * acc[mi][ni][4 * g4 + 1], rv.z + gt.z * acc[mi][ni][4 * g4 + 2], rv.w + gt.w * acc[mi][ni][4 * g4 + 3]);
        }
    }
  }
};
struct EpiSwiglu {
  u16* act;
  template <int MF> DI void operator()(f32x16 (&acc)[MF][2], int mb, int nb, int l31, int h) const {
#pragma unroll
    for (int mi = 0; mi < MF; ++mi) {
      const int row = mb + mi * 32 + l31;
#pragma unroll
      for (int gp = 0; gp < 2; ++gp) {
        const int j0 = (nb >> 1) + 16 * h + 8 * gp;
        float v[8];
#pragma unroll
        for (int i = 0; i < 8; ++i) v[i] = siluf(acc[mi][0][8 * gp + i]) * acc[mi][1][8 * gp + i];
        *(u32x4*)(act + (size_t)row * FF + j0) = (u32x4){pack2(v[0], v[1]), pack2(v[2], v[3]), pack2(v[4], v[5]), pack2(v[6], v[7])};
      }
    }
  }
};

DI void ph_ada(const Params& p, char* lds) {
  float* sS = (float*)lds;
  float* sR = sS + 9 * 1024;
  const int tid = tid_l();
  const float* c = p.in[1]; const float* cc = p.in[3];
  for (int i = tid; i < 9 * 1024; i += 256) {
    const int r = i >> 10, k = i & 1023;
    const float v = r < 8 ? c[r * 1024 + k] : cc[k];
    sS[i] = v / (1.f + expf(-v));
  }
  __syncthreads();
  float* mod = (float*)(p.ws + OFF_MOD);
  for (int item = bid_l(); item < 4 * 96; item += gridDim.x) {
    const int l = item / 96, n0 = (item % 96) * 64, cq = (tid & 15) * 4, ks = tid >> 4;
    float acc[9][4];
#pragma unroll
    for (int r = 0; r < 9; ++r)
#pragma unroll
      for (int j = 0; j < 4; ++j) acc[r][j] = 0.f;
    const float* W = p.in[4] + (size_t)l * 1024 * 6144 + n0 + cq;
#pragma unroll 4
    for (int k = ks * 64; k < ks * 64 + 64; ++k) {
      const float4 wv = *(const float4*)(W + (size_t)k * 6144);
#pragma unroll
      for (int r = 0; r < 9; ++r) {
        const float sv = sS[r * 1024 + k];
        acc[r][0] += sv * wv.x; acc[r][1] += sv * wv.y; acc[r][2] += sv * wv.z; acc[r][3] += sv * wv.w;
      }
    }
#pragma unroll
    for (int r = 0; r < 9; ++r) *(float4*)(sR + (ks * 9 + r) * 64 + cq) = make_float4(acc[r][0], acc[r][1], acc[r][2], acc[r][3]);
    __syncthreads();
    for (int o = tid; o < 576; o += 256) {
      const int r = o >> 6, c2 = o & 63;
      float t = p.in[5][l * 6144 + n0 + c2];
#pragma unroll
      for (int q = 0; q < 16; ++q) t += sR[(q * 9 + r) * 64 + c2];
      mod[(size_t)(l * 9 + r) * 6144 + n0 + c2] = t;
    }
    __syncthreads();
  }
}

DI void convT_tile(char* lds, const float* src, int K, int Nsrc, u16* dst, int tk, int tn, int mode, const float* kscale) {
  float* sT = (float*)lds;
  const int tid = tid_l();
  const int k0 = tk * 64, n0 = tn * 64;
  {
    const int kk = tid >> 2, c16 = (tid & 3) * 16;
    int sc0 = n0 + c16;
    if (mode == 1) { const int blk = n0 >> 6; sc0 = (c16 < 32) ? (blk * 32 + c16) : (2816 + blk * 32 + (c16 - 32)); }
    const float ks = kscale ? kscale[k0 + kk] : 1.f;
    const bool ok = (mode == 1) || (n0 + c16 < Nsrc);
    const float* sp = src + (size_t)(k0 + kk) * Nsrc + sc0;
#pragma unroll
    for (int q = 0; q < 4; ++q) {
      float4 v = ok ? *(const float4*)(sp + q * 4) : make_float4(0.f, 0.f, 0.f, 0.f);
      sT[kk * 65 + c16 + q * 4 + 0] = v.x * ks; sT[kk * 65 + c16 + q * 4 + 1] = v.y * ks;
      sT[kk * 65 + c16 + q * 4 + 2] = v.z * ks; sT[kk * 65 + c16 + q * 4 + 3] = v.w * ks;
    }
  }
  __syncthreads();
  {
    const int n = tid >> 2, kq = (tid & 3) * 16;
    const int sg4 = (n >> 3) & 3, sh = (n >> 2) & 1, si = n & 3, sni = n >> 5;
    const int cs = (mode == 1) ? (n & 32) + 16 * sh + 4 * sg4 + si : 16 * sg4 + 8 * sh + 4 * sni + si;
    unsigned o[8];
#pragma unroll
    for (int q = 0; q < 8; ++q) o[q] = pack2(sT[(kq + 2 * q) * 65 + cs], sT[(kq + 2 * q + 1) * 65 + cs]);
    uint4* dp = (uint4*)(dst + (size_t)(n0 + n) * K + k0 + kq);
    dp[0] = make_uint4(o[0], o[1], o[2], o[3]);
    dp[1] = make_uint4(o[4], o[5], o[6], o[7]);
  }
  __syncthreads();
}

DI void filt_item(const Params& p, char* lds, int e, int idx, size_t wo) {
  float* zf = (float*)lds;
  float* h1 = zf + 16 * 33;
  float* h2 = h1 + 16 * 64;
  const int tid = tid_l();
  const bool lat = idx < 256;
  const int L = lat ? 4096 : 256;
  const int p0 = (lat ? idx : idx - 256) * 16;
  const float* w1 = p.in[16] + (size_t)e * 33 * 64; const float* b1 = p.in[17] + e * 64; const float* fr1 = p.in[18] + e * 64;
  const float* w2 = p.in[19] + (size_t)e * 64 * 64; const float* b2 = p.in[20] + e * 64; const float* fr2 = p.in[21] + e * 64;
  const float* w3 = p.in[22] + (size_t)e * 64 * 1024;
  for (int i = tid; i < 16 * 33; i += 256) {
    const int pp = i / 33, f = i % 33;
    const int pos = p0 + pp;
    const float tt = (float)pos / (float)(L - 1);
    const float wv = (6.283185307179586f * (float)pos) / (float)L;
    float v;
    if (f == 0) v = tt;
    else {
      const int j = (f - 1) & 15;
      const float band = 1e-4f + (float)j * ((15.f - 1e-4f) / 15.f);
      v = (f <= 16) ? cosf(band * wv) : -sinf(band * wv);
    }
    zf[i] = v;
  }
  __syncthreads();
  for (int i = tid; i < 1024; i += 256) {
    const int pp = i >> 6, j = i & 63;
    float s = b1[j];
#pragma unroll 3
    for (int f = 0; f < 33; ++f) s += zf[pp * 33 + f] * w1[f * 64 + j];
    h1[i] = sinf(fr1[j] * s);
  }
  __syncthreads();
  for (int i = tid; i < 1024; i += 256) {
    const int pp = i >> 6, j = i & 63;
    float s = b2[j];
#pragma unroll 4
    for (int k = 0; k < 64; ++k) s += h1[pp * 64 + k] * w2[k * 64 + j];
    h2[i] = sinf(fr2[j] * s);
  }
  __syncthreads();
  u16* R0 = (u16*)(p.ws + wo + OFF_FR0); u16* R1 = (u16*)(p.ws + wo + OFF_FR1); u16* FC = (u16*)(p.ws + wo + OFF_FCTX);
  float* psum = (float*)(p.ws + OFF_PSUM);
  const float d_lo = 4.605170185988091f / 1.5f, d_hi = 4.605170185988091f / 0.3f;
#pragma unroll 1
  for (int q = 0; q < 4; ++q) {
    const int n = tid + 256 * q;
    float acc[16];
#pragma unroll
    for (int pp = 0; pp < 16; ++pp) acc[pp] = 0.f;
#pragma unroll 2
    for (int k = 0; k < 64; ++k) {
      const float wv = w3[k * 1024 + n];
#pragma unroll
      for (int pp = 0; pp < 16; ++pp) acc[pp] += h2[pp * 64 + k] * wv;
    }
    const int ch = n & 511;
    const bool bwd = n >= 512;
    const float delta = d_lo + (float)ch * ((d_hi - d_lo) / 511.f);
    float asum = 0.f;
#pragma unroll
    for (int pp = 0; pp < 16; ++pp) {
      const int pos = p0 + pp;
      const float tt = (float)pos / (float)(L - 1);
      const float val = acc[pp] * expf(-tt * delta);
      const int lag = bwd ? -(pos + 1) : pos;
      const bool valid = !bwd || (pos <= L - 2);
      if (valid) {
        asum += fabsf(val);
        const u16 bv = f2bf(val);
        if (lat) {
          const int m = 8191 - (4096 + lag);
          R0[(size_t)ch * 8192 + m] = bv;
          if (m >= 1) R1[(size_t)ch * 8192 + m - 1] = bv;
        } else {
          FC[(size_t)ch * 512 + 256 + lag] = bv;
        }
      }
    }
    if (lat && bwd && p0 == 0) {   }
    psum[(size_t)idx * 1024 + n] = asum;
  }
  if (lat && p0 == 0) {
    for (int ch = tid; ch < 512; ch += 256) { R0[(size_t)ch * 8192 + 8191] = 0; R1[(size_t)ch * 8192 + 8191] = 0; R1[(size_t)ch * 8192 + 8190] = 0; }
  }
  if (!lat && p0 == 0) { for (int ch = tid; ch < 512; ch += 256) FC[(size_t)ch * 512] = 0; }
  __syncthreads();
}

DI void ph_norm(const float* src_lat, const float* src_ctx, int rows, const float* g, const float* modl, int i_shift, int i_scale, u16* dst) {
  const int lane = tid_l() & 63;
  const int wid = bid_l() * 4 + (tid_l() >> 6), nw = gridDim.x * 4;
  const int per = (rows + nw - 1) / nw;
  const int r0 = wid * per, r1 = (r0 + per < rows) ? r0 + per : rows;
  float gs[16], sh[16];
  int cur = -1;
  for (int row = r0; row < r1; ++row) {
    const int mrow = modrow(row);
    if (mrow != cur) {
      cur = mrow;
      const float* mr = modl + (size_t)mrow * 6144;
#pragma unroll
      for (int j = 0; j < 4; ++j) {
        const int c0 = lane * 4 + 256 * j;
        const float4 gg = *(const float4*)(g + c0);
        const float4 sc = *(const float4*)(mr + i_scale * 1024 + c0);
        const float4 s4 = *(const float4*)(mr + i_shift * 1024 + c0);
        gs[4 * j] = gg.x * (1.f + sc.x); gs[4 * j + 1] = gg.y * (1.f + sc.y); gs[4 * j + 2] = gg.z * (1.f + sc.z); gs[4 * j + 3] = gg.w * (1.f + sc.w);
        sh[4 * j] = s4.x; sh[4 * j + 1] = s4.y; sh[4 * j + 2] = s4.z; sh[4 * j + 3] = s4.w;
      }
    }
    const float* src = row < TL ? src_lat + (size_t)row * D : src_ctx + (size_t)(row - TL) * D;
    float4 v[4]; float ss = 0.f;
#pragma unroll
    for (int j = 0; j < 4; ++j) { v[j] = *(const float4*)(src + lane * 4 + 256 * j); ss += v[j].x * v[j].x + v[j].y * v[j].y + v[j].z * v[j].z + v[j].w * v[j].w; }
    ss = wave_sum(ss);
    const float rs = rsqrtf(ss * (1.f / 1024.f) + 1e-6f);
#pragma unroll
    for (int j = 0; j < 4; ++j) {
      const int c0 = lane * 4 + 256 * j;
      *(uint2*)(dst + (size_t)row * D + c0) = make_uint2(pack2(v[j].x * rs * gs[4 * j] + sh[4 * j], v[j].y * rs * gs[4 * j + 1] + sh[4 * j + 1]),
                                                         pack2(v[j].z * rs * gs[4 * j + 2] + sh[4 * j + 2], v[j].w * rs * gs[4 * j + 3] + sh[4 * j + 3]));
    }
  }
}

DI void ph_convert(const Params& p, char* lds, int layer, int b0) {
  const bool even = (layer & 1) == 0;
  const int e = layer >> 1;
  char* ws = p.ws + wofs(layer);
  const float* w_in  = even ? p.in[10] + (size_t)e * 1024 * 4096 : p.in[24] + (size_t)e * 1024 * 1952;
  const int n_in = even ? 4096 : 1952, n_in_pad = even ? 4096 : 2048;
  const float* w_out = even ? p.in[11] + (size_t)e * 1024 * 1024 : p.in[25] + (size_t)e * 1024 * 1024;
  const float* w_gu = p.in[8] + (size_t)layer * 1024 * 5632;
  const float* w_dn = p.in[9] + (size_t)layer * 2816 * 1024;
  const int s0 = 16 * (n_in_pad / 64);
  const int s1 = s0 + 16 * 16;
  const int s2 = s1 + 16 * 88;
  const int s3 = s2 + 44 * 16;
  const int s4 = s3 + (even ? 0 : 4 * 6);
  const int s5 = s4 + (even ? 0 : 2 * 12);
  const int s6 = s5 + (even ? 272 : 0);
  const int bid = bid_l();
  if (bid < b0) return;
  for (int it0 = bid - b0; it0 < s6; it0 += (int)gridDim.x - b0) {
    const int it = (it0 < s6 - s5) ? s5 + it0 : it0 - (s6 - s5);
    if (it >= s5) { filt_item(p, lds, e, it - s5, wofs(layer)); continue; }
    const float* src; int K, Nsrc, ntn, q, mode = 0; u16* dst; const float* ksc = nullptr;
    if (it < s0) { src = w_in; K = 1024; Nsrc = n_in; ntn = n_in_pad / 64; q = it; dst = (u16*)(ws + OFF_WIN); }
    else if (it < s1) { src = w_out; K = 1024; Nsrc = 1024; ntn = 16; q = it - s0; dst = (u16*)(ws + OFF_WOUT); }
    else if (it < s2) { src = w_gu; K = 1024; Nsrc = 5632; ntn = 88; q = it - s1; dst = (u16*)(ws + OFF_WGU); mode = 1; }
    else if (it < s3) { src = w_dn; K = 2816; Nsrc = 1024; ntn = 16; q = it - s2; dst = (u16*)(ws + OFF_WDN); }
    else if (it < s4) { src = p.in[29] + (size_t)e * 256 * 384; K = 256; Nsrc = 384; ntn = 6; q = it - s3; dst = (u16*)(ws + OFF_WUQ); ksc = p.in[28] + e * 256; }
    else { src = p.in[31] + (size_t)e * 128 * 768; K = 128; Nsrc = 768; ntn = 12; q = it - s4; dst = (u16*)(ws + OFF_WUKV); ksc = p.in[30] + e * 128; }
    convT_tile(lds, src, K, Nsrc, dst, q / ntn, q % ntn, mode, ksc);
  }
}
DI void ph_layer_start(const Params& p, char* lds, int layer) {
  char* ws = p.ws;
  const float* hl = layer == 0 ? p.in[0] : p.out;
  const float* hc = layer == 0 ? p.in[2] : (const float*)(ws + OFF_HCTX);
  ph_norm(hl, hc, TA, p.in[6] + layer * 1024, (const float*)(ws + OFF_MOD) + (size_t)layer * 9 * 6144, 0, 1, (u16*)(ws + OFF_HN));
}

DI void ph_hy_short(const Params& p, char* lds, int e) {
  u16* sU = (u16*)lds; u16* sX = sU + 64 * 72;
  const int tid = tid_l();
  const u16* zhy = (const u16*)(p.ws + OFF_ZHY);
  const float* sw = p.in[14] + (size_t)e * 3 * 1536; const float* sb = p.in[15] + e * 1536;
  const int cc = bid_l() & 7, rank = bid_l() >> 3, nbc = ((int)gridDim.x + 7 - cc) >> 3;
  float wa[3][8], wb[3][8], wc[3][8], bb[3][8];
#pragma unroll
  for (int sct = 0; sct < 3; ++sct) {
    const int col = sct * 512 + cc * 64 + (tid & 7) * 8;
#pragma unroll
    for (int q = 0; q < 2; ++q) {
      const float4 a = *(const float4*)(sw + col + 4 * q), b2 = *(const float4*)(sw + 1536 + col + 4 * q), c2 = *(const float4*)(sw + 3072 + col + 4 * q), d2 = *(const float4*)(sb + col + 4 * q);
      wa[sct][4 * q] = a.x; wa[sct][4 * q + 1] = a.y; wa[sct][4 * q + 2] = a.z; wa[sct][4 * q + 3] = a.w;
      wb[sct][4 * q] = b2.x; wb[sct][4 * q + 1] = b2.y; wb[sct][4 * q + 2] = b2.z; wb[sct][4 * q + 3] = b2.w;
      wc[sct][4 * q] = c2.x; wc[sct][4 * q + 1] = c2.y; wc[sct][4 * q + 2] = c2.z; wc[sct][4 * q + 3] = c2.w;
      bb[sct][4 * q] = d2.x; bb[sct][4 * q + 1] = d2.y; bb[sct][4 * q + 2] = d2.z; bb[sct][4 * q + 3] = d2.w;
    }
  }
  for (int jp = rank; jp < 512 + 32; jp += nbc) {
    int b, tt, L; size_t rowbase; u16 *ud, *xd;
    if (jp < 512) { b = jp >> 6; tt = jp & 63; L = 4096; rowbase = (size_t)b * 4096;
      ud = (u16*)(p.ws + OFF_UT) + (size_t)b * 512 * 4096; xd = (u16*)(p.ws + OFF_X0T) + (size_t)b * 512 * 4096; }
    else { const int q = jp - 512; b = q >> 2; tt = q & 3; L = 256; rowbase = (size_t)TL + (size_t)b * 256;
      ud = (u16*)(p.ws + OFF_UTC) + (size_t)b * 512 * 256; xd = (u16*)(p.ws + OFF_X0TC) + (size_t)b * 512 * 256; }
    {
      const int cg = tid & 7, tp = tid >> 3;
      const int ch0 = cc * 64 + cg * 8;
      const int t0 = tt * 64 + tp * 2;
      float zc[3][2][8];
#pragma unroll
      for (int sct = 0; sct < 3; ++sct) {
        const int col = sct * 512 + ch0;
        u32x4 zv[4];
#pragma unroll
        for (int k = 0; k < 4; ++k) {
          const int t = t0 - 1 + k;
          zv[k] = (t >= 0 && t < L) ? *(const u32x4*)(zhy + (rowbase + t) * 1536 + col) : (u32x4){0u, 0u, 0u, 0u};
        }
#pragma unroll
        for (int k = 0; k < 2; ++k)
#pragma unroll
          for (int i = 0; i < 8; ++i) {
            const float pv = (i & 1) ? bfhi(zv[k][i >> 1]) : bflo(zv[k][i >> 1]);
            const float cv = (i & 1) ? bfhi(zv[k + 1][i >> 1]) : bflo(zv[k + 1][i >> 1]);
            const float nv = (i & 1) ? bfhi(zv[k + 2][i >> 1]) : bflo(zv[k + 2][i >> 1]);
            zc[sct][k][i] = pv * wa[sct][i] + cv * wb[sct][i] + nv * wc[sct][i] + bb[sct][i];
          }
      }
#pragma unroll
      for (int k = 0; k < 2; ++k)
#pragma unroll
        for (int i = 0; i < 8; ++i) {
          sU[(cg * 8 + i) * 72 + tp * 2 + k] = f2bf(zc[1][k][i] * zc[2][k][i]);
          sX[(cg * 8 + i) * 72 + tp * 2 + k] = f2bf(zc[0][k][i]);
        }
    }
    __syncthreads();
    {
      const int cr = tid >> 2, tq2 = (tid & 3) * 16;
      const size_t o = (size_t)(cc * 64 + cr) * L + tt * 64 + tq2;
      const uint4* su = (const uint4*)(sU + cr * 72 + tq2); const uint4* sx = (const uint4*)(sX + cr * 72 + tq2);
      uint4* du = (uint4*)(ud + o); uint4* dx = (uint4*)(xd + o);
      du[0] = su[0]; du[1] = su[1]; dx[0] = sx[0]; dx[1] = sx[1];
    }
    __syncthreads();
  }
}

DI void ph_hy_long(const Params& p, char* lds, int e) {
  constexpr int UR = 5128;
  u16* sUu = (u16*)lds;
  u16* sF0 = sUu + 4 * UR;
  u16* sF1 = sF0 + 8224;
  float* sRed = (float*)(sF1 + 8200);
  const int tid = tid_l(), lane = tid & 63, w = tid >> 6, l31 = lane & 31, h = lane >> 5;
  const float* psum = (const float*)(p.ws + OFF_PSUM);
  const float* skip = p.in[23] + e * 512;
  {
    unsigned z0 = 0u;
    asm volatile("" : "+v"(z0));
    const u32x4 zz = {z0, z0, z0, z0};
    for (int i = tid; i < 4 * 129; i += 256) {
      const int b = i / 129, q = i % 129;
      const int off = q < 64 ? q * 8 : 512 + 4096 + (q - 64) * 8;
      *(u32x4*)(sUu + b * UR + off) = zz;
    }
  }
  __syncthreads();
  for (int it = bid_l(); it < 1024; it += gridDim.x) {
    const int c = it >> 1, bh = it & 1;
    {
      float v = psum[(size_t)tid * 1024 + c] + psum[(size_t)tid * 1024 + 512 + c];
      v = wave_sum(v);
      if (lane == 0) sRed[w] = v;
    }
    {
      const u16* ut = (const u16*)(p.ws + OFF_UT);
      for (int i = tid; i < 4 * 512; i += 256) {
        const int b = i >> 9, q = i & 511;
        *(u32x4*)(sUu + b * UR + 512 + q * 8) = *(const u32x4*)(ut + ((size_t)(bh * 4 + b) * 512 + c) * 4096 + q * 8);
      }
      const u16* R0 = (const u16*)(p.ws + OFF_FR0) + (size_t)c * 8192; const u16* R1 = (const u16*)(p.ws + OFF_FR1) + (size_t)c * 8192;
      for (int i = tid; i < 1024; i += 256) { *(u32x4*)(sF0 + i * 8) = *(const u32x4*)(R0 + i * 8); *(u32x4*)(sF1 + i * 8) = *(const u32x4*)(R1 + i * 8); }
    }
    __syncthreads();
    const float inv = 1.f / (sRed[0] + sRed[1] + sRed[2] + sRed[3]);
    f32x16 acc[2][2];
#pragma unroll
    for (int i = 0; i < 2; ++i)
#pragma unroll
      for (int j = 0; j < 2; ++j) acc[i][j] = zero16();
    const int ci = elem_of(l31);
    const int par = (4095 - ci) & 1;
    const u16* fl = (par ? sF1 : sF0) + (4095 - ci + 8 * h - par);
    const int Tl = l31 >> 2, bl = l31 & 3;
    const u16* ub = sUu + bl * UR + 512 + 64 * Tl + 8 * h;
    const int wsc = __builtin_amdgcn_readfirstlane(w);
#define HY_BODY(V0_, V1_)                                                                                      \
    {                                                                                                          \
      const u16* fd = fl - 64 * dl;                                                                            \
      const u16* u0 = ub + 64 * (16 * wsc - dl);                                                               \
      _Pragma("unroll") for (int kk = 0; kk < 4; ++kk) {                                                       \
        bf16x8 af[2];                                                                                          \
        _Pragma("unroll") for (int mi = 0; mi < 2; ++mi) {                                                     \
          const unsigned* fp = (const unsigned*)(fd - 32 * mi + 16 * kk);                                      \
          u32x4 q = {fp[0], fp[1], fp[2], fp[3]};                                                              \
          af[mi] = __builtin_bit_cast(bf16x8, q);                                                              \
        }                                                                                                      \
        if (V0_) { const bf16x8 bb = *(const bf16x8*)(u0 + kk * 16);       acc[0][0] = MFMA32(af[0], bb, acc[0][0]); acc[1][0] = MFMA32(af[1], bb, acc[1][0]); } \
        if (V1_) { const bf16x8 bb = *(const bf16x8*)(u0 + 512 + kk * 16); acc[0][1] = MFMA32(af[0], bb, acc[0][1]); acc[1][1] = MFMA32(af[1], bb, acc[1][1]); } \
      }                                                                                                        \
    }
    {
      const int a0 = 16 * wsc - 63 < -63 ? -63 : 16 * wsc - 63, a1 = 16 * wsc - 56;
      for (int dl = a0; dl <= a1; ++dl) HY_BODY(true, false)
      const int b0 = 16 * wsc - 55 < -63 ? -63 : 16 * wsc - 55, b1 = 16 * wsc + 7;
      for (int dl = b0; dl <= b1; ++dl) HY_BODY(true, true)
      const int c0 = 16 * wsc + 8, c1 = 16 * wsc + 15 > 63 ? 63 : 16 * wsc + 15;
      for (int dl = c0; dl <= c1; ++dl) HY_BODY(false, true)
    }
#undef HY_BODY
    int Tl_e = Tl, h_e = h;
    asm volatile("" : "+v"(Tl_e), "+v"(h_e));
    const float sk = skip[c];
    const int b = bh * 4 + bl;
    const u16* x0t = (const u16*)(p.ws + OFF_X0T) + ((size_t)b * 512 + c) * 4096;
    u16* ytp = (u16*)(p.ws + OFF_YT) + ((size_t)b * 512 + c) * 4096;
#pragma unroll
    for (int mi = 0; mi < 2; ++mi)
#pragma unroll
      for (int nf = 0; nf < 2; ++nf) {
        const int T = 16 * w + 8 * nf + Tl_e;
        asm volatile("" ::: "memory");
#pragma unroll
        for (int gp = 0; gp < 2; ++gp) {
          const int t = 64 * T + mi * 32 + 16 * h_e + 8 * gp;
          const u32x4 uu = *(const u32x4*)(sUu + bl * UR + 512 + t);
          const u32x4 xx = *(const u32x4*)(x0t + t);
          float y[8];
#pragma unroll
          for (int q = 0; q < 4; ++q) {
            y[2 * q] = bflo(xx[q]) * (acc[mi][nf][8 * gp + 2 * q] * inv + sk * bflo(uu[q]));
            y[2 * q + 1] = bfhi(xx[q]) * (acc[mi][nf][8 * gp + 2 * q + 1] * inv + sk * bfhi(uu[q]));
          }
          *(u32x4*)(ytp + t) = (u32x4){pack2(y[0], y[1]), pack2(y[2], y[3]), pack2(y[4], y[5]), pack2(y[6], y[7])};
        }
      }
    __syncthreads();
  }
  {
    const u16* FC = (const u16*)(p.ws + OFF_FCTX);
    const u16* utc = (const u16*)(p.ws + OFF_UTC); const u16* x0c = (const u16*)(p.ws + OFF_X0TC); u16* ytc = (u16*)(p.ws + OFF_YTC);
    const int total = 8 * 512 * 32;
    for (int i = bid_l() * 256 + tid; i < total; i += gridDim.x * 256) {
      const int tb = i & 31, c = (i >> 5) & 511, b = i >> 14;
      float nrm = 0.f;
#pragma unroll 4
      for (int q = 256; q < 272; ++q) nrm += psum[(size_t)q * 1024 + c] + psum[(size_t)q * 1024 + 512 + c];
      const u16* uu = utc + ((size_t)b * 512 + c) * 256;
      const u16* ff = FC + (size_t)c * 512;
      float y[8];
#pragma unroll
      for (int k = 0; k < 8; ++k) y[k] = 0.f;
      u32x4 hi = *(const u32x4*)(ff + (32 + tb) * 8);
      for (int sb = 0; sb < 32; ++sb) {
        const u32x4 lo = *(const u32x4*)(ff + (31 + tb - sb) * 8);
        const u32x4 uv = *(const u32x4*)(uu + sb * 8);
        float f[16], u8[8];
#pragma unroll
        for (int q = 0; q < 4; ++q) { f[2 * q] = bflo(lo[q]); f[2 * q + 1] = bfhi(lo[q]); f[8 + 2 * q] = bflo(hi[q]); f[9 + 2 * q] = bfhi(hi[q]); u8[2 * q] = bflo(uv[q]); u8[2 * q + 1] = bfhi(uv[q]); }
#pragma unroll
        for (int k = 0; k < 8; ++k)
#pragma unroll
          for (int j = 0; j < 8; ++j) y[k] += f[8 + k - j] * u8[j];
        hi = lo;
      }
      const float inv = 1.f / nrm, sk = skip[c];
      const u32x4 ut = *(const u32x4*)(uu + tb * 8);
      const u32x4 xv = *(const u32x4*)(x0c + ((size_t)b * 512 + c) * 256 + tb * 8);
      float o[8];
#pragma unroll
      for (int q = 0; q < 4; ++q) {
        o[2 * q] = bflo(xv[q]) * (y[2 * q] * inv + sk * bflo(ut[q]));
        o[2 * q + 1] = bfhi(xv[q]) * (y[2 * q + 1] * inv + sk * bfhi(ut[q]));
      }
      *(u32x4*)(ytc + ((size_t)b * 512 + c) * 256 + tb * 8) = (u32x4){pack2(o[0], o[1]), pack2(o[2], o[3]), pack2(o[4], o[5]), pack2(o[6], o[7])};
    }
  }
}

DI float hg_lb(const Params& p, int e, int dir, int j) {
  if (e == 0) return 0.f;
  const float a0 = p.in[12][(0 * 2 + dir) * 512 + j], a1 = p.in[12][(1 * 2 + dir) * 512 + j];
  return 1.f / (1.f + expf(a0 - a1));
}
DI size_t hg_row(int b, int dir, int c, int s) {
  if (c < 4) { const int pp = 64 * c + s; return (size_t)TL + (size_t)b * 256 + (dir ? 255 - pp : pp); }
  const int pp = 64 * (c - 4) + s; return (size_t)b * 4096 + (dir ? 4095 - pp : pp);
}

DI void ph_hg1(const Params& p, char* lds, int e) {
  u16* sKe = (u16*)lds;
  u16* sVt = sKe + 128 * 72;
  u16* sF = sVt + 128 * 72;
  u16* sV = sF + 64 * 136;
  const int tid = tid_l(), lane = tid & 63, w = tid >> 6, l31 = lane & 31, h = lane >> 5;
  const u16* z = (const u16*)(p.ws + OFF_ZA);
  u16* st = (u16*)(p.ws + OFF_ST); float* dbuf = (float*)(p.ws + OFF_DBUF);
  {
    u16* sT = (u16*)lds;
    u16* mix = (u16*)(p.ws + OFF_MIXE);
    const int nlat = 8 * 64 * 8, nall = nlat + 8 * 4 * 8;
    for (int it = bid_l(); it < nall; it += gridDim.x) {
      int b, tt, cc, L; size_t rowbase; const u16* src;
      if (it < nlat) { b = it >> 9; tt = (it >> 3) & 63; cc = it & 7; L = 4096; rowbase = (size_t)b * 4096; src = (const u16*)(p.ws + OFF_YT) + (size_t)b * 512 * 4096; }
      else { const int q = it - nlat; b = q >> 5; tt = (q >> 3) & 3; cc = q & 7; L = 256; rowbase = (size_t)TL + (size_t)b * 256; src = (const u16*)(p.ws + OFF_YTC) + (size_t)b * 512 * 256; }
      {
        const int cr = tid >> 2, tq = (tid & 3) * 16;
        const u32x4* sp = (const u32x4*)(src + (size_t)(cc * 64 + cr) * L + tt * 64 + tq);
        *(u32x4*)(sT + cr * 72 + tq) = sp[0];
        *(u32x4*)(sT + cr * 72 + tq + 8) = sp[1];
      }
      __syncthreads();
      {
        const int t = tid >> 2, cq = (tid & 3) * 16;
        unsigned o[8];
#pragma unroll
        for (int q = 0; q < 8; ++q) o[q] = (unsigned)sT[(cq + 2 * q) * 72 + t] | ((unsigned)sT[(cq + 2 * q + 1) * 72 + t] << 16);
        u32x4* dp = (u32x4*)(mix + (rowbase + tt * 64 + t) * D + 512 + cc * 64 + cq);
        dp[0] = (u32x4){o[0], o[1], o[2], o[3]};
        dp[1] = (u32x4){o[4], o[5], o[6], o[7]};
      }
      __syncthreads();
    }
  }
  for (int it = bid_l(); it < 64 * 68; it += gridDim.x) {
    const int seq = it / 68, c = it % 68;
    const int dir = seq & 1, hh = (seq >> 1) & 3, b = seq >> 3;
#pragma unroll
    for (int j = 0; j < 4; ++j) {
      const int i = tid + 256 * j, r = i >> 4, ch = i & 15;
      const u16* zr = z + hg_row(b, dir, c, r) * 2560 + hh * 128 + ch * 8;
      *(u32x4*)(sF + r * 136 + ch * 8) = *(const u32x4*)(zr + 512 + dir * 512);
      *(u32x4*)(sV + r * 136 + ch * 8) = *(const u32x4*)(zr + 1536);
    }
    __syncthreads();
    if (tid < 128) {
      const int d = tid;
      const int dc = d & 63, dslot = (d & 64) + ((dc >> 2) & 1) * 32 + (dc >> 4) * 8 + ((dc >> 3) & 1) * 4 + (dc & 3);
      const float lb = hg_lb(p, e, dir, hh * 128 + d);
      float P = 1.f;
      for (int s = 63; s >= 0; --s) {
        const float zf = bf2f(sF[s * 136 + d]);
        const float f = lb + (1.f - lb) * sigm(zf);
        sKe[dslot * 72 + s] = f2bf((1.f - f) * P);
        P *= f;
      }
      dbuf[(size_t)(seq * 68 + c) * 128 + d] = P;
    } else {
      const int ee = tid - 128;
      for (int s = 0; s < 64; ++s) sVt[ee * 72 + s] = sV[s * 136 + ee];
    }
    __syncthreads();
    f32x16 acc[4];
#pragma unroll
    for (int i = 0; i < 4; ++i) acc[i] = zero16();
#pragma unroll
    for (int kk = 0; kk < 4; ++kk) {
      const bf16x8 af = *(const bf16x8*)(sVt + (32 * w + l31) * 72 + kk * 16 + 8 * h);
#pragma unroll
      for (int nf = 0; nf < 4; ++nf) {
        const bf16x8 bb = *(const bf16x8*)(sKe + (nf * 32 + l31) * 72 + kk * 16 + 8 * h);
        acc[nf] = MFMA32(bb, af, acc[nf]);
      }
    }
    u16* dst = st + (size_t)(seq * 68 + c) * 16384 + (32 * w + l31) * 128;
#pragma unroll
    for (int grp = 0; grp < 2; ++grp)
#pragma unroll
      for (int g4 = 0; g4 < 4; ++g4)
        *(u32x4*)(dst + grp * 64 + 16 * g4 + 8 * h) = (u32x4){pack2(acc[2 * grp][4 * g4], acc[2 * grp][4 * g4 + 1]), pack2(acc[2 * grp][4 * g4 + 2], acc[2 * grp][4 * g4 + 3]),
                                                              pack2(acc[2 * grp + 1][4 * g4], acc[2 * grp + 1][4 * g4 + 1]), pack2(acc[2 * grp + 1][4 * g4 + 2], acc[2 * grp + 1][4 * g4 + 3])};
    __syncthreads();
  }
}

DI void ph_hg2(const Params& p) {
  u16* st = (u16*)(p.ws + OFF_ST); const float* dbuf = (const float*)(p.ws + OFF_DBUF);
  for (int i = bid_l() * 256 + tid_l(); i < 64 * 128 * 16; i += gridDim.x * 256) {
    const int dg = i & 15, ee = (i >> 4) & 127, seq = i >> 11;
    float S[8];
#pragma unroll
    for (int j = 0; j < 8; ++j) S[j] = 0.f;
    u32x4* base = (u32x4*)(st + ((size_t)(seq * 68) * 128 + ee) * 128 + dg * 8);
    const float* dp = dbuf + (size_t)(seq * 68) * 128 + dg * 8;
    u32x4 l0 = base[0], l1 = base[2048], l2 = base[2 * 2048];
    for (int c = 0; c < 68; ++c) {
      u32x4 l3 = l2;
      if (c + 3 < 68) l3 = base[(size_t)(c + 3) * 2048];
      const float4 d0 = *(const float4*)(dp + c * 128);
      const float4 d1 = *(const float4*)(dp + c * 128 + 4);
      base[(size_t)c * 2048] = (u32x4){pack2(S[0], S[1]), pack2(S[2], S[3]), pack2(S[4], S[5]), pack2(S[6], S[7])};
      const float dd[8] = {d0.x, d0.y, d0.z, d0.w, d1.x, d1.y, d1.z, d1.w};
#pragma unroll
      for (int j = 0; j < 8; ++j) {
        const unsigned wv = l0[j >> 1];
        const float L = __uint_as_float((j & 1) ? (wv & 0xffff0000u) : (wv << 16));
        S[j] = dd[j] * S[j] + L;
      }
      l0 = l1; l1 = l2; l2 = l3;
    }
  }
}

DI void ph_hg3(const Params& p, char* lds, int e) {
  u16* sQx = (u16*)lds;
  u16* sKx = sQx + 64 * 136;
  u16* sQt = sKx + 64 * 136;
  u16* sVt = sQt + 64 * 136;
  float* sRef = (float*)(sVt + 128 * 72);
  float* sRed = sRef + 128;
  const int tid = tid_l(), lane = tid & 63, w = tid >> 6, l31 = lane & 31, h = lane >> 5;
  const u16* z = (const u16*)(p.ws + OFF_ZA);
  const u16* st = (const u16*)(p.ws + OFF_ST);
  u16* mix = (u16*)(p.ws + OFF_MIXE);
  const float* gn = p.in[13] + e * 128;
  for (int it = bid_l(); it < 8 * 4 * 68; it += gridDim.x) {
    const int tc = it % 68, hh = (it / 68) & 3, b = it / (68 * 4);
    const bool isl = tc < 64;
    const size_t rowbase = isl ? (size_t)b * 4096 + tc * 64 : (size_t)TL + (size_t)b * 256 + (tc - 64) * 64;
    {
#pragma unroll
      for (int j = 0; j < 4; ++j) {
        const int i = tid + 256 * j, r = i >> 4, ch = i & 15;
        *(u32x4*)(sQx + r * 136 + ch * 8) = *(const u32x4*)(z + (rowbase + r) * 2560 + 1536 + hh * 128 + ch * 8);
      }
      __syncthreads();
      const int ee = tid & 127, sh = tid >> 7;
      const int vslot = (ee & 96) + slot_of(ee & 31);
      for (int s = sh * 32; s < sh * 32 + 32; ++s) sVt[vslot * 72 + s] = sQx[s * 136 + ee];
      __syncthreads();
    }
    f32x16 o[2]; o[0] = zero16(); o[1] = zero16();
    for (int dir = 0; dir < 2; ++dir) {
      const int cs = isl ? (dir ? 4 + (63 - tc) : 4 + tc) : (dir ? 3 - (tc - 64) : (tc - 64));
      const int seq = (b * 4 + hh) * 2 + dir;
      const int d = tid & 127, part = tid >> 7;
      const float lb = hg_lb(p, e, dir, hh * 128 + d);
      const int fcol = 512 + dir * 512 + hh * 128 + d;
#pragma unroll
      for (int j = 0; j < 4; ++j) {
        const int i = tid + 256 * j, r = i >> 4, ch = i & 15;
        const u16* zr = z + (rowbase + r) * 2560 + hh * 128 + ch * 8;
        *(u32x4*)(sQx + r * 136 + ch * 8) = *(const u32x4*)(zr);
        *(u32x4*)(sKx + r * 136 + ch * 8) = *(const u32x4*)(zr + 512 + dir * 512);
      }
      __syncthreads();
      if (part == 0) {
        float x = 0.f;
        for (int pp = 31; pp >= 0; --pp) {
          const int t = dir ? 63 - pp : pp;
          const float f = lb + (1.f - lb) * sigm(bf2f(sKx[t * 136 + d]));
          const float xc = fminf(x, 80.f);
          const float q = bf2f(sQx[t * 136 + d]);
          sQx[t * 136 + d] = f2bf(q * __expf(xc));
          sKx[t * 136 + d] = f2bf((1.f - f) * __expf(-xc));
          x -= __logf(f);
        }
        sRef[d] = __expf(-x);
      } else {
        float run = 0.f;
        for (int pp = 32; pp < 64; ++pp) {
          const int t = dir ? 63 - pp : pp;
          const float f = lb + (1.f - lb) * sigm(bf2f(sKx[t * 136 + d]));
          run += __logf(f);
          const float xc = fmaxf(run, -80.f);
          const float q = bf2f(sQx[t * 136 + d]);
          sQx[t * 136 + d] = f2bf(q * __expf(xc));
          sKx[t * 136 + d] = f2bf((1.f - f) * __expf(-xc));
        }
      }
      __syncthreads();
      f32x16 at[2][2];
#pragma unroll
      for (int i = 0; i < 2; ++i)
#pragma unroll
        for (int j = 0; j < 2; ++j) at[i][j] = zero16();
#pragma unroll
      for (int kk = 0; kk < 8; ++kk) {
        bf16x8 ka[2], qb[2];
#pragma unroll
        for (int mf = 0; mf < 2; ++mf) ka[mf] = *(const bf16x8*)(sKx + (mf * 32 + l31) * 136 + kk * 16 + 8 * h);
#pragma unroll
        for (int nf = 0; nf < 2; ++nf) qb[nf] = *(const bf16x8*)(sQx + (nf * 32 + l31) * 136 + kk * 16 + 8 * h);
#pragma unroll
        for (int mf = 0; mf < 2; ++mf)
#pragma unroll
          for (int nf = 0; nf < 2; ++nf) at[mf][nf] = MFMA32(ka[mf], qb[nf], at[mf][nf]);
      }
#pragma unroll
      for (int mf = 0; mf < 2; ++mf)
#pragma unroll
        for (int nf = 0; nf < 2; ++nf)
#pragma unroll
          for (int r = 0; r < 16; ++r) {
            const int s = mf * 32 + crow(r, h), t = nf * 32 + l31;
            const bool valid = dir ? (s >= t) : (s <= t);
            at[mf][nf][r] = valid ? at[mf][nf][r] : 0.f;
          }
#pragma unroll
      for (int mf = 0; mf < 2; ++mf)
#pragma unroll
        for (int ks = 0; ks < 2; ++ks) {
          const int kb = mf * 32 + ks * 16 + 4 * h;
          const s16x4 lo = *(const s16x4*)(sVt + (32 * w + l31) * 72 + kb);
          const s16x4 hi = *(const s16x4*)(sVt + (32 * w + l31) * 72 + kb + 8);
          const bf16x8 vf = __builtin_shufflevector(lo, hi, 0, 1, 2, 3, 4, 5, 6, 7);
#pragma unroll
          for (int nf = 0; nf < 2; ++nf) o[nf] = MFMA32(vf, pack8(at[mf][nf], ks), o[nf]);
        }
      const u16* sp = st + ((size_t)(seq * 68 + cs) * 128 + 32 * w + elem_of(l31)) * 128 + 8 * h;
#pragma unroll
      for (int kk = 0; kk < 8; ++kk) {
        const u32x4 sraw = *(const u32x4*)(sp + kk * 16);
        const float4 e0 = *(const float4*)(sRef + kk * 16 + 8 * h), e1 = *(const float4*)(sRef + kk * 16 + 8 * h + 4);
        const u32x4 ssc = {pack2(bflo(sraw[0]) * e0.x, bfhi(sraw[0]) * e0.y), pack2(bflo(sraw[1]) * e0.z, bfhi(sraw[1]) * e0.w),
                           pack2(bflo(sraw[2]) * e1.x, bfhi(sraw[2]) * e1.y), pack2(bflo(sraw[3]) * e1.z, bfhi(sraw[3]) * e1.w)};
        const bf16x8 sf = __builtin_bit_cast(bf16x8, ssc);
#pragma unroll
        for (int nf = 0; nf < 2; ++nf) {
          const bf16x8 qb = *(const bf16x8*)(sQx + (nf * 32 + l31) * 136 + kk * 16 + 8 * h);
          o[nf] = MFMA32(sf, qb, o[nf]);
        }
      }
      __syncthreads();
    }
#pragma unroll
    for (int nf = 0; nf < 2; ++nf) {
      float ss = 0.f;
#pragma unroll
      for (int r = 0; r < 16; ++r) ss += o[nf][r] * o[nf][r];
      ss += __shfl_xor(ss, 32);
      if (h == 0) sRed[w * 64 + nf * 32 + l31] = ss;
    }
    __syncthreads();
#pragma unroll
    for (int nf = 0; nf < 2; ++nf) {
      const int t = nf * 32 + l31;
      const float tot = sRed[t] + sRed[64 + t] + sRed[128 + t] + sRed[192 + t];
      const float rs = rsqrtf(tot * (1.f / 128.f) + 1e-6f);
      const size_t row = rowbase + t;
#pragma unroll
      for (int gp = 0; gp < 2; ++gp) {
        const int e0 = 32 * w + 16 * h + 8 * gp;
        const u32x4 gz = *(const u32x4*)(z + row * 2560 + 2048 + hh * 128 + e0);
        const float4 na = *(const float4*)(gn + e0), nb4 = *(const float4*)(gn + e0 + 4);
        const float nv[8] = {na.x, na.y, na.z, na.w, nb4.x, nb4.y, nb4.z, nb4.w};
        float v[8];
#pragma unroll
        for (int q = 0; q < 4; ++q) {
          v[2 * q] = o[nf][8 * gp + 2 * q] * rs * nv[2 * q] * siluf(bflo(gz[q]));
          v[2 * q + 1] = o[nf][8 * gp + 2 * q + 1] * rs * nv[2 * q + 1] * siluf(bfhi(gz[q]));
        }
        *(u32x4*)(mix + row * D + hh * 128 + e0) = (u32x4){pack2(v[0], v[1]), pack2(v[2], v[3]), pack2(v[4], v[5]), pack2(v[6], v[7])};
      }
    }
    __syncthreads();
  }
}

DI void vt_tile(u16* sT, const u16* src, int ld, const float* rscale, u16* dst) {
  const int tid = tid_l();
#pragma unroll
  for (int j = 0; j < 4; ++j) {
    const int i = tid + 256 * j, r = i >> 4, ch = i & 15;
    u32x4 v = *(const u32x4*)(src + (size_t)r * ld + ch * 8);
    if (rscale) {
      const float sc = rscale[r];
      v = (u32x4){pack2(bflo(v[0]) * sc, bfhi(v[0]) * sc), pack2(bflo(v[1]) * sc, bfhi(v[1]) * sc), pack2(bflo(v[2]) * sc, bfhi(v[2]) * sc), pack2(bflo(v[3]) * sc, bfhi(v[3]) * sc)};
    }
    *(u32x4*)(sT + r * 136 + ch * 8) = v;
  }
  __syncthreads();
  {
    const int ee = tid >> 1, ph = tid & 1;
    unsigned o[16];
#pragma unroll
    for (int q = 0; q < 16; ++q) o[q] = (unsigned)sT[(ph * 32 + 2 * q) * 136 + ee] | ((unsigned)sT[(ph * 32 + 2 * q + 1) * 136 + ee] << 16);
    u32x4* dp = (u32x4*)(dst + (size_t)ee * KPOS + ph * 32);
#pragma unroll
    for (int q = 0; q < 4; ++q) dp[q] = (u32x4){o[4 * q], o[4 * q + 1], o[4 * q + 2], o[4 * q + 3]};
  }
  __syncthreads();
}

DI void ph_odd_prepA(const Params& p, char* lds) {
  const int tid = tid_l(), lane = tid & 63;
  float* tS = (float*)lds;
  float* tC = tS + 1024;
  u16* sT = (u16*)(tC + 1024);
  const u16* z = (const u16*)(p.ws + OFF_ZO);
  u16* Qa = (u16*)(p.ws + OFF_QA); u16* Qac = (u16*)(p.ws + OFF_QAC); u16* Ka = (u16*)(p.ws + OFF_KA);
  float* rsq = (float*)(p.ws + OFF_RSQ); float* rskv = (float*)(p.ws + OFF_RSKV);
  {
    const int wid = bid_l() * 4 + (tid >> 6), nw = gridDim.x * 4;
    for (int row = wid; row < TA; row += nw) {
      const u16* zr = z + (size_t)row * 1952;
      const uint2 v = *(const uint2*)(zr + 1536 + lane * 4);
      const unsigned v2 = *(const unsigned*)(zr + 1792 + lane * 2);
      const float a0 = bflo(v.x), a1 = bfhi(v.x), a2 = bflo(v.y), a3 = bfhi(v.y), c0 = bflo(v2), c1 = bfhi(v2);
      const float sq = wave_sum(a0 * a0 + a1 * a1 + a2 * a2 + a3 * a3);
      const float sk = wave_sum(c0 * c0 + c1 * c1);
      if (lane == 0) { rsq[row] = rsqrtf(sq * (1.f / 256.f) + 1e-6f); rskv[row] = rsqrtf(sk * (1.f / 128.f) + 1e-6f); }
    }
  }
  {
    u16* Vta = (u16*)(p.ws + OFF_VTA);
    for (int it = bid_l(); it < 8 * 4 * 68; it += gridDim.x) {
      const int pt = it % 68, bh = it / 68, b = bh >> 2, hh = bh & 3;
      const int pos0 = pt * 64;
      const size_t rb = pos0 < 4096 ? (size_t)b * 4096 + pos0 : (size_t)TL + (size_t)b * 256 + (pos0 - 4096);
      vt_tile(sT, z + rb * 1952 + 1024 + hh * 128, 1952, nullptr, Vta + (size_t)bh * 128 * KPOS + pos0);
    }
  }
  {
    GemmDesc g1{z + 1536, 1952, (const u16*)(p.ws + W2_DELTA + OFF_WUQ), 256, TA, 384, 256};
    gemm_phase(lds, g1, EpiStore{(u16*)(p.ws + OFF_UPQ), 384, 384});
    GemmDesc g2{z + 1792, 1952, (const u16*)(p.ws + W2_DELTA + OFF_WUKV), 128, TA, 768, 128};
    gemm_phase(lds, g2, EpiStore{(u16*)(p.ws + OFF_UPKV), 768, 768});
  }
}

DI void ph_odd_prepB(const Params& p, char* lds) {
  const int tid = tid_l();
  float* tS = (float*)lds;
  float* tC = tS + 512;
  u16* sT = (u16*)(tC + 512);
  const u16* z = (const u16*)(p.ws + OFF_ZO);
  const u16* upq = (const u16*)(p.ws + OFF_UPQ); const u16* upkv = (const u16*)(p.ws + OFF_UPKV);
  const float* rsq = (const float*)(p.ws + OFF_RSQ); const float* rskv = (const float*)(p.ws + OFF_RSKV);
  u16* Qm = (u16*)(p.ws + OFF_QM); u16* Qmc = (u16*)(p.ws + OFF_QMC); u16* Km = (u16*)(p.ws + OFF_KM); u16* Vtm = (u16*)(p.ws + OFF_VTM);
  for (int i = tid; i < 512; i += 256) {
    const float inv = exp2f(-(float)(i & 7) * (13.287712379549449f / 8.f));
    const float a = (float)(i >> 3) * inv;
    tS[i] = sinf(a); tC[i] = cosf(a);
  }
  __syncthreads();
  for (int u = bid_l() * 256 + tid; u < TA * 96; u += gridDim.x * 256) {
    const int row = u / 96, chunk = u - row * 96;
    const bool isk = chunk >= 48;
    const int c2 = isk ? chunk - 48 : chunk;
    const int hm = c2 / 12, cc = c2 - hm * 12;
    const bool isl = row < TL;
    const int b = isl ? row >> 12 : (row - TL) >> 8;
    const int t = isl ? row & 4095 : (row - TL) & 255;
    const float rq = rsq[row], rk = rskv[row];
    u32x4 o;
    if (cc < 8) {
      const u32x4 v = isk ? *(const u32x4*)(upkv + (size_t)row * 768 + hm * 192 + cc * 8) : *(const u32x4*)(upq + (size_t)row * 384 + hm * 96 + cc * 8);
      const float sc = isk ? rk : rq;
#pragma unroll
      for (int q = 0; q < 4; ++q) o[q] = pack2(bflo(v[q]) * sc, bfhi(v[q]) * sc);
    } else {
      const int rc = cc - 8, grp = rc >> 1, second = rc & 1;
      u32x4 x1, x2; float sc;
      if (isk) { const u16* kr = z + (size_t)row * 1952 + 1920 + grp * 16; x1 = *(const u32x4*)(kr); x2 = *(const u32x4*)(kr + 8); sc = 1.f; }
      else { const u16* qr = upq + (size_t)row * 384 + hm * 96 + 64 + grp * 16; x1 = *(const u32x4*)(qr); x2 = *(const u32x4*)(qr + 8); sc = rq; }
      if (isl) {
        const int pos = grp ? (t & 63) : (t >> 6);
        const float* sp = tS + pos * 8; const float* cp = tC + pos * 8;
#pragma unroll
        for (int q = 0; q < 4; ++q) {
          const float a0 = bflo(x1[q]) * sc, a1 = bfhi(x1[q]) * sc, b0 = bflo(x2[q]) * sc, b1 = bfhi(x2[q]) * sc;
          const float s0 = sp[2 * q], s1 = sp[2 * q + 1], c0 = cp[2 * q], c1 = cp[2 * q + 1];
          o[q] = second ? pack2(b0 * c0 + a0 * s0, b1 * c1 + a1 * s1) : pack2(a0 * c0 - b0 * s0, a1 * c1 - b1 * s1);
        }
      } else {
        const u32x4 xs = second ? x2 : x1;
#pragma unroll
        for (int q = 0; q < 4; ++q) o[q] = pack2(bflo(xs[q]) * sc, bfhi(xs[q]) * sc);
      }
    }
    u16* dst;
    if (isk) dst = Km + ((size_t)(b * 4 + hm) * KPOS + (isl ? t : 4096 + t)) * 96 + cc * 8;
    else dst = isl ? Qm + ((size_t)(b * 4 + hm) * 4096 + t) * 96 + cc * 8 : Qmc + ((size_t)(b * 4 + hm) * 256 + t) * 96 + cc * 8;
    *(u32x4*)dst = o;
  }
  for (int it = bid_l(); it < 8 * 4 * 68; it += gridDim.x) {
    const int pt = it % 68, bh = it / 68, b = bh >> 2, hm = bh & 3;
    const int pos0 = pt * 64;
    const size_t rb = pos0 < 4096 ? (size_t)b * 4096 + pos0 : (size_t)TL + (size_t)b * 256 + (pos0 - 4096);
    vt_tile(sT, upkv + rb * 768 + hm * 192 + 64, 768, rskv + rb, Vtm + (size_t)bh * 128 * KPOS + pos0);
  }
}

template <int DQ>
DI void attn_item(char* lds, const u16* __restrict__ Qb, const u16* __restrict__ Kb, const u16* __restrict__ Vtb,
                  int q0, int kt_lo, int kt_hi, float sc, u16* __restrict__ Ob, int ldo) {
  constexpr int KS = DQ + 8, KCH = DQ / 8, KPT = 64 * KCH / 256, NKK = DQ / 16;
  u16* sK = (u16*)lds;
  u16* sV = sK + 64 * KS;
  const int tid = tid_l(), lane = tid & 63, w = tid >> 6, l31 = lane & 31, h = lane >> 5;
  bf16x8 qf[NKK];
  {
    const u16* qrow = Qb + (size_t)(q0 + w * 32 + l31) * DQ + h * 8;
#pragma unroll
    for (int kk = 0; kk < NKK; ++kk) qf[kk] = *(const bf16x8*)(qrow + kk * 16);
  }
  u32x4 rk[KPT], rv[4];
#define ATT_LOAD(kt_)                                                                                   \
  {                                                                                                     \
    _Pragma("unroll") for (int j = 0; j < KPT; ++j) {                                                   \
      const int idx = tid + 256 * j; const int r = idx / KCH, cch = idx % KCH;                          \
      rk[j] = *(const u32x4*)(Kb + (size_t)((kt_) * 64 + r) * DQ + cch * 8);                            \
    }                                                                                                   \
    _Pragma("unroll") for (int j = 0; j < 4; ++j) {                                                     \
      const int idx = tid + 256 * j; const int ee = idx >> 3, cch = idx & 7;                            \
      rv[j] = *(const u32x4*)(Vtb + (size_t)ee * KPOS + (kt_) * 64 + cch * 8);                          \
    }                                                                                                   \
  }
  f32x16 o[4];
#pragma unroll
  for (int i = 0; i < 4; ++i) o[i] = zero16();
  float m_run = -INFINITY, l_run = 0.f;
  constexpr int STG = 64 * KS + 128 * 72;
#define ATT_STORE(st_)                                                                                  \
  {                                                                                                     \
    u16* dK = (u16*)lds + (st_) * STG; u16* dV = dK + 64 * KS;                                          \
    _Pragma("unroll") for (int j = 0; j < KPT; ++j) { const int idx = tid + 256 * j; const int r = idx / KCH, cch = idx % KCH; *(u32x4*)(dK + r * KS + cch * 8) = rk[j]; } \
    _Pragma("unroll") for (int j = 0; j < 4; ++j) { const int idx = tid + 256 * j; const int ee = idx >> 3, cch = idx & 7; *(u32x4*)(dV + ((ee & 96) + slot_of(ee & 31)) * 72 + cch * 8) = rv[j]; } \
  }
  ATT_LOAD(kt_lo)
  ATT_STORE(0)
  if (kt_lo + 1 < kt_hi) ATT_LOAD(kt_lo + 1)
  for (int kt = kt_lo; kt < kt_hi; ++kt) {
    __syncthreads();
    const int cur = (kt - kt_lo) & 1;
    sK = (u16*)lds + cur * STG; sV = sK + 64 * KS;
    if (kt + 1 < kt_hi) {
      ATT_STORE(cur ^ 1)
      if (kt + 2 < kt_hi) ATT_LOAD(kt + 2)
    }
    f32x16 s0 = zero16(), s1 = zero16();
#pragma unroll
    for (int kk = 0; kk < NKK; ++kk) {
      const bf16x8 k0 = *(const bf16x8*)(sK + l31 * KS + kk * 16 + h * 8);
      const bf16x8 k1 = *(const bf16x8*)(sK + (32 + l31) * KS + kk * 16 + h * 8);
      s0 = MFMA32(k0, qf[kk], s0);
      s1 = MFMA32(k1, qf[kk], s1);
    }
    float mx = fmaxf(fmaxf(s0[0], s0[1]), s0[2]);
#pragma unroll
    for (int r = 3; r < 15; r += 2) mx = fmaxf(fmaxf(mx, s0[r]), s0[r + 1]);
    mx = fmaxf(fmaxf(mx, s0[15]), s1[0]);
#pragma unroll
    for (int r = 1; r < 15; r += 2) mx = fmaxf(fmaxf(mx, s1[r]), s1[r + 1]);
    mx = fmaxf(mx, s1[15]);
    mx = fmaxf(mx, __shfl_xor(mx, 32));
    const float m_new = fmaxf(m_run, mx * sc);
    if (__builtin_amdgcn_ballot_w64(m_new > m_run) != 0ull) {
      const float alpha = __builtin_amdgcn_exp2f(m_run - m_new);
      m_run = m_new;
      l_run *= alpha;
#pragma unroll
      for (int ef = 0; ef < 4; ++ef) o[ef] = o[ef] * alpha;
    }
    s0 = s0 * sc - m_new;
    s1 = s1 * sc - m_new;
#pragma unroll
    for (int r = 0; r < 16; ++r) { s0[r] = __builtin_amdgcn_exp2f(s0[r]); s1[r] = __builtin_amdgcn_exp2f(s1[r]); }
    const f32x16 sp = s0 + s1;
    const float ps = ((sp[0] + sp[1]) + (sp[2] + sp[3])) + ((sp[4] + sp[5]) + (sp[6] + sp[7])) + ((sp[8] + sp[9]) + (sp[10] + sp[11])) + ((sp[12] + sp[13]) + (sp[14] + sp[15]));
    l_run += ps;
#pragma unroll
    for (int mf = 0; mf < 2; ++mf)
#pragma unroll
      for (int ks = 0; ks < 2; ++ks) {
        const bf16x8 pb = mf ? pack8(s1, ks) : pack8(s0, ks);
        const int kb = mf * 32 + ks * 16 + 4 * h;
#pragma unroll
        for (int ef = 0; ef < 4; ++ef) {
          const s16x4 lo = *(const s16x4*)(sV + (ef * 32 + l31) * 72 + kb);
          const s16x4 hi = *(const s16x4*)(sV + (ef * 32 + l31) * 72 + kb + 8);
          const bf16x8 vf = __builtin_shufflevector(lo, hi, 0, 1, 2, 3, 4, 5, 6, 7);
          o[ef] = MFMA32(vf, pb, o[ef]);
        }
      }
  }
#undef ATT_LOAD
#undef ATT_STORE
  const float lt = l_run + __shfl_xor(l_run, 32);
  const float inv = 1.f / lt;
  u16* orow = Ob + (size_t)(q0 + w * 32 + l31) * ldo;
#pragma unroll
  for (int ef = 0; ef < 4; ++ef)
#pragma unroll
    for (int gp = 0; gp < 2; ++gp) {
      const int e0 = ef * 32 + 16 * h + 8 * gp;
      *(u32x4*)(orow + e0) = (u32x4){pack2(o[ef][8 * gp] * inv, o[ef][8 * gp + 1] * inv), pack2(o[ef][8 * gp + 2] * inv, o[ef][8 * gp + 3] * inv),
                                     pack2(o[ef][8 * gp + 4] * inv, o[ef][8 * gp + 5] * inv), pack2(o[ef][8 * gp + 6] * inv, o[ef][8 * gp + 7] * inv)};
    }
  __syncthreads();
}

DI void ph_attn(const Params& p, char* lds, bool need_ctx) {
  char* ws = p.ws;
  u16* oa = (u16*)(ws + OFF_OA); u16* mix = (u16*)(ws + OFF_MIXO);
  const int n_lat = 8 * 12 * 32, n_all = n_lat + (need_ctx ? 8 * 12 * 2 : 0);
  const float sa = 0.125f * 1.4426950408889634f;
  const float sm = 0.10206207261596575f * 1.4426950408889634f;
  for (int it = bid_l(); it < n_all; it += gridDim.x) {
    int b, head, qb; bool isl;
    if (it < n_lat) {
      isl = true;
      int pr;
      if (gridDim.x == 512) {
        const int bid = it & 511, rnd = it >> 9, xcd = bid & 7, slot = bid >> 3;
        pr = rnd * 16 + xcd * 2 + (slot >> 5); qb = slot & 31;
      } else { qb = it & 31; pr = it >> 5; }
      head = 11 - (pr % 12); b = pr / 12;
    }
    else { isl = false; const int q = it - n_lat; qb = q & 1; const int r = q >> 1; head = 11 - (r % 12); b = r / 12; }
    const int kt_lo = isl ? 0 : 64, kt_hi = 68;
    const size_t orow0 = isl ? (size_t)b * 4096 : (size_t)TL + (size_t)b * 256;
    if (head >= 8) {
      const int hm = head - 8;
      const u16* Q = isl ? (const u16*)(ws + OFF_QM) + (size_t)(b * 4 + hm) * 4096 * 96 : (const u16*)(ws + OFF_QMC) + (size_t)(b * 4 + hm) * 256 * 96;
      const u16* K = (const u16*)(ws + OFF_KM) + (size_t)(b * 4 + hm) * KPOS * 96;
      const u16* V = (const u16*)(ws + OFF_VTM) + (size_t)(b * 4 + hm) * 128 * KPOS;
      attn_item<96>(lds, Q, K, V, qb * 128, kt_lo, kt_hi, sm, mix + orow0 * D + 512 + hm * 128, D);
    } else {
      const u16* Q = isl ? (const u16*)(ws + OFF_QA) + (size_t)(b * 8 + head) * 4096 * 64 : (const u16*)(ws + OFF_QAC) + (size_t)(b * 8 + head) * 256 * 64;
      const u16* K = (const u16*)(ws + OFF_KA) + (size_t)(b * 8 + head) * KPOS * 64;
      const u16* V = (const u16*)(ws + OFF_VTA) + (size_t)(b * 4 + (head & 3)) * 128 * KPOS;
      attn_item<64>(lds, Q, K, V, qb * 128, kt_lo, kt_hi, sa, oa + orow0 * D + head * 128, D);
    }
  }
}

DI void ph_da_readout(const Params& p, int layer, int rows) {
  const int o = layer >> 1;
  const int lane = tid_l() & 63;
  const int wid = bid_l() * 4 + (tid_l() >> 6), nw = gridDim.x * 4;
  const float* lp = p.in[26] + o * 256;
  const float lam_init = 0.8f - 0.6f * expf(-0.3f * (float)layer);
  const float d1 = wave_sum(lp[lane] * lp[64 + lane]), d2 = wave_sum(lp[128 + lane] * lp[192 + lane]);
  const float lam = expf(d1) - expf(d2) + lam_init;
  const int hh = lane >> 4, e0 = (lane & 15) * 8;
  const float* sg = p.in[27] + o * 128 + e0;
  const float4 ga = *(const float4*)(sg), gb = *(const float4*)(sg + 4);
  const float gv[8] = {ga.x, ga.y, ga.z, ga.w, gb.x, gb.y, gb.z, gb.w};
  const u16* oa = (const u16*)(p.ws + OFF_OA); u16* mix = (u16*)(p.ws + OFF_MIXO);
  const float post = 1.f - lam_init;
  for (int row = wid; row < rows; row += nw) {
    const u32x4 a = *(const u32x4*)(oa + (size_t)row * D + hh * 128 + e0);
    const u32x4 bq = *(const u32x4*)(oa + (size_t)row * D + (4 + hh) * 128 + e0);
    float x[8]; float ss = 0.f;
#pragma unroll
    for (int q = 0; q < 4; ++q) {
      x[2 * q] = bflo(a[q]) - lam * bflo(bq[q]);
      x[2 * q + 1] = bfhi(a[q]) - lam * bfhi(bq[q]);
      ss += x[2 * q] * x[2 * q] + x[2 * q + 1] * x[2 * q + 1];
    }
    ss += __shfl_xor(ss, 1); ss += __shfl_xor(ss, 2); ss += __shfl_xor(ss, 4); ss += __shfl_xor(ss, 8);
    const float rs = rsqrtf(ss * (1.f / 128.f) + 1e-6f) * post;
    *(u32x4*)(mix + (size_t)row * D + hh * 128 + e0) = (u32x4){pack2(x[0] * rs * gv[0], x[1] * rs * gv[1]), pack2(x[2] * rs * gv[2], x[3] * rs * gv[3]),
                                                              pack2(x[4] * rs * gv[4], x[5] * rs * gv[5]), pack2(x[6] * rs * gv[6], x[7] * rs * gv[7])};
  }
}

DI void ph_final(const Params& p) {
  const int lane = tid_l() & 63;
  const int wid = bid_l() * 4 + (tid_l() >> 6), nw = gridDim.x * 4;
  const float* g = p.in[32];
  float4 gq[4];
#pragma unroll
  for (int j = 0; j < 4; ++j) gq[j] = *(const float4*)(g + lane * 4 + 256 * j);
  for (int row = wid; row < TL; row += nw) {
    float* src = p.out + (size_t)row * D;
    float4 v[4]; float ss = 0.f;
#pragma unroll
    for (int j = 0; j < 4; ++j) { v[j] = *(const float4*)(src + lane * 4 + 256 * j); ss += v[j].x * v[j].x + v[j].y * v[j].y + v[j].z * v[j].z + v[j].w * v[j].w; }
    ss = wave_sum(ss);
    const float rs = rsqrtf(ss * (1.f / 1024.f) + 1e-6f);
#pragma unroll
    for (int j = 0; j < 4; ++j) {
      const float4 gg = gq[j];
      *(float4*)(src + lane * 4 + 256 * j) = make_float4(v[j].x * rs * gg.x, v[j].y * rs * gg.y, v[j].z * rs * gg.z, v[j].w * rs * gg.w);
    }
  }
}

DI void run_phase(const Params& p, char* lds, int ph) {
  char* ws = p.ws;
  if (ph == 0) { if (en(0)) {
      if (bid_l() == 0) { float* rt = (float*)(ws + OFF_ROPE);
        for (int i = tid_l(); i < 1024; i += 256) { const float inv = exp2f(-(float)(i & 15) * (13.287712379549449f / 16.f)); const float a = (float)(i >> 4) * inv; rt[i] = sinf(a); rt[1024 + i] = cosf(a); } }
      ph_ada(p, lds); ph_convert(p, lds, 0, 0); } return; }
  if (ph == NPHASES - 1) { if (en(17)) ph_final(p); return; }
  int layer, sub;
  { const int q = ph - 1;
    if (q < 11) { layer = 0; sub = q; } else if (q < 21) { layer = 1; sub = q - 11; } else if (q < 32) { layer = 2; sub = q - 21; } else { layer = 3; sub = q - 32; }
    if ((layer & 1) && sub >= 6) sub += 1; }
  const bool even = (layer & 1) == 0;
  const int e = layer >> 1;
  const bool need_ctx = layer < 3;
  const int rows = need_ctx ? TA : TL;
  const float* modl = (const float*)(ws + OFF_MOD) + (size_t)layer * 9 * 6144;
  const float* res_lat = layer == 0 ? p.in[0] : p.out;
  const float* res_ctx = layer == 0 ? p.in[2] : (const float*)(ws + OFF_HCTX);
  switch (sub) {
    case 0: if (en(1)) { ph_layer_start(p, lds, layer); if (dbl(1)) ph_layer_start(p, lds, layer); } break;
    case 1:
      if (even) { if (en(2)) { GemmDesc g{(const u16*)(ws + OFF_HN), 1024, (const u16*)(ws + wofs(layer) + OFF_WIN), 1024, TA, 4096, 1024};
        gemm_phase_t<4, 32>(lds, g, EpiSplitEven{(u16*)(ws + OFF_ZA), (u16*)(ws + OFF_ZHY)}); } }
      else { if (en(3)) { GemmDesc g{(const u16*)(ws + OFF_HN), 1024, (const u16*)(ws + wofs(layer) + OFF_WIN), 1024, TA, 2048, 1024};
        gemm_phase(lds, g, EpiOddIn{(u16*)(ws + OFF_ZO), (u16*)(ws + OFF_QA), (u16*)(ws + OFF_QAC), (u16*)(ws + OFF_KA), (const float*)(ws + OFF_ROPE)}); } }
      break;
    case 2: if (even) { if (en(4)) { ph_hy_short(p, lds, e); if (dbl(4)) ph_hy_short(p, lds, e); } } else { if (en(5)) { ph_odd_prepA(p, lds); if (dbl(5)) ph_odd_prepA(p, lds); } } break;
    case 3: if (even) { if (en(6)) { ph_hy_long(p, lds, e); if (dbl(6)) ph_hy_long(p, lds, e); } } else { if (en(7)) { ph_odd_prepB(p, lds); if (dbl(7)) ph_odd_prepB(p, lds); } } break;
    case 4: if (even) { if (en(8)) { ph_hg1(p, lds, e); if (dbl(8)) ph_hg1(p, lds, e); } } else { if (en(9)) { ph_attn(p, lds, need_ctx); if (dbl(9)) ph_attn(p, lds, need_ctx); } } break;
    case 5: if (even) { if (en(10)) ph_hg2(p); } else { if (en(11)) { ph_da_readout(p, layer, rows); if (dbl(11)) ph_da_readout(p, layer, rows); } } break;
    case 6: if (even) { if (en(12)) { ph_hg3(p, lds, e); if (dbl(12)) ph_hg3(p, lds, e); } } break;
    case 7: if (en(13)) {
      const u16* Amix = (const u16*)(ws + (even ? OFF_MIXE : OFF_MIXO));
      const EpiResid ep{res_lat, res_ctx, p.out, (float*)(ws + OFF_HCTX), modl + 2 * 1024};
      GemmDesc g{Amix, 1024, (const u16*)(ws + wofs(layer) + OFF_WOUT), 1024, TL, 1024, 1024};
      gemm_phase(lds, g, ep);
      if (need_ctx) {
        GemmDesc gc{Amix + (size_t)TL * 1024, 1024, (const u16*)(ws + wofs(layer) + OFF_WOUT), 1024, TC, 1024, 1024, TL};
        gemm_phase_t<1, 64>(lds, gc, ep);
      }
    } break;
    case 8: if (en(14)) ph_norm(p.out, (const float*)(ws + OFF_HCTX), rows, p.in[7] + layer * 1024, modl, 3, 4, (u16*)(ws + OFF_HN)); break;
    case 9: if (en(15)) {
      GemmDesc g{(const u16*)(ws + OFF_HN), 1024, (const u16*)(ws + wofs(layer) + OFF_WGU), 1024, rows, 5632, 1024};
      gemm_phase_t<4, 32>(lds, g, EpiSwiglu{(u16*)(ws + OFF_ACT)});
    } break;
    case 10: if (en(16)) {
      const EpiResid ep{p.out, (const float*)(ws + OFF_HCTX), p.out, (float*)(ws + OFF_HCTX), modl + 5 * 1024};
      GemmDesc g{(const u16*)(ws + OFF_ACT), FF, (const u16*)(ws + wofs(layer) + OFF_WDN), FF, TL, 1024, FF};
      gemm_phase(lds, g, ep);
      if (need_ctx) {
        GemmDesc gc{(const u16*)(ws + OFF_ACT) + (size_t)TL * FF, FF, (const u16*)(ws + wofs(layer) + OFF_WDN), FF, TC, 1024, FF, TL};
        gemm_phase_t<1, 64>(lds, gc, ep);
      }
      if (layer < 3) {
        const int nt = ((TC / 64) * 8) % (int)gridDim.x;
        ph_convert(p, lds, layer + 1, nt);
      }
    } break;
  }
}

__global__ void __launch_bounds__(256, 2) mega(Params p) {
  __shared__ __attribute__((aligned(16))) char lds[LDS_BYTES];
  __shared__ uint4 xb_words;
  cg::grid_group grid = cg::this_grid();
  if (threadIdx.x == 0) xb_words = make_uint4(0u, 0u, 0u, 0u);
  __syncthreads();
  const XcdBarrier xb = xcd_barrier_post((unsigned*)(p.ws + OFF_BAR), (volatile LAS unsigned*)&xb_words);
  const int ph_lo = p.ph_lo, ph_hi = p.ph_hi;
  for (int ph = ph_lo; ph < ph_hi; ++ph) {
    const __attribute__((address_space(4))) Params* pp = (const __attribute__((address_space(4))) Params*)__builtin_amdgcn_kernarg_segment_ptr();
    asm volatile("" : "+s"(pp));
    Params q;
    q.out = pp->out; q.ws = pp->ws; q.ph_lo = ph_lo; q.ph_hi = ph_hi;
#pragma unroll
    for (int i = 0; i < 33; ++i) q.in[i] = pp->in[i];
    run_phase(q, lds, ph);
    if (ph + 1 < ph_hi) {
      if (ph_lo == 0x7fffffff) grid.sync();
      xcd_barrier(xb);
    }
  }
}

extern "C" void kernel_launch(void* const* d_in, const int* in_sizes, int n_in, void* d_out, int out_size, void* d_ws, size_t ws_size, hipStream_t stream) {
  static int grid_blocks = 0;
  if (!grid_blocks) {
    int dev = 0, cus = 0, per_cu = 0;
    (void)hipGetDevice(&dev);
    (void)hipDeviceGetAttribute(&cus, hipDeviceAttributeMultiprocessorCount, dev);
    (void)hipOccupancyMaxActiveBlocksPerMultiprocessor(&per_cu, mega, 256, 0);
    if (per_cu < 1) per_cu = 1;
    if (per_cu > 2) per_cu = 2;
    grid_blocks = cus * per_cu;
    if (n_in != 33 || ws_size < WS_END) { fprintf(stderr, "kernel_launch: bad inputs n_in %d ws %zu need %zu\n", n_in, ws_size, (size_t)WS_END); }
  }
  (void)hipMemsetAsync((char*)d_ws + OFF_BAR, 0, 16384, stream);
  Params p{};
  for (int i = 0; i < 33; ++i) p.in[i] = (const float*)d_in[i];
  p.out = (float*)d_out; p.ws = (char*)d_ws;
#if MK_PER_PHASE
  for (int ph = 0; ph < NPHASES; ++ph) {
    p.ph_lo = ph; p.ph_hi = ph + 1;
    hipLaunchKernelGGL(mega, dim3(grid_blocks), dim3(256), 0, stream, p);
  }
#else
  p.ph_lo = 0; p.ph_hi = NPHASES;
  void* args[] = {&p};
  hipError_t e = hipLaunchCooperativeKernel((void*)mega, dim3(grid_blocks), dim3(256), args, 0, stream);
  if (e != hipSuccess) fprintf(stderr, "cooperative launch failed: %s (grid %d)\n", hipGetErrorString(e), grid_blocks);
#endif
}
```

```cpp
#include <hip/hip_runtime.h>
#include <hip/hip_cooperative_groups.h>
#include <cstdio>
#include <cstdint>
namespace cg = cooperative_groups;

#ifndef MK_PER_PHASE
#define MK_PER_PHASE 0
#endif
#ifndef DBG_ONLY
#define DBG_ONLY -1
#endif
constexpr bool en(int t) { return DBG_ONLY < 0 || DBG_ONLY == t; }
#ifndef PROBE_DBL
#define PROBE_DBL 0
#endif
constexpr bool dbl(int t) { return ((PROBE_DBL >> t) & 1) != 0; }

#define DI __device__ __forceinline__
typedef unsigned short u16;
using bf16x8 = __attribute__((ext_vector_type(8))) short;
using s16x4  = __attribute__((ext_vector_type(4))) short;
using f32x16 = __attribute__((ext_vector_type(16))) float;
using u32x4  = __attribute__((ext_vector_type(4))) unsigned;
typedef unsigned u32x2_t __attribute__((ext_vector_type(2)));
#define MFMA32(a, b, c) __builtin_amdgcn_mfma_f32_32x32x16_bf16((a), (b), (c), 0, 0, 0)

constexpr int D = 1024, NB = 8, SEQ = 4096, CTX = 256;
constexpr int TL = NB * SEQ, TC = NB * CTX, TA = TL + TC;
constexpr int FF = 2816, KPOS = SEQ + CTX;
constexpr int LDS_BYTES = 77824;
constexpr int NPH_LAYER = 11;
constexpr int NPHASES = 1 + (11 + 10 + 11 + 10) + 1;

constexpr size_t OFF_HCTX = 0;
constexpr size_t OFF_MOD  = OFF_HCTX + (size_t)TC * D * 4;
constexpr size_t OFF_RSQ  = OFF_MOD + 4 * 9 * 6144 * 4;
constexpr size_t OFF_RSKV = OFF_RSQ + (size_t)TA * 4;
constexpr size_t OFF_PSUM = OFF_RSKV + (size_t)TA * 4;
constexpr size_t OFF_DBUF = OFF_PSUM + 272 * 1024 * 4;
constexpr size_t OFF_WIN  = OFF_DBUF + 64 * 68 * 128 * 4;
constexpr size_t OFF_WOUT = OFF_WIN + 4096 * 1024 * 2;
constexpr size_t OFF_WGU  = OFF_WOUT + 1024 * 1024 * 2;
constexpr size_t OFF_WDN  = OFF_WGU + 5632 * 1024 * 2;
constexpr size_t OFF_WUQ  = OFF_WDN + 1024 * 2816 * 2;
constexpr size_t OFF_WUKV = OFF_WUQ + 384 * 256 * 2;
constexpr size_t OFF_FR0  = OFF_WUKV + 768 * 128 * 2;
constexpr size_t OFF_FR1  = OFF_FR0 + 512 * 8192 * 2;
constexpr size_t OFF_FCTX = OFF_FR1 + 512 * 8192 * 2;
constexpr size_t OFF_ZA   = OFF_FCTX + 512 * 512 * 2;
constexpr size_t SZ_ZHG   = (size_t)TA * 2560 * 2;
constexpr size_t OFF_ZHY  = OFF_ZA + SZ_ZHG;
constexpr size_t SZ_ZA    = (size_t)TA * 4096 * 2;
constexpr size_t OFF_HN   = OFF_ZA + SZ_ZA;
constexpr size_t SZ_HN    = (size_t)TA * 1024 * 2;
constexpr size_t OFF_UT   = OFF_HN;
constexpr size_t OFF_UTC  = OFF_UT + (size_t)8 * 512 * 4096 * 2;
constexpr size_t OFF_X0T  = OFF_UTC + (size_t)8 * 512 * 256 * 2;
constexpr size_t OFF_X0TC = OFF_X0T + (size_t)8 * 512 * 4096 * 2;
constexpr size_t OFF_ST   = OFF_HN;
constexpr size_t SZ_ST    = (size_t)64 * 68 * 16384 * 2;
constexpr size_t OFF_MIXE = OFF_ZHY;
constexpr size_t OFF_YT   = OFF_ZHY + SZ_HN;
constexpr size_t OFF_YTC  = OFF_YT + (size_t)8 * 512 * 4096 * 2;
static_assert(OFF_YTC + (size_t)8 * 512 * 256 * 2 <= OFF_ZHY + (size_t)TA * 1536 * 2, "yt overflows z_hy");
constexpr size_t OFF_ZO   = OFF_ZA;
constexpr size_t OFF_UPQ  = OFF_ZA + (size_t)TA * 1952 * 2;
constexpr size_t OFF_UPKV = OFF_UPQ + (size_t)TA * 384 * 2;
constexpr size_t OFF_QA   = OFF_UPKV + (size_t)TA * 768 * 2;
constexpr size_t OFF_QAC  = OFF_QA + (size_t)8 * 8 * 4096 * 64 * 2;
constexpr size_t OFF_QM   = OFF_QAC + (size_t)8 * 8 * 256 * 64 * 2;
constexpr size_t OFF_QMC  = OFF_QM + (size_t)8 * 4 * 4096 * 96 * 2;
constexpr size_t OFF_QEND = OFF_QMC + (size_t)8 * 4 * 256 * 96 * 2;
static_assert(OFF_QEND <= OFF_HN, "odd-layer q buffers overflow region A");
constexpr size_t OFF_KA   = OFF_HN;
constexpr size_t OFF_VTA  = OFF_KA + (size_t)8 * 8 * KPOS * 64 * 2;
constexpr size_t OFF_KM   = OFF_VTA + (size_t)8 * 4 * 128 * KPOS * 2;
constexpr size_t OFF_VTM  = OFF_KM + (size_t)8 * 4 * KPOS * 96 * 2;
constexpr size_t OFF_OA   = OFF_ZA;
constexpr size_t OFF_MIXO = OFF_ZA + SZ_HN;
constexpr size_t OFF_ACT  = OFF_ZA;
constexpr size_t OFF_BAR  = OFF_HN + SZ_ST;
constexpr size_t OFF_W2   = OFF_BAR + 16384;
constexpr size_t W2_DELTA = OFF_W2 - OFF_WIN;
constexpr size_t OFF_ROPE = OFF_W2 + (OFF_ZA - OFF_WIN);
constexpr size_t WS_END   = OFF_ROPE + 2 * 1024 * 4;
static_assert(WS_END <= (size_t)536870912, "workspace too large");

struct Params {
  const float* in[33];
  float* out;
  char* ws;
  int ph_lo, ph_hi;
};

__device__ __forceinline__ size_t wofs(int layer) { return (layer & 1) ? W2_DELTA : (size_t)0; }
DI int tid_l() { int t = threadIdx.x; asm volatile("" : "+v"(t)); return t; }
DI int bid_l() { int t = blockIdx.x; asm volatile("" : "+s"(t)); return t; }
typedef __bf16 bf2_t __attribute__((ext_vector_type(2)));
typedef float f2_t __attribute__((ext_vector_type(2)));
DI unsigned pack2(float a, float b) { f2_t v = {a, b}; return __builtin_bit_cast(unsigned, __builtin_convertvector(v, bf2_t)); }
DI u16 f2bf(float x) { return (u16)(pack2(x, x) & 0xffffu); }
DI float bf2f(u16 v) { return __uint_as_float(((unsigned)v) << 16); }
DI float bflo(unsigned w) { return __uint_as_float(w << 16); }
DI float bfhi(unsigned w) { return __uint_as_float(w & 0xffff0000u); }
DI float wave_sum(float v) { for (int o = 32; o > 0; o >>= 1) v += __shfl_xor(v, o); return v; }
DI float sigm(float x) { return __builtin_amdgcn_rcpf(1.f + __expf(-x)); }
DI float siluf(float x) { return x * __builtin_amdgcn_rcpf(1.f + __expf(-x)); }
DI int crow(int r, int h) { return (r & 3) + 8 * (r >> 2) + 4 * h; }
DI int modrow(int row) { return row < TL ? (row >> 12) : 8; }
DI bf16x8 pack8(const f32x16& x, const int s) {
  u32x4 q = {pack2(x[8 * s], x[8 * s + 1]), pack2(x[8 * s + 2], x[8 * s + 3]), pack2(x[8 * s + 4], x[8 * s + 5]), pack2(x[8 * s + 6], x[8 * s + 7])};
  return __builtin_bit_cast(bf16x8, q);
}
DI int slot_of(int e32) { return ((e32 >> 2) & 3) * 8 + (e32 >> 4) * 4 + (e32 & 3); }
DI int elem_of(int slot) { return ((slot >> 2) & 1) * 16 + (slot >> 3) * 4 + (slot & 3); }
DI f32x16 zero16() { f32x16 z; for (int i = 0; i < 16; ++i) z[i] = 0.f; return z; }


#define XB_TMO      128
#define XB_XCNT(j)  (256  + 64 * (j))
#define XB_XSUB(j)  (1280 + 64 * (j))
#define XB_XGEN(j)  (2304 + 64 * (j))
#define XB_TOP      3328
#define XB_TOPGEN   3392
#define XCD_BAR_WORDS 3456
#define XB_SPIN_CAP (1u << 20)
#define LAS __attribute__((address_space(3)))
DI unsigned xb_ld(unsigned* p) { return __hip_atomic_load(p, __ATOMIC_RELAXED, __HIP_MEMORY_SCOPE_AGENT); }
DI unsigned xb_add(unsigned* p, unsigned v) { return __hip_atomic_fetch_add(p, v, __ATOMIC_RELAXED, __HIP_MEMORY_SCOPE_AGENT); }
DI unsigned xb_xcc_id() { return (unsigned)__builtin_amdgcn_s_getreg((3 << 11) | 20) & 0xFu; }
#define XB_SPIN(cond, bar) do { unsigned _sp = 0; while (cond) { __builtin_amdgcn_s_sleep(1); \
    if ((++_sp & 255u) == 0u) { if (xb_ld(&(bar)[XB_TMO])) break; if (_sp > XB_SPIN_CAP) { atomicAdd(&(bar)[XB_TMO], 1u); break; } } } } while (0)
struct XcdBarrier { unsigned* bar; unsigned x; volatile LAS unsigned* st; };
DI XcdBarrier xcd_barrier_post(unsigned* bar, volatile LAS unsigned* st) {
  XcdBarrier b; b.bar = bar; b.x = xb_xcc_id(); b.st = st;
  if (threadIdx.x == 0) (void)xb_add(&bar[XB_XCNT(b.x)], 1u);
  return b;
}
DI void xcd_barrier_complete(unsigned* bar, unsigned x, unsigned& nloc, unsigned& nx) {
  const unsigned G = gridDim.x * gridDim.y * gridDim.z;
  unsigned sum, cnt, mine, sp = 0u;
  for (;;) {
    sum = 0u; cnt = 0u; mine = 0u;
#pragma unroll
    for (unsigned j = 0; j < 16; ++j) { const unsigned c = xb_ld(&bar[XB_XCNT(j)]); sum += c; cnt += (c > 0u) ? 1u : 0u; mine = (j == x) ? c : mine; }
    if (sum == G) break;
    __builtin_amdgcn_s_sleep(1);
    if ((++sp & 255u) == 0u) { if (xb_ld(&bar[XB_TMO])) break; if (sp > XB_SPIN_CAP) { atomicAdd(&bar[XB_TMO], 1u); break; } }
  }
  nloc = mine > 0u ? mine : 1u; nx = cnt > 0u ? cnt : 1u;
}
DI void xcd_barrier(const XcdBarrier& b) {
  asm volatile("s_waitcnt vmcnt(0)" ::: "memory");
  __syncthreads();
  if (threadIdx.x == 0) {
    unsigned* bar = b.bar;
    __builtin_amdgcn_s_waitcnt(0);
    unsigned nloc = b.st[0], nx = b.st[1];
    if (nloc == 0u) { xcd_barrier_complete(bar, b.x, nloc, nx); b.st[0] = nloc; b.st[1] = nx; }
    const unsigned old = xb_add(&bar[XB_XSUB(b.x)], 1u);
    const unsigned gen = old / nloc;
    if (old + 1u == (gen + 1u) * nloc) {
      __builtin_amdgcn_fence(__ATOMIC_RELEASE, "agent");
      asm volatile("s_waitcnt vmcnt(0)" ::: "memory");
      const unsigned og = xb_add(&bar[XB_TOP], 1u);
      const unsigned tg = og / nx;
      if (og + 1u == (tg + 1u) * nx) xb_add(&bar[XB_TOPGEN], 1u);
      else XB_SPIN(xb_ld(&bar[XB_TOPGEN]) == tg, bar);
      __builtin_amdgcn_fence(__ATOMIC_ACQUIRE, "agent");
      xb_add(&bar[XB_XGEN(b.x)], 1u);
      asm volatile("s_waitcnt vmcnt(0)" ::: "memory");
    } else {
      XB_SPIN(xb_ld(&bar[XB_XGEN(b.x)]) == gen, bar);
      __builtin_amdgcn_fence(__ATOMIC_ACQUIRE, "agent");
      asm volatile("s_waitcnt vmcnt(0)" ::: "memory");
    }
  }
  __syncthreads();
}

struct GemmDesc { const u16* A; int lda; const u16* Bt; int ldb; int M; int Npad; int K; int mbase = 0; };

template <int MF, int BK, class Epi>
DI void gemm_phase_t(char* lds, const GemmDesc g, const Epi epi) {
  constexpr int BM = MF * 64, LS = BK + 8, CPR = BK / 8, RSTEP = 256 / CPR;
  constexpr int APT = BM * CPR / 256, BPT = 128 * CPR / 256, STG = (BM + 128) * LS, NKK = BK / 16;
  u16* sbase = (u16*)lds;
  const int tid = tid_l(), lane = tid & 63, w = tid >> 6, wm = w >> 1, wn = w & 1, l31 = lane & 31, h = lane >> 5;
  const int ntn = g.Npad / 128, ntm = g.M / BM, ntiles = ntm * ntn, nk = g.K / BK;
  const int lr = tid / CPR, lc = tid % CPR;
  for (int t = bid_l(); t < ntiles; t += gridDim.x) {
    const int tn = t % ntn, tm = t / ntn;
    const int m0 = tm * BM, n0 = tn * 128;
    const u16* Ap = g.A + (size_t)(m0 + lr) * g.lda + lc * 8;
    const u16* Bp = g.Bt + (size_t)(n0 + lr) * g.ldb + lc * 8;
    u32x4 ra[APT], rb[BPT];
#pragma unroll
    for (int j = 0; j < APT; ++j) ra[j] = *(const u32x4*)(Ap + (size_t)j * RSTEP * g.lda);
#pragma unroll
    for (int j = 0; j < BPT; ++j) rb[j] = *(const u32x4*)(Bp + (size_t)j * RSTEP * g.ldb);
#pragma unroll
    for (int j = 0; j < APT; ++j) *(u32x4*)(sbase + (lr + RSTEP * j) * LS + lc * 8) = ra[j];
#pragma unroll
    for (int j = 0; j < BPT; ++j) *(u32x4*)(sbase + BM * LS + (lr + RSTEP * j) * LS + lc * 8) = rb[j];
    if (nk > 1) {
#pragma unroll
      for (int j = 0; j < APT; ++j) ra[j] = *(const u32x4*)(Ap + (size_t)j * RSTEP * g.lda + BK);
#pragma unroll
      for (int j = 0; j < BPT; ++j) rb[j] = *(const u32x4*)(Bp + (size_t)j * RSTEP * g.ldb + BK);
    }
    f32x16 acc[MF][2];
#pragma unroll
    for (int i = 0; i < MF; ++i)
#pragma unroll
      for (int j = 0; j < 2; ++j) acc[i][j] = zero16();
    for (int kt = 0; kt < nk; ++kt) {
      __syncthreads();
      const u16* sA = sbase + (kt & 1) * STG;
      const u16* sB = sA + BM * LS;
      if (kt + 1 < nk) {
        u16* nA = sbase + ((kt + 1) & 1) * STG;
#pragma unroll
        for (int j = 0; j < APT; ++j) *(u32x4*)(nA + (lr + RSTEP * j) * LS + lc * 8) = ra[j];
#pragma unroll
        for (int j = 0; j < BPT; ++j) *(u32x4*)(nA + BM * LS + (lr + RSTEP * j) * LS + lc * 8) = rb[j];
        if (kt + 2 < nk) {
#pragma unroll
          for (int j = 0; j < APT; ++j) ra[j] = *(const u32x4*)(Ap + (size_t)j * RSTEP * g.lda + (kt + 2) * BK);
#pragma unroll
          for (int j = 0; j < BPT; ++j) rb[j] = *(const u32x4*)(Bp + (size_t)j * RSTEP * g.ldb + (kt + 2) * BK);
        }
      }
      bf16x8 af[NKK][MF], bfr[NKK][2];
#pragma unroll
      for (int kk = 0; kk < NKK; ++kk) {
#pragma unroll
        for (int ni = 0; ni < 2; ++ni) bfr[kk][ni] = *(const bf16x8*)(sB + (wn * 64 + ni * 32 + l31) * LS + kk * 16 + h * 8);
#pragma unroll
        for (int mi = 0; mi < MF; ++mi) af[kk][mi] = *(const bf16x8*)(sA + (wm * (MF * 32) + mi * 32 + l31) * LS + kk * 16 + h * 8);
      }
      __builtin_amdgcn_sched_barrier(0);
#pragma unroll
      for (int kk = 0; kk < NKK; ++kk)
#pragma unroll
        for (int mi = 0; mi < MF; ++mi)
#pragma unroll
          for (int ni = 0; ni < 2; ++ni) acc[mi][ni] = MFMA32(bfr[kk][ni], af[kk][mi], acc[mi][ni]);
    }
    epi(acc, g.mbase + m0 + wm * (MF * 32), n0 + wn * 64, l31, h);
  }
  __syncthreads();
}
template <class Epi>
DI void gemm_phase(char* lds, const GemmDesc g, const Epi epi) { gemm_phase_t<2, 64, Epi>(lds, g, epi); }

struct EpiStore {
  u16* C; int ldc; int N;
  template <int MF> DI void operator()(f32x16 (&acc)[MF][2], int mb, int nb, int l31, int h) const {
#pragma unroll
    for (int mi = 0; mi < MF; ++mi) {
      const int row = mb + mi * 32 + l31;
#pragma unroll
      for (int g4 = 0; g4 < 4; ++g4) {
        const int col0 = nb + 16 * g4 + 8 * h;
        if (col0 < N) *(u32x4*)(C + (size_t)row * ldc + col0) = (u32x4){pack2(acc[mi][0][4 * g4], acc[mi][0][4 * g4 + 1]), pack2(acc[mi][0][4 * g4 + 2], acc[mi][0][4 * g4 + 3]),
                                                                        pack2(acc[mi][1][4 * g4], acc[mi][1][4 * g4 + 1]), pack2(acc[mi][1][4 * g4 + 2], acc[mi][1][4 * g4 + 3])};
      }
    }
  }
};
struct EpiOddIn {
  u16* z; u16* Qa; u16* Qac; u16* Ka; const float* rope;
  template <int MF> DI void operator()(f32x16 (&acc)[MF][2], int mb, int nb, int l31, int h) const {
    if (nb >= 1024) {
#pragma unroll
      for (int mi = 0; mi < MF; ++mi) {
        const int row = mb + mi * 32 + l31;
#pragma unroll
        for (int g4 = 0; g4 < 4; ++g4) {
          const int col0 = nb + 16 * g4 + 8 * h;
          if (col0 < 1952) *(u32x4*)(z + (size_t)row * 1952 + col0) = (u32x4){pack2(acc[mi][0][4 * g4], acc[mi][0][4 * g4 + 1]), pack2(acc[mi][0][4 * g4 + 2], acc[mi][0][4 * g4 + 3]),
                                                                                pack2(acc[mi][1][4 * g4], acc[mi][1][4 * g4 + 1]), pack2(acc[mi][1][4 * g4 + 2], acc[mi][1][4 * g4 + 3])};
        }
      }
      return;
    }
    const int which = nb >> 9, head = ((nb >> 6) & 1) * 4 + ((nb >> 7) & 3);
#pragma unroll
    for (int mi = 0; mi < MF; ++mi) {
      const int row = mb + mi * 32 + l31;
      const bool isl = row < TL;
      const int b = isl ? row >> 12 : (row - TL) >> 8;
      const int t = isl ? row & 4095 : (row - TL) & 255;
      float x[4][8];
#pragma unroll
      for (int g4 = 0; g4 < 4; ++g4)
#pragma unroll
        for (int k = 0; k < 4; ++k) { x[g4][k] = acc[mi][0][4 * g4 + k]; x[g4][4 + k] = acc[mi][1][4 * g4 + k]; }
      if (isl) {
        const float* sr = rope + (t >> 6) * 16 + 8 * h; const float* sc = rope + (t & 63) * 16 + 8 * h;
        const float4 s1a = *(const float4*)(sr), s1b = *(const float4*)(sr + 4), c1a = *(const float4*)(sr + 1024), c1b = *(const float4*)(sr + 1028);
        const float4 s2a = *(const float4*)(sc), s2b = *(const float4*)(sc + 4), c2a = *(const float4*)(sc + 1024), c2b = *(const float4*)(sc + 1028);
        const float s1[8] = {s1a.x, s1a.y, s1a.z, s1a.w, s1b.x, s1b.y, s1b.z, s1b.w}, c1[8] = {c1a.x, c1a.y, c1a.z, c1a.w, c1b.x, c1b.y, c1b.z, c1b.w};
        const float s2[8] = {s2a.x, s2a.y, s2a.z, s2a.w, s2b.x, s2b.y, s2b.z, s2b.w}, c2[8] = {c2a.x, c2a.y, c2a.z, c2a.w, c2b.x, c2b.y, c2b.z, c2b.w};
#pragma unroll
        for (int k = 0; k < 8; ++k) {
          const float a = x[0][k], bq = x[1][k], cq = x[2][k], dq = x[3][k];
          x[0][k] = a * c1[k] - bq * s1[k]; x[1][k] = bq * c1[k] + a * s1[k];
          x[2][k] = cq * c2[k] - dq * s2[k]; x[3][k] = dq * c2[k] + cq * s2[k];
        }
      }
      u16* dst;
      if (which == 0) dst = isl ? Qa + ((size_t)(b * 8 + head) * 4096 + t) * 64 : Qac + ((size_t)(b * 8 + head) * 256 + t) * 64;
      else dst = Ka + ((size_t)(b * 8 + head) * KPOS + (isl ? t : 4096 + t)) * 64;
      dst += 8 * h;
#pragma unroll
      for (int g4 = 0; g4 < 4; ++g4)
        *(u32x4*)(dst + 16 * g4) = (u32x4){pack2(x[g4][0], x[g4][1]), pack2(x[g4][2], x[g4][3]), pack2(x[g4][4], x[g4][5]), pack2(x[g4][6], x[g4][7])};
    }
  }
};
struct EpiSplitEven {
  u16* zhg; u16* zhy;
  template <int MF> DI void operator()(f32x16 (&acc)[MF][2], int mb, int nb, int l31, int h) const {
#pragma unroll
    for (int mi = 0; mi < MF; ++mi) {
      const int row = mb + mi * 32 + l31;
#pragma unroll
      for (int g4 = 0; g4 < 4; ++g4) {
        const int col0 = nb + 16 * g4 + 8 * h;
        u16* dst = (col0 < 2560) ? zhg + (size_t)row * 2560 + col0 : zhy + (size_t)row * 1536 + (col0 - 2560);
        *(u32x4*)dst = (u32x4){pack2(acc[mi][0][4 * g4], acc[mi][0][4 * g4 + 1]), pack2(acc[mi][0][4 * g4 + 2], acc[mi][0][4 * g4 + 3]),
                               pack2(acc[mi][1][4 * g4], acc[mi][1][4 * g4 + 1]), pack2(acc[mi][1][4 * g4 + 2], acc[mi][1][4 * g4 + 3])};
      }
    }
  }
};
struct EpiResid {
  const float* res_lat; const float* res_ctx; float* out_lat; float* out_ctx; const float* gate;
  template <int MF> DI void operator()(f32x16 (&acc)[MF][2], int mb, int nb, int l31, int h) const {
#pragma unroll
    for (int mi = 0; mi < MF; ++mi) {
      const int row = mb + mi * 32 + l31;
      const float* gr = gate + (size_t)modrow(row) * 6144;
      const float* rp = row < TL ? res_lat + (size_t)row * D : res_ctx + (size_t)(row - TL) * D;
      float* op = row < TL ? out_lat + (size_t)row * D : out_ctx + (size_t)(row - TL) * D;
#pragma unroll
      for (int g4 = 0; g4 < 4; ++g4)
#pragma unroll
        for (int ni = 0; ni < 2; ++ni) {
          const int col0 = nb + 16 * g4 + 8 * h + 4 * ni;
          const float4 gt = *(const float4*)(gr + col0);
          const float4 rv = *(const float4*)(rp + col0);
          *(float4*)(op + col0) = make_float4(rv.x + gt.x * acc[mi][ni][4 * g4], rv.y + gt.y * acc[mi][ni][4 * g4 + 1], rv.z + gt.z * acc[mi][ni][4 * g4 + 2], rv.w + gt.w * acc[mi][ni][4 * g4 + 3]);
        }
    }
  }
};
struct EpiSwiglu {
  u16* act;
  template <int MF> DI void operator()(f32x16 (&acc)[MF][2], int mb, int nb, int l31, int h) const {
#pragma unroll
    for (int mi = 0; mi < MF; ++mi) {
      const int row = mb + mi * 32 + l31;
#pragma unroll
      for (int gp = 0; gp < 2; ++gp) {
        const int j0 = (nb >> 1) + 16 * h + 8 * gp;
        float v[8];
#pragma unroll
        for (int i = 0; i < 8; ++i) v[i] = siluf(acc[mi][0][8 * gp + i]) * acc[mi][1][8 * gp + i];
        *(u32x4*)(act + (size_t)row * FF + j0) = (u32x4){pack2(v[0], v[1]), pack2(v[2], v[3]), pack2(v[4], v[5]), pack2(v[6], v[7])};
      }
    }
  }
};

DI void ph_ada(const Params& p, char* lds) {
  float* sS = (float*)lds;
  float* sR = sS + 9 * 1024;
  const int tid = tid_l();
  const float* c = p.in[1]; const float* cc = p.in[3];
  for (int i = tid; i < 9 * 1024; i += 256) {
    const int r = i >> 10, k = i & 1023;
    const float v = r < 8 ? c[r * 1024 + k] : cc[k];
    sS[i] = v / (1.f + expf(-v));
  }
  __syncthreads();
  float* mod = (float*)(p.ws + OFF_MOD);
  for (int item = bid_l(); item < 4 * 96; item += gridDim.x) {
    const int l = item / 96, n0 = (item % 96) * 64, cq = (tid & 15) * 4, ks = tid >> 4;
    float acc[9][4];
#pragma unroll
    for (int r = 0; r < 9; ++r)
#pragma unroll
      for (int j = 0; j < 4; ++j) acc[r][j] = 0.f;
    const float* W = p.in[4] + (size_t)l * 1024 * 6144 + n0 + cq;
#pragma unroll 4
    for (int k = ks * 64; k < ks * 64 + 64; ++k) {
      const float4 wv = *(const float4*)(W + (size_t)k * 6144);
#pragma unroll
      for (int r = 0; r < 9; ++r) {
        const float sv = sS[r * 1024 + k];
        acc[r][0] += sv * wv.x; acc[r][1] += sv * wv.y; acc[r][2] += sv * wv.z; acc[r][3] += sv * wv.w;
      }
    }
#pragma unroll
    for (int r = 0; r < 9; ++r) *(float4*)(sR + (ks * 9 + r) * 64 + cq) = make_float4(acc[r][0], acc[r][1], acc[r][2], acc[r][3]);
    __syncthreads();
    for (int o = tid; o < 576; o += 256) {
      const int r = o >> 6, c2 = o & 63;
      float t = p.in[5][l * 6144 + n0 + c2];
#pragma unroll
      for (int q = 0; q < 16; ++q) t += sR[(q * 9 + r) * 64 + c2];
      mod[(size_t)(l * 9 + r) * 6144 + n0 + c2] = t;
    }
    __syncthreads();
  }
}

DI void convT_tile(char* lds, const float* src, int K, int Nsrc, u16* dst, int tk, int tn, int mode, const float* kscale) {
  float* sT = (float*)lds;
  const int tid = tid_l();
  const int k0 = tk * 64, n0 = tn * 64;
  {
    const int kk = tid >> 2, c16 = (tid & 3) * 16;
    int sc0 = n0 + c16;
    if (mode == 1) { const int blk = n0 >> 6; sc0 = (c16 < 32) ? (blk * 32 + c16) : (2816 + blk * 32 + (c16 - 32)); }
    const float ks = kscale ? kscale[k0 + kk] : 1.f;
    const bool ok = (mode == 1) || (n0 + c16 < Nsrc);
    const float* sp = src + (size_t)(k0 + kk) * Nsrc + sc0;
#pragma unroll
    for (int q = 0; q < 4; ++q) {
      float4 v = ok ? *(const float4*)(sp + q * 4) : make_float4(0.f, 0.f, 0.f, 0.f);
      sT[kk * 65 + c16 + q * 4 + 0] = v.x * ks; sT[kk * 65 + c16 + q * 4 + 1] = v.y * ks;
      sT[kk * 65 + c16 + q * 4 + 2] = v.z * ks; sT[kk * 65 + c16 + q * 4 + 3] = v.w * ks;
    }
  }
  __syncthreads();
  {
    const int n = tid >> 2, kq = (tid & 3) * 16;
    const int sg4 = (n >> 3) & 3, sh = (n >> 2) & 1, si = n & 3, sni = n >> 5;
    const int cs = (mode == 1) ? (n & 32) + 16 * sh + 4 * sg4 + si : 16 * sg4 + 8 * sh + 4 * sni + si;
    unsigned o[8];
#pragma unroll
    for (int q = 0; q < 8; ++q) o[q] = pack2(sT[(kq + 2 * q) * 65 + cs], sT[(kq + 2 * q + 1) * 65 + cs]);
    uint4* dp = (uint4*)(dst + (size_t)(n0 + n) * K + k0 + kq);
    dp[0] = make_uint4(o[0], o[1], o[2], o[3]);
    dp[1] = make_uint4(o[4], o[5], o[6], o[7]);
  }
  __syncthreads();
}

DI void filt_item(const Params& p, char* lds, int e, int idx, size_t wo) {
  float* zf = (float*)lds;
  float* h1 = zf + 16 * 33;
  float* h2 = h1 + 16 * 64;
  const int tid = tid_l();
  const bool lat = idx < 256;
  const int L = lat ? 4096 : 256;
  const int p0 = (lat ? idx : idx - 256) * 16;
  const float* w1 = p.in[16] + (size_t)e * 33 * 64; const float* b1 = p.in[17] + e * 64; const float* fr1 = p.in[18] + e * 64;
  const float* w2 = p.in[19] + (size_t)e * 64 * 64; const float* b2 = p.in[20] + e * 64; const float* fr2 = p.in[21] + e * 64;
  const float* w3 = p.in[22] + (size_t)e * 64 * 1024;
  for (int i = tid; i < 16 * 33; i += 256) {
    const int pp = i / 33, f = i % 33;
    const int pos = p0 + pp;
    const float tt = (float)pos / (float)(L - 1);
    const float wv = (6.283185307179586f * (float)pos) / (float)L;
    float v;
    if (f == 0) v = tt;
    else {
      const int j = (f - 1) & 15;
      const float band = 1e-4f + (float)j * ((15.f - 1e-4f) / 15.f);
      v = (f <= 16) ? cosf(band * wv) : -sinf(band * wv);
    }
    zf[i] = v;
  }
  __syncthreads();
  for (int i = tid; i < 1024; i += 256) {
    const int pp = i >> 6, j = i & 63;
    float s = b1[j];
#pragma unroll 3
    for (int f = 0; f < 33; ++f) s += zf[pp * 33 + f] * w1[f * 64 + j];
    h1[i] = sinf(fr1[j] * s);
  }
  __syncthreads();
  for (int i = tid; i < 1024; i += 256) {
    const int pp = i >> 6, j = i & 63;
    float s = b2[j];
#pragma unroll 4
    for (int k = 0; k < 64; ++k) s += h1[pp * 64 + k] * w2[k * 64 + j];
    h2[i] = sinf(fr2[j] * s);
  }
  __syncthreads();
  u16* R0 = (u16*)(p.ws + wo + OFF_FR0); u16* R1 = (u16*)(p.ws + wo + OFF_FR1); u16* FC = (u16*)(p.ws + wo + OFF_FCTX);
  float* psum = (float*)(p.ws + OFF_PSUM);
  const float d_lo = 4.605170185988091f / 1.5f, d_hi = 4.605170185988091f / 0.3f;
#pragma unroll 1
  for (int q = 0; q < 4; ++q) {
    const int n = tid + 256 * q;
    float acc[16];
#pragma unroll
    for (int pp = 0; pp < 16; ++pp) acc[pp] = 0.f;
#pragma unroll 2
    for (int k = 0; k < 64; ++k) {
      const float wv = w3[k * 1024 + n];
#pragma unroll
      for (int pp = 0; pp < 16; ++pp) acc[pp] += h2[pp * 64 + k] * wv;
    }
    const int ch = n & 511;
    const bool bwd = n >= 512;
    const float delta = d_lo + (float)ch * ((d_hi - d_lo) / 511.f);
    float asum = 0.f;
#pragma unroll
    for (int pp = 0; pp < 16; ++pp) {
      const int pos = p0 + pp;
      const float tt = (float)pos / (float)(L - 1);
      const float val = acc[pp] * expf(-tt * delta);
      const int lag = bwd ? -(pos + 1) : pos;
      const bool valid = !bwd || (pos <= L - 2);
      if (valid) {
        asum += fabsf(val);
        const u16 bv = f2bf(val);
        if (lat) {
          const int m = 8191 - (4096 + lag);
          R0[(size_t)ch * 8192 + m] = bv;
          if (m >= 1) R1[(size_t)ch * 8192 + m - 1] = bv;
        } else {
          FC[(size_t)ch * 512 + 256 + lag] = bv;
        }
      }
    }
    if (lat && bwd && p0 == 0) {   }
    psum[(size_t)idx * 1024 + n] = asum;
  }
  if (lat && p0 == 0) {
    for (int ch = tid; ch < 512; ch += 256) { R0[(size_t)ch * 8192 + 8191] = 0; R1[(size_t)ch * 8192 + 8191] = 0; R1[(size_t)ch * 8192 + 8190] = 0; }
  }
  if (!lat && p0 == 0) { for (int ch = tid; ch < 512; ch += 256) FC[(size_t)ch * 512] = 0; }
  __syncthreads();
}

DI void ph_norm(const float* src_lat, const float* src_ctx, int rows, const float* g, const float* modl, int i_shift, int i_scale, u16* dst) {
  const int lane = tid_l() & 63;
  const int wid = bid_l() * 4 + (tid_l() >> 6), nw = gridDim.x * 4;
  const int per = (rows + nw - 1) / nw;
  const int r0 = wid * per, r1 = (r0 + per < rows) ? r0 + per : rows;
  float gs[16], sh[16];
  int cur = -1;
  for (int row = r0; row < r1; ++row) {
    const int mrow = modrow(row);
    if (mrow != cur) {
      cur = mrow;
      const float* mr = modl + (size_t)mrow * 6144;
#pragma unroll
      for (int j = 0; j < 4; ++j) {
        const int c0 = lane * 4 + 256 * j;
        const float4 gg = *(const float4*)(g + c0);
        const float4 sc = *(const float4*)(mr + i_scale * 1024 + c0);
        const float4 s4 = *(const float4*)(mr + i_shift * 1024 + c0);
        gs[4 * j] = gg.x * (1.f + sc.x); gs[4 * j + 1] = gg.y * (1.f + sc.y); gs[4 * j + 2] = gg.z * (1.f + sc.z); gs[4 * j + 3] = gg.w * (1.f + sc.w);
        sh[4 * j] = s4.x; sh[4 * j + 1] = s4.y; sh[4 * j + 2] = s4.z; sh[4 * j + 3] = s4.w;
      }
    }
    const float* src = row < TL ? src_lat + (size_t)row * D : src_ctx + (size_t)(row - TL) * D;
    float4 v[4]; float ss = 0.f;
#pragma unroll
    for (int j = 0; j < 4; ++j) { v[j] = *(const float4*)(src + lane * 4 + 256 * j); ss += v[j].x * v[j].x + v[j].y * v[j].y + v[j].z * v[j].z + v[j].w * v[j].w; }
    ss = wave_sum(ss);
    const float rs = rsqrtf(ss * (1.f / 1024.f) + 1e-6f);
#pragma unroll
    for (int j = 0; j < 4; ++j) {
      const int c0 = lane * 4 + 256 * j;
      *(uint2*)(dst + (size_t)row * D + c0) = make_uint2(pack2(v[j].x * rs * gs[4 * j] + sh[4 * j], v[j].y * rs * gs[4 * j + 1] + sh[4 * j + 1]),
                                                         pack2(v[j].z * rs * gs[4 * j + 2] + sh[4 * j + 2], v[j].w * rs * gs[4 * j + 3] + sh[4 * j + 3]));
    }
  }
}

DI void ph_convert(const Params& p, char* lds, int layer, int b0) {
  const bool even = (layer & 1) == 0;
  const int e = layer >> 1;
  char* ws = p.ws + wofs(layer);
  const float* w_in  = even ? p.in[10] + (size_t)e * 1024 * 4096 : p.in[24] + (size_t)e * 1024 * 1952;
  const int n_in = even ? 4096 : 1952, n_in_pad = even ? 4096 : 2048;
  const float* w_out = even ? p.in[11] + (size_t)e * 1024 * 1024 : p.in[25] + (size_t)e * 1024 * 1024;
  const float* w_gu = p.in[8] + (size_t)layer * 1024 * 5632;
  const float* w_dn = p.in[9] + (size_t)layer * 2816 * 1024;
  const int s0 = 16 * (n_in_pad / 64);
  const int s1 = s0 + 16 * 16;
  const int s2 = s1 + 16 * 88;
  const int s3 = s2 + 44 * 16;
  const int s4 = s3 + (even ? 0 : 4 * 6);
  const int s5 = s4 + (even ? 0 : 2 * 12);
  const int s6 = s5 + (even ? 272 : 0);
  const int bid = bid_l();
  if (bid < b0) return;
  for (int it0 = bid - b0; it0 < s6; it0 += (int)gridDim.x - b0) {
    const int it = (it0 < s6 - s5) ? s5 + it0 : it0 - (s6 - s5);
    if (it >= s5) { filt_item(p, lds, e, it - s5, wofs(layer)); continue; }
    const float* src; int K, Nsrc, ntn, q, mode = 0; u16* dst; const float* ksc = nullptr;
    if (it < s0) { src = w_in; K = 1024; Nsrc = n_in; ntn = n_in_pad / 64; q = it; dst = (u16*)(ws + OFF_WIN); }
    else if (it < s1) { src = w_out; K = 1024; Nsrc = 1024; ntn = 16; q = it - s0; dst = (u16*)(ws + OFF_WOUT); }
    else if (it < s2) { src = w_gu; K = 1024; Nsrc = 5632; ntn = 88; q = it - s1; dst = (u16*)(ws + OFF_WGU); mode = 1; }
    else if (it < s3) { src = w_dn; K = 2816; Nsrc = 1024; ntn = 16; q = it - s2; dst = (u16*)(ws + OFF_WDN); }
    else if (it < s4) { src = p.in[29] + (size_t)e * 256 * 384; K = 256; Nsrc = 384; ntn = 6; q = it - s3; dst = (u16*)(ws + OFF_WUQ); ksc = p.in[28] + e * 256; }
    else { src = p.in[31] + (size_t)e * 128 * 768; K = 128; Nsrc = 768; ntn = 12; q = it - s4; dst = (u16*)(ws + OFF_WUKV); ksc = p.in[30] + e * 128; }
    convT_tile(lds, src, K, Nsrc, dst, q / ntn, q % ntn, mode, ksc);
  }
}
DI void ph_layer_start(const Params& p, char* lds, int layer) {
  char* ws = p.ws;
  const float* hl = layer == 0 ? p.in[0] : p.out;
  const float* hc = layer == 0 ? p.in[2] : (const float*)(ws + OFF_HCTX);
  ph_norm(hl, hc, TA, p.in[6] + layer * 1024, (const float*)(ws + OFF_MOD) + (size_t)layer * 9 * 6144, 0, 1, (u16*)(ws + OFF_HN));
}

DI void ph_hy_short(const Params& p, char* lds, int e) {
  u16* sU = (u16*)lds; u16* sX = sU + 64 * 72;
  const int tid = tid_l();
  const u16* zhy = (const u16*)(p.ws + OFF_ZHY);
  const float* sw = p.in[14] + (size_t)e * 3 * 1536; const float* sb = p.in[15] + e * 1536;
  const int cc = bid_l() & 7, rank = bid_l() >> 3, nbc = ((int)gridDim.x + 7 - cc) >> 3;
  float wa[3][8], wb[3][8], wc[3][8], bb[3][8];
#pragma unroll
  for (int sct = 0; sct < 3; ++sct) {
    const int col = sct * 512 + cc * 64 + (tid & 7) * 8;
#pragma unroll
    for (int q = 0; q < 2; ++q) {
      const float4 a = *(const float4*)(sw + col + 4 * q), b2 = *(const float4*)(sw + 1536 + col + 4 * q), c2 = *(const float4*)(sw + 3072 + col + 4 * q), d2 = *(const float4*)(sb + col + 4 * q);
      wa[sct][4 * q] = a.x; wa[sct][4 * q + 1] = a.y; wa[sct][4 * q + 2] = a.z; wa[sct][4 * q + 3] = a.w;
      wb[sct][4 * q] = b2.x; wb[sct][4 * q + 1] = b2.y; wb[sct][4 * q + 2] = b2.z; wb[sct][4 * q + 3] = b2.w;
      wc[sct][4 * q] = c2.x; wc[sct][4 * q + 1] = c2.y; wc[sct][4 * q + 2] = c2.z; wc[sct][4 * q + 3] = c2.w;
      bb[sct][4 * q] = d2.x; bb[sct][4 * q + 1] = d2.y; bb[sct][4 * q + 2] = d2.z; bb[sct][4 * q + 3] = d2.w;
    }
  }
  for (int jp = rank; jp < 512 + 32; jp += nbc) {
    int b, tt, L; size_t rowbase; u16 *ud, *xd;
    if (jp < 512) { b = jp >> 6; tt = jp & 63; L = 4096; rowbase = (size_t)b * 4096;
      ud = (u16*)(p.ws + OFF_UT) + (size_t)b * 512 * 4096; xd = (u16*)(p.ws + OFF_X0T) + (size_t)b * 512 * 4096; }
    else { const int q = jp - 512; b = q >> 2; tt = q & 3; L = 256; rowbase = (size_t)TL + (size_t)b * 256;
      ud = (u16*)(p.ws + OFF_UTC) + (size_t)b * 512 * 256; xd = (u16*)(p.ws + OFF_X0TC) + (size_t)b * 512 * 256; }
    {
      const int cg = tid & 7, tp = tid >> 3;
      const int ch0 = cc * 64 + cg * 8;
      const int t0 = tt * 64 + tp * 2;
      float zc[3][2][8];
#pragma unroll
      for (int sct = 0; sct < 3; ++sct) {
        const int col = sct * 512 + ch0;
        u32x4 zv[4];
#pragma unroll
        for (int k = 0; k < 4; ++k) {
          const int t = t0 - 1 + k;
          zv[k] = (t >= 0 && t < L) ? *(const u32x4*)(zhy + (rowbase + t) * 1536 + col) : (u32x4){0u, 0u, 0u, 0u};
        }
#pragma unroll
        for (int k = 0; k < 2; ++k)
#pragma unroll
          for (int i = 0; i < 8; ++i) {
            const float pv = (i & 1) ? bfhi(zv[k][i >> 1]) : bflo(zv[k][i >> 1]);
            const float cv = (i & 1) ? bfhi(zv[k + 1][i >> 1]) : bflo(zv[k + 1][i >> 1]);
            const float nv = (i & 1) ? bfhi(zv[k + 2][i >> 1]) : bflo(zv[k + 2][i >> 1]);
            zc[sct][k][i] = pv * wa[sct][i] + cv * wb[sct][i] + nv * wc[sct][i] + bb[sct][i];
          }
      }
#pragma unroll
      for (int k = 0; k < 2; ++k)
#pragma unroll
        for (int i = 0; i < 8; ++i) {
          sU[(cg * 8 + i) * 72 + tp * 2 + k] = f2bf(zc[1][k][i] * zc[2][k][i]);
          sX[(cg * 8 + i) * 72 + tp * 2 + k] = f2bf(zc[0][k][i]);
        }
    }
    __syncthreads();
    {
      const int cr = tid >> 2, tq2 = (tid & 3) * 16;
      const size_t o = (size_t)(cc * 64 + cr) * L + tt * 64 + tq2;
      const uint4* su = (const uint4*)(sU + cr * 72 + tq2); const uint4* sx = (const uint4*)(sX + cr * 72 + tq2);
      uint4* du = (uint4*)(ud + o); uint4* dx = (uint4*)(xd + o);
      du[0] = su[0]; du[1] = su[1]; dx[0] = sx[0]; dx[1] = sx[1];
    }
    __syncthreads();
  }
}

DI void ph_hy_long(const Params& p, char* lds, int e) {
  constexpr int UR = 5128;
  u16* sUu = (u16*)lds;
  u16* sF0 = sUu + 4 * UR;
  u16* sF1 = sF0 + 8224;
  float* sRed = (float*)(sF1 + 8200);
  const int tid = tid_l(), lane = tid & 63, w = tid >> 6, l31 = lane & 31, h = lane >> 5;
  const float* psum = (const float*)(p.ws + OFF_PSUM);
  const float* skip = p.in[23] + e * 512;
  {
    unsigned z0 = 0u;
    asm volatile("" : "+v"(z0));
    const u32x4 zz = {z0, z0, z0, z0};
    for (int i = tid; i < 4 * 129; i += 256) {
      const int b = i / 129, q = i % 129;
      const int off = q < 64 ? q * 8 : 512 + 4096 + (q - 64) * 8;
      *(u32x4*)(sUu + b * UR + off) = zz;
    }
  }
  __syncthreads();
  for (int it = bid_l(); it < 1024; it += gridDim.x) {
    const int c = it >> 1, bh = it & 1;
    {
      float v = psum[(size_t)tid * 1024 + c] + psum[(size_t)tid * 1024 + 512 + c];
      v = wave_sum(v);
      if (lane == 0) sRed[w] = v;
    }
    {
      const u16* ut = (const u16*)(p.ws + OFF_UT);
      for (int i = tid; i < 4 * 512; i += 256) {
        const int b = i >> 9, q = i & 511;
        *(u32x4*)(sUu + b * UR + 512 + q * 8) = *(const u32x4*)(ut + ((size_t)(bh * 4 + b) * 512 + c) * 4096 + q * 8);
      }
      const u16* R0 = (const u16*)(p.ws + OFF_FR0) + (size_t)c * 8192; const u16* R1 = (const u16*)(p.ws + OFF_FR1) + (size_t)c * 8192;
      for (int i = tid; i < 1024; i += 256) { *(u32x4*)(sF0 + i * 8) = *(const u32x4*)(R0 + i * 8); *(u32x4*)(sF1 + i * 8) = *(const u32x4*)(R1 + i * 8); }
    }
    __syncthreads();
    const float inv = 1.f / (sRed[0] + sRed[1] + sRed[2] + sRed[3]);
    f32x16 acc[2][2];
#pragma unroll
    for (int i = 0; i < 2; ++i)
#pragma unroll
      for (int j = 0; j < 2; ++j) acc[i][j] = zero16();
    const int ci = elem_of(l31);
    const int par = (4095 - ci) & 1;
    const u16* fl = (par ? sF1 : sF0) + (4095 - ci + 8 * h - par);
    const int Tl = l31 >> 2, bl = l31 & 3;
    const u16* ub = sUu + bl * UR + 512 + 64 * Tl + 8 * h;
    const int wsc = __builtin_amdgcn_readfirstlane(w);
#define HY_BODY(V0_, V1_)                                                                                      \
    {                                                                                                          \
      const u16* fd = fl - 64 * dl;                                                                            \
      const u16* u0 = ub + 64 * (16 * wsc - dl);                                                               \
      _Pragma("unroll") for (int kk = 0; kk < 4; ++kk) {                                                       \
        bf16x8 af[2];                                                                                          \
        _Pragma("unroll") for (int mi = 0; mi < 2; ++mi) {                                                     \
          const unsigned* fp = (const unsigned*)(fd - 32 * mi + 16 * kk);                                      \
          u32x4 q = {fp[0], fp[1], fp[2], fp[3]};                                                              \
          af[mi] = __builtin_bit_cast(bf16x8, q);                                                              \
        }                                                                                                      \
        if (V0_) { const bf16x8 bb = *(const bf16x8*)(u0 + kk * 16);       acc[0][0] = MFMA32(af[0], bb, acc[0][0]); acc[1][0] = MFMA32(af[1], bb, acc[1][0]); } \
        if (V1_) { const bf16x8 bb = *(const bf16x8*)(u0 + 512 + kk * 16); acc[0][1] = MFMA32(af[0], bb, acc[0][1]); acc[1][1] = MFMA32(af[1], bb, acc[1][1]); } \
      }                                                                                                        \
    }
    {
      const int a0 = 16 * wsc - 63 < -63 ? -63 : 16 * wsc - 63, a1 = 16 * wsc - 56;
      for (int dl = a0; dl <= a1; ++dl) HY_BODY(true, false)
      const int b0 = 16 * wsc - 55 < -63 ? -63 : 16 * wsc - 55, b1 = 16 * wsc + 7;
      for (int dl = b0; dl <= b1; ++dl) HY_BODY(true, true)
      const int c0 = 16 * wsc + 8, c1 = 16 * wsc + 15 > 63 ? 63 : 16 * wsc + 15;
      for (int dl = c0; dl <= c1; ++dl) HY_BODY(false, true)
    }
#undef HY_BODY
    int Tl_e = Tl, h_e = h;
    asm volatile("" : "+v"(Tl_e), "+v"(h_e));
    const float sk = skip[c];
    const int b = bh * 4 + bl;
    const u16* x0t = (const u16*)(p.ws + OFF_X0T) + ((size_t)b * 512 + c) * 4096;
    u16* ytp = (u16*)(p.ws + OFF_YT) + ((size_t)b * 512 + c) * 4096;
#pragma unroll
    for (int mi = 0; mi < 2; ++mi)
#pragma unroll
      for (int nf = 0; nf < 2; ++nf) {
        const int T = 16 * w + 8 * nf + Tl_e;
        asm volatile("" ::: "memory");
#pragma unroll
        for (int gp = 0; gp < 2; ++gp) {
          const int t = 64 * T + mi * 32 + 16 * h_e + 8 * gp;
          const u32x4 uu = *(const u32x4*)(sUu + bl * UR + 512 + t);
          const u32x4 xx = *(const u32x4*)(x0t + t);
          float y[8];
#pragma unroll
          for (int q = 0; q < 4; ++q) {
            y[2 * q] = bflo(xx[q]) * (acc[mi][nf][8 * gp + 2 * q] * inv + sk * bflo(uu[q]));
            y[2 * q + 1] = bfhi(xx[q]) * (acc[mi][nf][8 * gp + 2 * q + 1] * inv + sk * bfhi(uu[q]));
          }
          *(u32x4*)(ytp + t) = (u32x4){pack2(y[0], y[1]), pack2(y[2], y[3]), pack2(y[4], y[5]), pack2(y[6], y[7])};
        }
      }
    __syncthreads();
  }
  {
    const u16* FC = (const u16*)(p.ws + OFF_FCTX);
    const u16* utc = (const u16*)(p.ws + OFF_UTC); const u16* x0c = (const u16*)(p.ws + OFF_X0TC); u16* ytc = (u16*)(p.ws + OFF_YTC);
    const int total = 8 * 512 * 32;
    for (int i = bid_l() * 256 + tid; i < total; i += gridDim.x * 256) {
      const int tb = i & 31, c = (i >> 5) & 511, b = i >> 14;
      float nrm = 0.f;
#pragma unroll 4
      for (int q = 256; q < 272; ++q) nrm += psum[(size_t)q * 1024 + c] + psum[(size_t)q * 1024 + 512 + c];
      const u16* uu = utc + ((size_t)b * 512 + c) * 256;
      const u16* ff = FC + (size_t)c * 512;
      float y[8];
#pragma unroll
      for (int k = 0; k < 8; ++k) y[k] = 0.f;
      u32x4 hi = *(const u32x4*)(ff + (32 + tb) * 8);
      for (int sb = 0; sb < 32; ++sb) {
        const u32x4 lo = *(const u32x4*)(ff + (31 + tb - sb) * 8);
        const u32x4 uv = *(const u32x4*)(uu + sb * 8);
        float f[16], u8[8];
#pragma unroll
        for (int q = 0; q < 4; ++q) { f[2 * q] = bflo(lo[q]); f[2 * q + 1] = bfhi(lo[q]); f[8 + 2 * q] = bflo(hi[q]); f[9 + 2 * q] = bfhi(hi[q]); u8[2 * q] = bflo(uv[q]); u8[2 * q + 1] = bfhi(uv[q]); }
#pragma unroll
        for (int k = 0; k < 8; ++k)
#pragma unroll
          for (int j = 0; j < 8; ++j) y[k] += f[8 + k - j] * u8[j];
        hi = lo;
      }
      const float inv = 1.f / nrm, sk = skip[c];
      const u32x4 ut = *(const u32x4*)(uu + tb * 8);
      const u32x4 xv = *(const u32x4*)(x0c + ((size_t)b * 512 + c) * 256 + tb * 8);
      float o[8];
#pragma unroll
      for (int q = 0; q < 4; ++q) {
        o[2 * q] = bflo(xv[q]) * (y[2 * q] * inv + sk * bflo(ut[q]));
        o[2 * q + 1] = bfhi(xv[q]) * (y[2 * q + 1] * inv + sk * bfhi(ut[q]));
      }
      *(u32x4*)(ytc + ((size_t)b * 512 + c) * 256 + tb * 8) = (u32x4){pack2(o[0], o[1]), pack2(o[2], o[3]), pack2(o[4], o[5]), pack2(o[6], o[7])};
    }
  }
}

DI float hg_lb(const Params& p, int e, int dir, int j) {
  if (e == 0) return 0.f;
  const float a0 = p.in[12][(0 * 2 + dir) * 512 + j], a1 = p.in[12][(1 * 2 + dir) * 512 + j];
  return 1.f / (1.f + expf(a0 - a1));
}
DI size_t hg_row(int b, int dir, int c, int s) {
  if (c < 4) { const int pp = 64 * c + s; return (size_t)TL + (size_t)b * 256 + (dir ? 255 - pp : pp); }
  const int pp = 64 * (c - 4) + s; return (size_t)b * 4096 + (dir ? 4095 - pp : pp);
}

DI void ph_hg1(const Params& p, char* lds, int e) {
  u16* sKe = (u16*)lds;
  u16* sVt = sKe + 128 * 72;
  u16* sF = sVt + 128 * 72;
  u16* sV = sF + 64 * 136;
  const int tid = tid_l(), lane = tid & 63, w = tid >> 6, l31 = lane & 31, h = lane >> 5;
  const u16* z = (const u16*)(p.ws + OFF_ZA);
  u16* st = (u16*)(p.ws + OFF_ST); float* dbuf = (float*)(p.ws + OFF_DBUF);
  {
    u16* sT = (u16*)lds;
    u16* mix = (u16*)(p.ws + OFF_MIXE);
    const int nlat = 8 * 64 * 8, nall = nlat + 8 * 4 * 8;
    for (int it = bid_l(); it < nall; it += gridDim.x) {
      int b, tt, cc, L; size_t rowbase; const u16* src;
      if (it < nlat) { b = it >> 9; tt = (it >> 3) & 63; cc = it & 7; L = 4096; rowbase = (size_t)b * 4096; src = (const u16*)(p.ws + OFF_YT) + (size_t)b * 512 * 4096; }
      else { const int q = it - nlat; b = q >> 5; tt = (q >> 3) & 3; cc = q & 7; L = 256; rowbase = (size_t)TL + (size_t)b * 256; src = (const u16*)(p.ws + OFF_YTC) + (size_t)b * 512 * 256; }
      {
        const int cr = tid >> 2, tq = (tid & 3) * 16;
        const u32x4* sp = (const u32x4*)(src + (size_t)(cc * 64 + cr) * L + tt * 64 + tq);
        *(u32x4*)(sT + cr * 72 + tq) = sp[0];
        *(u32x4*)(sT + cr * 72 + tq + 8) = sp[1];
      }
      __syncthreads();
      {
        const int t = tid >> 2, cq = (tid & 3) * 16;
        unsigned o[8];
#pragma unroll
        for (int q = 0; q < 8; ++q) o[q] = (unsigned)sT[(cq + 2 * q) * 72 + t] | ((unsigned)sT[(cq + 2 * q + 1) * 72 + t] << 16);
        u32x4* dp = (u32x4*)(mix + (rowbase + tt * 64 + t) * D + 512 + cc * 64 + cq);
        dp[0] = (u32x4){o[0], o[1], o[2], o[3]};
        dp[1] = (u32x4){o[4], o[5], o[6], o[7]};
      }
      __syncthreads();
    }
  }
  for (int it = bid_l(); it < 64 * 68; it += gridDim.x) {
    const int seq = it / 68, c = it % 68;
    const int dir = seq & 1, hh = (seq >> 1) & 3, b = seq >> 3;
#pragma unroll
    for (int j = 0; j < 4; ++j) {
      const int i = tid + 256 * j, r = i >> 4, ch = i & 15;
      const u16* zr = z + hg_row(b, dir, c, r) * 2560 + hh * 128 + ch * 8;
      *(u32x4*)(sF + r * 136 + ch * 8) = *(const u32x4*)(zr + 512 + dir * 512);
      *(u32x4*)(sV + r * 136 + ch * 8) = *(const u32x4*)(zr + 1536);
    }
    __syncthreads();
    if (tid < 128) {
      const int d = tid;
      const int dc = d & 63, dslot = (d & 64) + ((dc >> 2) & 1) * 32 + (dc >> 4) * 8 + ((dc >> 3) & 1) * 4 + (dc & 3);
      const float lb = hg_lb(p, e, dir, hh * 128 + d);
      float P = 1.f;
      for (int s = 63; s >= 0; --s) {
        const float zf = bf2f(sF[s * 136 + d]);
        const float f = lb + (1.f - lb) * sigm(zf);
        sKe[dslot * 72 + s] = f2bf((1.f - f) * P);
        P *= f;
      }
      dbuf[(size_t)(seq * 68 + c) * 128 + d] = P;
    } else {
      const int ee = tid - 128;
      for (int s = 0; s < 64; ++s) sVt[ee * 72 + s] = sV[s * 136 + ee];
    }
    __syncthreads();
    f32x16 acc[4];
#pragma unroll
    for (int i = 0; i < 4; ++i) acc[i] = zero16();
#pragma unroll
    for (int kk = 0; kk < 4; ++kk) {
      const bf16x8 af = *(const bf16x8*)(sVt + (32 * w + l31) * 72 + kk * 16 + 8 * h);
#pragma unroll
      for (int nf = 0; nf < 4; ++nf) {
        const bf16x8 bb = *(const bf16x8*)(sKe + (nf * 32 + l31) * 72 + kk * 16 + 8 * h);
        acc[nf] = MFMA32(bb, af, acc[nf]);
      }
    }
    u16* dst = st + (size_t)(seq * 68 + c) * 16384 + (32 * w + l31) * 128;
#pragma unroll
    for (int grp = 0; grp < 2; ++grp)
#pragma unroll
      for (int g4 = 0; g4 < 4; ++g4)
        *(u32x4*)(dst + grp * 64 + 16 * g4 + 8 * h) = (u32x4){pack2(acc[2 * grp][4 * g4], acc[2 * grp][4 * g4 + 1]), pack2(acc[2 * grp][4 * g4 + 2], acc[2 * grp][4 * g4 + 3]),
                                                              pack2(acc[2 * grp + 1][4 * g4], acc[2 * grp + 1][4 * g4 + 1]), pack2(acc[2 * grp + 1][4 * g4 + 2], acc[2 * grp + 1][4 * g4 + 3])};
    __syncthreads();
  }
}

DI void ph_hg2(const Params& p) {
  u16* st = (u16*)(p.ws + OFF_ST); const float* dbuf = (const float*)(p.ws + OFF_DBUF);
  for (int i = bid_l() * 256 + tid_l(); i < 64 * 128 * 16; i += gridDim.x * 256) {
    const int dg = i & 15, ee = (i >> 4) & 127, seq = i >> 11;
    float S[8];
#pragma unroll
    for (int j = 0; j < 8; ++j) S[j] = 0.f;
    u32x4* base = (u32x4*)(st + ((size_t)(seq * 68) * 128 + ee) * 128 + dg * 8);
    const float* dp = dbuf + (size_t)(seq * 68) * 128 + dg * 8;
    u32x4 l0 = base[0], l1 = base[2048], l2 = base[2 * 2048];
    for (int c = 0; c < 68; ++c) {
      u32x4 l3 = l2;
      if (c + 3 < 68) l3 = base[(size_t)(c + 3) * 2048];
      const float4 d0 = *(const float4*)(dp + c * 128);
      const float4 d1 = *(const float4*)(dp + c * 128 + 4);
      base[(size_t)c * 2048] = (u32x4){pack2(S[0], S[1]), pack2(S[2], S[3]), pack2(S[4], S[5]), pack2(S[6], S[7])};
      const float dd[8] = {d0.x, d0.y, d0.z, d0.w, d1.x, d1.y, d1.z, d1.w};
#pragma unroll
      for (int j = 0; j < 8; ++j) {
        const unsigned wv = l0[j >> 1];
        const float L = __uint_as_float((j & 1) ? (wv & 0xffff0000u) : (wv << 16));
        S[j] = dd[j] * S[j] + L;
      }
      l0 = l1; l1 = l2; l2 = l3;
    }
  }
}

DI void ph_hg3(const Params& p, char* lds, int e) {
  u16* sQx = (u16*)lds;
  u16* sKx = sQx + 64 * 136;
  u16* sQt = sKx + 64 * 136;
  u16* sVt = sQt + 64 * 136;
  float* sRef = (float*)(sVt + 128 * 72);
  float* sRed = sRef + 128;
  const int tid = tid_l(), lane = tid & 63, w = tid >> 6, l31 = lane & 31, h = lane >> 5;
  const u16* z = (const u16*)(p.ws + OFF_ZA);
  const u16* st = (const u16*)(p.ws + OFF_ST);
  u16* mix = (u16*)(p.ws + OFF_MIXE);
  const float* gn = p.in[13] + e * 128;
  for (int it = bid_l(); it < 8 * 4 * 68; it += gridDim.x) {
    const int tc = it % 68, hh = (it / 68) & 3, b = it / (68 * 4);
    const bool isl = tc < 64;
    const size_t rowbase = isl ? (size_t)b * 4096 + tc * 64 : (size_t)TL + (size_t)b * 256 + (tc - 64) * 64;
    {
#pragma unroll
      for (int j = 0; j < 4; ++j) {
        const int i = tid + 256 * j, r = i >> 4, ch = i & 15;
        *(u32x4*)(sQx + r * 136 + ch * 8) = *(const u32x4*)(z + (rowbase + r) * 2560 + 1536 + hh * 128 + ch * 8);
      }
      __syncthreads();
      const int ee = tid & 127, sh = tid >> 7;
      const int vslot = (ee & 96) + slot_of(ee & 31);
      for (int s = sh * 32; s < sh * 32 + 32; ++s) sVt[vslot * 72 + s] = sQx[s * 136 + ee];
      __syncthreads();
    }
    f32x16 o[2]; o[0] = zero16(); o[1] = zero16();
    for (int dir = 0; dir < 2; ++dir) {
      const int cs = isl ? (dir ? 4 + (63 - tc) : 4 + tc) : (dir ? 3 - (tc - 64) : (tc - 64));
      const int seq = (b * 4 + hh) * 2 + dir;
      const int d = tid & 127, part = tid >> 7;
      const float lb = hg_lb(p, e, dir, hh * 128 + d);
      const int fcol = 512 + dir * 512 + hh * 128 + d;
#pragma unroll
      for (int j = 0; j < 4; ++j) {
        const int i = tid + 256 * j, r = i >> 4, ch = i & 15;
        const u16* zr = z + (rowbase + r) * 2560 + hh * 128 + ch * 8;
        *(u32x4*)(sQx + r * 136 + ch * 8) = *(const u32x4*)(zr);
        *(u32x4*)(sKx + r * 136 + ch * 8) = *(const u32x4*)(zr + 512 + dir * 512);
      }
      __syncthreads();
      if (part == 0) {
        float x = 0.f;
        for (int pp = 31; pp >= 0; --pp) {
          const int t = dir ? 63 - pp : pp;
          const float f = lb + (1.f - lb) * sigm(bf2f(sKx[t * 136 + d]));
          const float xc = fminf(x, 80.f);
          const float q = bf2f(sQx[t * 136 + d]);
          sQx[t * 136 + d] = f2bf(q * __expf(xc));
          sKx[t * 136 + d] = f2bf((1.f - f) * __expf(-xc));
          x -= __logf(f);
        }
        sRef[d] = __expf(-x);
      } else {
        float run = 0.f;
        for (int pp = 32; pp < 64; ++pp) {
          const int t = dir ? 63 - pp : pp;
          const float f = lb + (1.f - lb) * sigm(bf2f(sKx[t * 136 + d]));
          run += __logf(f);
          const float xc = fmaxf(run, -80.f);
          const float q = bf2f(sQx[t * 136 + d]);
          sQx[t * 136 + d] = f2bf(q * __expf(xc));
          sKx[t * 136 + d] = f2bf((1.f - f) * __expf(-xc));
        }
      }
      __syncthreads();
      f32x16 at[2][2];
#pragma unroll
      for (int i = 0; i < 2; ++i)
#pragma unroll
        for (int j = 0; j < 2; ++j) at[i][j] = zero16();
#pragma unroll
      for (int kk = 0; kk < 8; ++kk) {
        bf16x8 ka[2], qb[2];
#pragma unroll
        for (int mf = 0; mf < 2; ++mf) ka[mf] = *(const bf16x8*)(sKx + (mf * 32 + l31) * 136 + kk * 16 + 8 * h);
#pragma unroll
        for (int nf = 0; nf < 2; ++nf) qb[nf] = *(const bf16x8*)(sQx + (nf * 32 + l31) * 136 + kk * 16 + 8 * h);
#pragma unroll
        for (int mf = 0; mf < 2; ++mf)
#pragma unroll
          for (int nf = 0; nf < 2; ++nf) at[mf][nf] = MFMA32(ka[mf], qb[nf], at[mf][nf]);
      }
#pragma unroll
      for (int mf = 0; mf < 2; ++mf)
#pragma unroll
        for (int nf = 0; nf < 2; ++nf)
#pragma unroll
          for (int r = 0; r < 16; ++r) {
            const int s = mf * 32 + crow(r, h), t = nf * 32 + l31;
            const bool valid = dir ? (s >= t) : (s <= t);
            at[mf][nf][r] = valid ? at[mf][nf][r] : 0.f;
          }
#pragma unroll
      for (int mf = 0; mf < 2; ++mf)
#pragma unroll
        for (int ks = 0; ks < 2; ++ks) {
          const int kb = mf * 32 + ks * 16 + 4 * h;
          const s16x4 lo = *(const s16x4*)(sVt + (32 * w + l31) * 72 + kb);
          const s16x4 hi = *(const s16x4*)(sVt + (32 * w + l31) * 72 + kb + 8);
          const bf16x8 vf = __builtin_shufflevector(lo, hi, 0, 1, 2, 3, 4, 5, 6, 7);
#pragma unroll
          for (int nf = 0; nf < 2; ++nf) o[nf] = MFMA32(vf, pack8(at[mf][nf], ks), o[nf]);
        }
      const u16* sp = st + ((size_t)(seq * 68 + cs) * 128 + 32 * w + elem_of(l31)) * 128 + 8 * h;
#pragma unroll
      for (int kk = 0; kk < 8; ++kk) {
        const u32x4 sraw = *(const u32x4*)(sp + kk * 16);
        const float4 e0 = *(const float4*)(sRef + kk * 16 + 8 * h), e1 = *(const float4*)(sRef + kk * 16 + 8 * h + 4);
        const u32x4 ssc = {pack2(bflo(sraw[0]) * e0.x, bfhi(sraw[0]) * e0.y), pack2(bflo(sraw[1]) * e0.z, bfhi(sraw[1]) * e0.w),
                           pack2(bflo(sraw[2]) * e1.x, bfhi(sraw[2]) * e1.y), pack2(bflo(sraw[3]) * e1.z, bfhi(sraw[3]) * e1.w)};
        const bf16x8 sf = __builtin_bit_cast(bf16x8, ssc);
#pragma unroll
        for (int nf = 0; nf < 2; ++nf) {
          const bf16x8 qb = *(const bf16x8*)(sQx + (nf * 32 + l31) * 136 + kk * 16 + 8 * h);
          o[nf] = MFMA32(sf, qb, o[nf]);
        }
      }
      __syncthreads();
    }
#pragma unroll
    for (int nf = 0; nf < 2; ++nf) {
      float ss = 0.f;
#pragma unroll
      for (int r = 0; r < 16; ++r) ss += o[nf][r] * o[nf][r];
      ss += __shfl_xor(ss, 32);
      if (h == 0) sRed[w * 64 + nf * 32 + l31] = ss;
    }
    __syncthreads();
#pragma unroll
    for (int nf = 0; nf < 2; ++nf) {
      const int t = nf * 32 + l31;
      const float tot = sRed[t] + sRed[64 + t] + sRed[128 + t] + sRed[192 + t];
      const float rs = rsqrtf(tot * (1.f / 128.f) + 1e-6f);
      const size_t row = rowbase + t;
#pragma unroll
      for (int gp = 0; gp < 2; ++gp) {
        const int e0 = 32 * w + 16 * h + 8 * gp;
        const u32x4 gz = *(const u32x4*)(z + row * 2560 + 2048 + hh * 128 + e0);
        const float4 na = *(const float4*)(gn + e0), nb4 = *(const float4*)(gn + e0 + 4);
        const float nv[8] = {na.x, na.y, na.z, na.w, nb4.x, nb4.y, nb4.z, nb4.w};
        float v[8];
#pragma unroll
        for (int q = 0; q < 4; ++q) {
          v[2 * q] = o[nf][8 * gp + 2 * q] * rs * nv[2 * q] * siluf(bflo(gz[q]));
          v[2 * q + 1] = o[nf][8 * gp + 2 * q + 1] * rs * nv[2 * q + 1] * siluf(bfhi(gz[q]));
        }
        *(u32x4*)(mix + row * D + hh * 128 + e0) = (u32x4){pack2(v[0], v[1]), pack2(v[2], v[3]), pack2(v[4], v[5]), pack2(v[6], v[7])};
      }
    }
    __syncthreads();
  }
}

DI void vt_tile(u16* sT, const u16* src, int ld, const float* rscale, u16* dst) {
  const int tid = tid_l();
#pragma unroll
  for (int j = 0; j < 4; ++j) {
    const int i = tid + 256 * j, r = i >> 4, ch = i & 15;
    u32x4 v = *(const u32x4*)(src + (size_t)r * ld + ch * 8);
    if (rscale) {
      const float sc = rscale[r];
      v = (u32x4){pack2(bflo(v[0]) * sc, bfhi(v[0]) * sc), pack2(bflo(v[1]) * sc, bfhi(v[1]) * sc), pack2(bflo(v[2]) * sc, bfhi(v[2]) * sc), pack2(bflo(v[3]) * sc, bfhi(v[3]) * sc)};
    }
    *(u32x4*)(sT + r * 136 + ch * 8) = v;
  }
  __syncthreads();
  {
    const int ee = tid >> 1, ph = tid & 1;
    unsigned o[16];
#pragma unroll
    for (int q = 0; q < 16; ++q) o[q] = (unsigned)sT[(ph * 32 + 2 * q) * 136 + ee] | ((unsigned)sT[(ph * 32 + 2 * q + 1) * 136 + ee] << 16);
    u32x4* dp = (u32x4*)(dst + (size_t)ee * KPOS + ph * 32);
#pragma unroll
    for (int q = 0; q < 4; ++q) dp[q] = (u32x4){o[4 * q], o[4 * q + 1], o[4 * q + 2], o[4 * q + 3]};
  }
  __syncthreads();
}

DI void ph_odd_prepA(const Params& p, char* lds) {
  const int tid = tid_l(), lane = tid & 63;
  float* tS = (float*)lds;
  float* tC = tS + 1024;
  u16* sT = (u16*)(tC + 1024);
  const u16* z = (const u16*)(p.ws + OFF_ZO);
  u16* Qa = (u16*)(p.ws + OFF_QA); u16* Qac = (u16*)(p.ws + OFF_QAC); u16* Ka = (u16*)(p.ws + OFF_KA);
  float* rsq = (float*)(p.ws + OFF_RSQ); float* rskv = (float*)(p.ws + OFF_RSKV);
  {
    const int wid = bid_l() * 4 + (tid >> 6), nw = gridDim.x * 4;
    for (int row = wid; row < TA; row += nw) {
      const u16* zr = z + (size_t)row * 1952;
      const uint2 v = *(const uint2*)(zr + 1536 + lane * 4);
      const unsigned v2 = *(const unsigned*)(zr + 1792 + lane * 2);
      const float a0 = bflo(v.x), a1 = bfhi(v.x), a2 = bflo(v.y), a3 = bfhi(v.y), c0 = bflo(v2), c1 = bfhi(v2);
      const float sq = wave_sum(a0 * a0 + a1 * a1 + a2 * a2 + a3 * a3);
      const float sk = wave_sum(c0 * c0 + c1 * c1);
      if (lane == 0) { rsq[row] = rsqrtf(sq * (1.f / 256.f) + 1e-6f); rskv[row] = rsqrtf(sk * (1.f / 128.f) + 1e-6f); }
    }
  }
  {
    u16* Vta = (u16*)(p.ws + OFF_VTA);
    for (int it = bid_l(); it < 8 * 4 * 68; it += gridDim.x) {
      const int pt = it % 68, bh = it / 68, b = bh >> 2, hh = bh & 3;
      const int pos0 = pt * 64;
      const size_t rb = pos0 < 4096 ? (size_t)b * 4096 + pos0 : (size_t)TL + (size_t)b * 256 + (pos0 - 4096);
      vt_tile(sT, z + rb * 1952 + 1024 + hh * 128, 1952, nullptr, Vta + (size_t)bh * 128 * KPOS + pos0);
    }
  }
  {
    GemmDesc g1{z + 1536, 1952, (const u16*)(p.ws + W2_DELTA + OFF_WUQ), 256, TA, 384, 256};
    gemm_phase(lds, g1, EpiStore{(u16*)(p.ws + OFF_UPQ), 384, 384});
    GemmDesc g2{z + 1792, 1952, (const u16*)(p.ws + W2_DELTA + OFF_WUKV), 128, TA, 768, 128};
    gemm_phase(lds, g2, EpiStore{(u16*)(p.ws + OFF_UPKV), 768, 768});
  }
}

DI void ph_odd_prepB(const Params& p, char* lds) {
  const int tid = tid_l();
  float* tS = (float*)lds;
  float* tC = tS + 512;
  u16* sT = (u16*)(tC + 512);
  const u16* z = (const u16*)(p.ws + OFF_ZO);
  const u16* upq = (const u16*)(p.ws + OFF_UPQ); const u16* upkv = (const u16*)(p.ws + OFF_UPKV);
  const float* rsq = (const float*)(p.ws + OFF_RSQ); const float* rskv = (const float*)(p.ws + OFF_RSKV);
  u16* Qm = (u16*)(p.ws + OFF_QM); u16* Qmc = (u16*)(p.ws + OFF_QMC); u16* Km = (u16*)(p.ws + OFF_KM); u16* Vtm = (u16*)(p.ws + OFF_VTM);
  for (int i = tid; i < 512; i += 256) {
    const float inv = exp2f(-(float)(i & 7) * (13.287712379549449f / 8.f));
    const float a = (float)(i >> 3) * inv;
    tS[i] = sinf(a); tC[i] = cosf(a);
  }
  __syncthreads();
  for (int u = bid_l() * 256 + tid; u < TA * 96; u += gridDim.x * 256) {
    const int row = u / 96, chunk = u - row * 96;
    const bool isk = chunk >= 48;
    const int c2 = isk ? chunk - 48 : chunk;
    const int hm = c2 / 12, cc = c2 - hm * 12;
    const bool isl = row < TL;
    const int b = isl ? row >> 12 : (row - TL) >> 8;
    const int t = isl ? row & 4095 : (row - TL) & 255;
    const float rq = rsq[row], rk = rskv[row];
    u32x4 o;
    if (cc < 8) {
      const u32x4 v = isk ? *(const u32x4*)(upkv + (size_t)row * 768 + hm * 192 + cc * 8) : *(const u32x4*)(upq + (size_t)row * 384 + hm * 96 + cc * 8);
      const float sc = isk ? rk : rq;
#pragma unroll
      for (int q = 0; q < 4; ++q) o[q] = pack2(bflo(v[q]) * sc, bfhi(v[q]) * sc);
    } else {
      const int rc = cc - 8, grp = rc >> 1, second = rc & 1;
      u32x4 x1, x2; float sc;
      if (isk) { const u16* kr = z + (size_t)row * 1952 + 1920 + grp * 16; x1 = *(const u32x4*)(kr); x2 = *(const u32x4*)(kr + 8); sc = 1.f; }
      else { const u16* qr = upq + (size_t)row * 384 + hm * 96 + 64 + grp * 16; x1 = *(const u32x4*)(qr); x2 = *(const u32x4*)(qr + 8); sc = rq; }
      if (isl) {
        const int pos = grp ? (t & 63) : (t >> 6);
        const float* sp = tS + pos * 8; const float* cp = tC + pos * 8;
#pragma unroll
        for (int q = 0; q < 4; ++q) {
          const float a0 = bflo(x1[q]) * sc, a1 = bfhi(x1[q]) * sc, b0 = bflo(x2[q]) * sc, b1 = bfhi(x2[q]) * sc;
          const float s0 = sp[2 * q], s1 = sp[2 * q + 1], c0 = cp[2 * q], c1 = cp[2 * q + 1];
          o[q] = second ? pack2(b0 * c0 + a0 * s0, b1 * c1 + a1 * s1) : pack2(a0 * c0 - b0 * s0, a1 * c1 - b1 * s1);
        }
      } else {
        const u32x4 xs = second ? x2 : x1;
#pragma unroll
        for (int q = 0; q < 4; ++q) o[q] = pack2(bflo(xs[q]) * sc, bfhi(xs[q]) * sc);
      }
    }
    u16* dst;
    if (isk) dst = Km + ((size_t)(b * 4 + hm) * KPOS + (isl ? t : 4096 + t)) * 96 + cc * 8;
    else dst = isl ? Qm + ((size_t)(b * 4 + hm) * 4096 + t) * 96 + cc * 8 : Qmc + ((size_t)(b * 4 + hm) * 256 + t) * 96 + cc * 8;
    *(u32x4*)dst = o;
  }
  for (int it = bid_l(); it < 8 * 4 * 68; it += gridDim.x) {
    const int pt = it % 68, bh = it / 68, b = bh >> 2, hm = bh & 3;
    const int pos0 = pt * 64;
    const size_t rb = pos0 < 4096 ? (size_t)b * 4096 + pos0 : (size_t)TL + (size_t)b * 256 + (pos0 - 4096);
    vt_tile(sT, upkv + rb * 768 + hm * 192 + 64, 768, rskv + rb, Vtm + (size_t)bh * 128 * KPOS + pos0);
  }
}

template <int DQ>
DI void attn_item(char* lds, const u16* __restrict__ Qb, const u16* __restrict__ Kb, const u16* __restrict__ Vtb,
                  int q0, int kt_lo, int kt_hi, float sc, u16* __restrict__ Ob, int ldo) {
  constexpr int KS = DQ + 8, KCH = DQ / 8, KPT = 64 * KCH / 256, NKK = DQ / 16;
  u16* sK = (u16*)lds;
  u16* sV = sK + 64 * KS;
  const int tid = tid_l(), lane = tid & 63, w = tid >> 6, l31 = lane & 31, h = lane >> 5;
  bf16x8 qf[NKK];
  {
    const u16* qrow = Qb + (size_t)(q0 + w * 32 + l31) * DQ + h * 8;
#pragma unroll
    for (int kk = 0; kk < NKK; ++kk) qf[kk] = *(const bf16x8*)(qrow + kk * 16);
  }
  u32x4 rk[KPT], rv[4];
#define ATT_LOAD(kt_)                                                                                   \
  {                                                                                                     \
    _Pragma("unroll") for (int j = 0; j < KPT; ++j) {                                                   \
      const int idx = tid + 256 * j; const int r = idx / KCH, cch = idx % KCH;                          \
      rk[j] = *(const u32x4*)(Kb + (size_t)((kt_) * 64 + r) * DQ + cch * 8);                            \
    }                                                                                                   \
    _Pragma("unroll") for (int j = 0; j < 4; ++j) {                                                     \
      const int idx = tid + 256 * j; const int ee = idx >> 3, cch = idx & 7;                            \
      rv[j] = *(const u32x4*)(Vtb + (size_t)ee * KPOS + (kt_) * 64 + cch * 8);                          \
    }                                                                                                   \
  }
  f32x16 o[4];
#pragma unroll
  for (int i = 0; i < 4; ++i) o[i] = zero16();
  float m_run = -INFINITY, l_run = 0.f;
  constexpr int STG = 64 * KS + 128 * 72;
#define ATT_STORE(st_)                                                                                  \
  {                                                                                                     \
    u16* dK = (u16*)lds + (st_) * STG; u16* dV = dK + 64 * KS;                                          \
    _Pragma("unroll") for (int j = 0; j < KPT; ++j) { const int idx = tid + 256 * j; const int r = idx / KCH, cch = idx % KCH; *(u32x4*)(dK + r * KS + cch * 8) = rk[j]; } \
    _Pragma("unroll") for (int j = 0; j < 4; ++j) { const int idx = tid + 256 * j; const int ee = idx >> 3, cch = idx & 7; u16* vr_ = dV + ((ee & 96) + slot_of(ee & 31)) * 72 + (cch >> 1) * 16 + (cch & 1) * 4; *(u32x2_t*)(vr_) = (u32x2_t){rv[j][0], rv[j][1]}; *(u32x2_t*)(vr_ + 8) = (u32x2_t){rv[j][2], rv[j][3]}; } \
  }
  ATT_LOAD(kt_lo)
  ATT_STORE(0)
  if (kt_lo + 1 < kt_hi) ATT_LOAD(kt_lo + 1)
  for (int kt = kt_lo; kt < kt_hi; ++kt) {
    __syncthreads();
    const int cur = (kt - kt_lo) & 1;
    sK = (u16*)lds + cur * STG; sV = sK + 64 * KS;
    if (kt + 1 < kt_hi) {
      ATT_STORE(cur ^ 1)
      if (kt + 2 < kt_hi) ATT_LOAD(kt + 2)
    }
    f32x16 s0 = zero16(), s1 = zero16();
#pragma unroll
    for (int kk = 0; kk < NKK; ++kk) {
      const bf16x8 k0 = *(const bf16x8*)(sK + l31 * KS + kk * 16 + h * 8);
      const bf16x8 k1 = *(const bf16x8*)(sK + (32 + l31) * KS + kk * 16 + h * 8);
      s0 = MFMA32(k0, qf[kk], s0);
      s1 = MFMA32(k1, qf[kk], s1);
    }
    float mx = fmaxf(fmaxf(s0[0], s0[1]), s0[2]);
#pragma unroll
    for (int r = 3; r < 15; r += 2) mx = fmaxf(fmaxf(mx, s0[r]), s0[r + 1]);
    mx = fmaxf(fmaxf(mx, s0[15]), s1[0]);
#pragma unroll
    for (int r = 1; r < 15; r += 2) mx = fmaxf(fmaxf(mx, s1[r]), s1[r + 1]);
    mx = fmaxf(mx, s1[15]);
    mx = fmaxf(mx, __shfl_xor(mx, 32));
    const float m_new = fmaxf(m_run, mx * sc);
    if (__builtin_amdgcn_ballot_w64(m_new > m_run) != 0ull) {
      const float alpha = __builtin_amdgcn_exp2f(m_run - m_new);
      m_run = m_new;
      l_run *= alpha;
#pragma unroll
      for (int ef = 0; ef < 4; ++ef) o[ef] = o[ef] * alpha;
    }
    s0 = s0 * sc - m_new;
    s1 = s1 * sc - m_new;
#pragma unroll
    for (int r = 0; r < 16; ++r) { s0[r] = __builtin_amdgcn_exp2f(s0[r]); s1[r] = __builtin_amdgcn_exp2f(s1[r]); }
    const f32x16 sp = s0 + s1;
    const float ps = ((sp[0] + sp[1]) + (sp[2] + sp[3])) + ((sp[4] + sp[5]) + (sp[6] + sp[7])) + ((sp[8] + sp[9]) + (sp[10] + sp[11])) + ((sp[12] + sp[13]) + (sp[14] + sp[15]));
    l_run += ps;
#pragma unroll
    for (int mf = 0; mf < 2; ++mf)
#pragma unroll
      for (int ks = 0; ks < 2; ++ks) {
        const bf16x8 pb = mf ? pack8(s1, ks) : pack8(s0, ks);
        const int kb = (mf * 2 + ks) * 16 + 8 * h;
#pragma unroll
        for (int ef = 0; ef < 4; ++ef) {
          const bf16x8 vf = *(const bf16x8*)(sV + (ef * 32 + l31) * 72 + kb);
          o[ef] = MFMA32(vf, pb, o[ef]);
        }
      }
  }
#undef ATT_LOAD
#undef ATT_STORE
  const float lt = l_run + __shfl_xor(l_run, 32);
  const float inv = 1.f / lt;
  u16* orow = Ob + (size_t)(q0 + w * 32 + l31) * ldo;
#pragma unroll
  for (int ef = 0; ef < 4; ++ef)
#pragma unroll
    for (int gp = 0; gp < 2; ++gp) {
      const int e0 = ef * 32 + 16 * h + 8 * gp;
      *(u32x4*)(orow + e0) = (u32x4){pack2(o[ef][8 * gp] * inv, o[ef][8 * gp + 1] * inv), pack2(o[ef][8 * gp + 2] * inv, o[ef][8 * gp + 3] * inv),
                                     pack2(o[ef][8 * gp + 4] * inv, o[ef][8 * gp + 5] * inv), pack2(o[ef][8 * gp + 6] * inv, o[ef][8 * gp + 7] * inv)};
    }
  __syncthreads();
}

DI void ph_attn(const Params& p, char* lds, bool need_ctx) {
  char* ws = p.ws;
  u16* oa = (u16*)(ws + OFF_OA); u16* mix = (u16*)(ws + OFF_MIXO);
  const int n_lat = 8 * 12 * 32, n_all = n_lat + (need_ctx ? 8 * 12 * 2 : 0);
  const float sa = 0.125f * 1.4426950408889634f;
  const float sm = 0.10206207261596575f * 1.4426950408889634f;
  for (int it = bid_l(); it < n_all; it += gridDim.x) {
    int b, head, qb; bool isl;
    if (it < n_lat) {
      isl = true;
      int pr;
      if (gridDim.x == 512) {
        const int bid = it & 511, rnd = it >> 9, xcd = bid & 7, slot = bid >> 3;
        pr = rnd * 16 + xcd * 2 + (slot >> 5); qb = slot & 31;
      } else { qb = it & 31; pr = it >> 5; }
      head = 11 - (pr % 12); b = pr / 12;
    }
    else { isl = false; const int q = it - n_lat; qb = q & 1; const int r = q >> 1; head = 11 - (r % 12); b = r / 12; }
    const int kt_lo = isl ? 0 : 64, kt_hi = 68;
    const size_t orow0 = isl ? (size_t)b * 4096 : (size_t)TL + (size_t)b * 256;
    if (head >= 8) {
      const int hm = head - 8;
      const u16* Q = isl ? (const u16*)(ws + OFF_QM) + (size_t)(b * 4 + hm) * 4096 * 96 : (const u16*)(ws + OFF_QMC) + (size_t)(b * 4 + hm) * 256 * 96;
      const u16* K = (const u16*)(ws + OFF_KM) + (size_t)(b * 4 + hm) * KPOS * 96;
      const u16* V = (const u16*)(ws + OFF_VTM) + (size_t)(b * 4 + hm) * 128 * KPOS;
      attn_item<96>(lds, Q, K, V, qb * 128, kt_lo, kt_hi, sm, mix + orow0 * D + 512 + hm * 128, D);
    } else {
      const u16* Q = isl ? (const u16*)(ws + OFF_QA) + (size_t)(b * 8 + head) * 4096 * 64 : (const u16*)(ws + OFF_QAC) + (size_t)(b * 8 + head) * 256 * 64;
      const u16* K = (const u16*)(ws + OFF_KA) + (size_t)(b * 8 + head) * KPOS * 64;
      const u16* V = (const u16*)(ws + OFF_VTA) + (size_t)(b * 4 + (head & 3)) * 128 * KPOS;
      attn_item<64>(lds, Q, K, V, qb * 128, kt_lo, kt_hi, sa, oa + orow0 * D + head * 128, D);
    }
  }
}

DI void ph_da_readout(const Params& p, int layer, int rows) {
  const int o = layer >> 1;
  const int lane = tid_l() & 63;
  const int wid = bid_l() * 4 + (tid_l() >> 6), nw = gridDim.x * 4;
  const float* lp = p.in[26] + o * 256;
  const float lam_init = 0.8f - 0.6f * expf(-0.3f * (float)layer);
  const float d1 = wave_sum(lp[lane] * lp[64 + lane]), d2 = wave_sum(lp[128 + lane] * lp[192 + lane]);
  const float lam = expf(d1) - expf(d2) + lam_init;
  const int hh = lane >> 4, e0 = (lane & 15) * 8;
  const float* sg = p.in[27] + o * 128 + e0;
  const float4 ga = *(const float4*)(sg), gb = *(const float4*)(sg + 4);
  const float gv[8] = {ga.x, ga.y, ga.z, ga.w, gb.x, gb.y, gb.z, gb.w};
  const u16* oa = (const u16*)(p.ws + OFF_OA); u16* mix = (u16*)(p.ws + OFF_MIXO);
  const float post = 1.f - lam_init;
  for (int row = wid; row < rows; row += nw) {
    const u32x4 a = *(const u32x4*)(oa + (size_t)row * D + hh * 128 + e0);
    const u32x4 bq = *(const u32x4*)(oa + (size_t)row * D + (4 + hh) * 128 + e0);
    float x[8]; float ss = 0.f;
#pragma unroll
    for (int q = 0; q < 4; ++q) {
      x[2 * q] = bflo(a[q]) - lam * bflo(bq[q]);
      x[2 * q + 1] = bfhi(a[q]) - lam * bfhi(bq[q]);
      ss += x[2 * q] * x[2 * q] + x[2 * q + 1] * x[2 * q + 1];
    }
    ss += __shfl_xor(ss, 1); ss += __shfl_xor(ss, 2); ss += __shfl_xor(ss, 4); ss += __shfl_xor(ss, 8);
    const float rs = rsqrtf(ss * (1.f / 128.f) + 1e-6f) * post;
    *(u32x4*)(mix + (size_t)row * D + hh * 128 + e0) = (u32x4){pack2(x[0] * rs * gv[0], x[1] * rs * gv[1]), pack2(x[2] * rs * gv[2], x[3] * rs * gv[3]),
                                                              pack2(x[4] * rs * gv[4], x[5] * rs * gv[5]), pack2(x[6] * rs * gv[6], x[7] * rs * gv[7])};
  }
}

DI void ph_final(const Params& p) {
  const int lane = tid_l() & 63;
  const int wid = bid_l() * 4 + (tid_l() >> 6), nw = gridDim.x * 4;
  const float* g = p.in[32];
  float4 gq[4];
#pragma unroll
  for (int j = 0; j < 4; ++j) gq[j] = *(const float4*)(g + lane * 4 + 256 * j);
  for (int row = wid; row < TL; row += nw) {
    float* src = p.out + (size_t)row * D;
    float4 v[4]; float ss = 0.f;
#pragma unroll
    for (int j = 0; j < 4; ++j) { v[j] = *(const float4*)(src + lane * 4 + 256 * j); ss += v[j].x * v[j].x + v[j].y * v[j].y + v[j].z * v[j].z + v[j].w * v[j].w; }
    ss = wave_sum(ss);
    const float rs = rsqrtf(ss * (1.f / 1024.f) + 1e-6f);
#pragma unroll
    for (int j = 0; j < 4; ++j) {
      const float4 gg = gq[j];
      *(float4*)(src + lane * 4 + 256 * j) = make_float4(v[j].x * rs * gg.x, v[j].y * rs * gg.y, v[j].z * rs * gg.z, v[j].w * rs * gg.w);
    }
  }
}

DI void run_phase(const Params& p, char* lds, int ph) {
  char* ws = p.ws;
  if (ph == 0) { if (en(0)) {
      if (bid_l() == 0) { float* rt = (float*)(ws + OFF_ROPE);
        for (int i = tid_l(); i < 1024; i += 256) { const float inv = exp2f(-(float)(i & 15) * (13.287712379549449f / 16.f)); const float a = (float)(i >> 4) * inv; rt[i] = sinf(a); rt[1024 + i] = cosf(a); } }
      ph_ada(p, lds); ph_convert(p, lds, 0, 0); } return; }
  if (ph == NPHASES - 1) { if (en(17)) ph_final(p); return; }
  int layer, sub;
  { const int q = ph - 1;
    if (q < 11) { layer = 0; sub = q; } else if (q < 21) { layer = 1; sub = q - 11; } else if (q < 32) { layer = 2; sub = q - 21; } else { layer = 3; sub = q - 32; }
    if ((layer & 1) && sub >= 6) sub += 1; }
  const bool even = (layer & 1) == 0;
  const int e = layer >> 1;
  const bool need_ctx = layer < 3;
  const int rows = need_ctx ? TA : TL;
  const float* modl = (const float*)(ws + OFF_MOD) + (size_t)layer * 9 * 6144;
  const float* res_lat = layer == 0 ? p.in[0] : p.out;
  const float* res_ctx = layer == 0 ? p.in[2] : (const float*)(ws + OFF_HCTX);
  switch (sub) {
    case 0: if (en(1)) { ph_layer_start(p, lds, layer); if (dbl(1)) ph_layer_start(p, lds, layer); } break;
    case 1:
      if (even) { if (en(2)) { GemmDesc g{(const u16*)(ws + OFF_HN), 1024, (const u16*)(ws + wofs(layer) + OFF_WIN), 1024, TA, 4096, 1024};
        gemm_phase_t<4, 32>(lds, g, EpiSplitEven{(u16*)(ws + OFF_ZA), (u16*)(ws + OFF_ZHY)}); } }
      else { if (en(3)) { GemmDesc g{(const u16*)(ws + OFF_HN), 1024, (const u16*)(ws + wofs(layer) + OFF_WIN), 1024, TA, 2048, 1024};
        gemm_phase(lds, g, EpiOddIn{(u16*)(ws + OFF_ZO), (u16*)(ws + OFF_QA), (u16*)(ws + OFF_QAC), (u16*)(ws + OFF_KA), (const float*)(ws + OFF_ROPE)}); } }
      break;
    case 2: if (even) { if (en(4)) { ph_hy_short(p, lds, e); if (dbl(4)) ph_hy_short(p, lds, e); } } else { if (en(5)) { ph_odd_prepA(p, lds); if (dbl(5)) ph_odd_prepA(p, lds); } } break;
    case 3: if (even) { if (en(6)) { ph_hy_long(p, lds, e); if (dbl(6)) ph_hy_long(p, lds, e); } } else { if (en(7)) { ph_odd_prepB(p, lds); if (dbl(7)) ph_odd_prepB(p, lds); } } break;
    case 4: if (even) { if (en(8)) { ph_hg1(p, lds, e); if (dbl(8)) ph_hg1(p, lds, e); } } else { if (en(9)) { ph_attn(p, lds, need_ctx); if (dbl(9)) ph_attn(p, lds, need_ctx); } } break;
    case 5: if (even) { if (en(10)) ph_hg2(p); } else { if (en(11)) { ph_da_readout(p, layer, rows); if (dbl(11)) ph_da_readout(p, layer, rows); } } break;
    case 6: if (even) { if (en(12)) { ph_hg3(p, lds, e); if (dbl(12)) ph_hg3(p, lds, e); } } break;
    case 7: if (en(13)) {
      const u16* Amix = (const u16*)(ws + (even ? OFF_MIXE : OFF_MIXO));
      const EpiResid ep{res_lat, res_ctx, p.out, (float*)(ws + OFF_HCTX), modl + 2 * 1024};
      GemmDesc g{Amix, 1024, (const u16*)(ws + wofs(layer) + OFF_WOUT), 1024, TL, 1024, 1024};
      gemm_phase(lds, g, ep);
      if (need_ctx) {
        GemmDesc gc{Amix + (size_t)TL * 1024, 1024, (const u16*)(ws + wofs(layer) + OFF_WOUT), 1024, TC, 1024, 1024, TL};
        gemm_phase_t<1, 64>(lds, gc, ep);
      }
    } break;
    case 8: if (en(14)) ph_norm(p.out, (const float*)(ws + OFF_HCTX), rows, p.in[7] + layer * 1024, modl, 3, 4, (u16*)(ws + OFF_HN)); break;
    case 9: if (en(15)) {
      GemmDesc g{(const u16*)(ws + OFF_HN), 1024, (const u16*)(ws + wofs(layer) + OFF_WGU), 1024, rows, 5632, 1024};
      gemm_phase_t<4, 32>(lds, g, EpiSwiglu{(u16*)(ws + OFF_ACT)});
    } break;
    case 10: if (en(16)) {
      const EpiResid ep{p.out, (const float*)(ws + OFF_HCTX), p.out, (float*)(ws + OFF_HCTX), modl + 5 * 1024};
      GemmDesc g{(const u16*)(ws + OFF_ACT), FF, (const u16*)(ws + wofs(layer) + OFF_WDN), FF, TL, 1024, FF};
      gemm_phase(lds, g, ep);
      if (need_ctx) {
        GemmDesc gc{(const u16*)(ws + OFF_ACT) + (size_t)TL * FF, FF, (const u16*)(ws + wofs(layer) + OFF_WDN), FF, TC, 1024, FF, TL};
        gemm_phase_t<1, 64>(lds, gc, ep);
      }
      if (layer < 3) {
        const int nt = ((TC / 64) * 8) % (int)gridDim.x;
        ph_convert(p, lds, layer + 1, nt);
      }
    } break;
  }
}

__global__ void __launch_bounds__(256, 2) mega(Params p) {
  __shared__ __attribute__((aligned(16))) char lds[LDS_BYTES];
  __shared__ uint4 xb_words;
  cg::grid_group grid = cg::this_grid();
  if (threadIdx.x == 0) xb_words = make_uint4(0u, 0u, 0u, 0u);
  __syncthreads();
  const XcdBarrier xb = xcd_barrier_post((unsigned*)(p.ws + OFF_BAR), (volatile LAS unsigned*)&xb_words);
  const int ph_lo = p.ph_lo, ph_hi = p.ph_hi;
  for (int ph = ph_lo; ph < ph_hi; ++ph) {
    const __attribute__((address_space(4))) Params* pp = (const __attribute__((address_space(4))) Params*)__builtin_amdgcn_kernarg_segment_ptr();
    asm volatile("" : "+s"(pp));
    Params q;
    q.out = pp->out; q.ws = pp->ws; q.ph_lo = ph_lo; q.ph_hi = ph_hi;
#pragma unroll
    for (int i = 0; i < 33; ++i) q.in[i] = pp->in[i];
    run_phase(q, lds, ph);
    if (ph + 1 < ph_hi) {
      if (ph_lo == 0x7fffffff) grid.sync();
      xcd_barrier(xb);
    }
  }
}

extern "C" void kernel_launch(void* const* d_in, const int* in_sizes, int n_in, void* d_out, int out_size, void* d_ws, size_t ws_size, hipStream_t stream) {
  static int grid_blocks = 0;
  if (!grid_blocks) {
    int dev = 0, cus = 0, per_cu = 0;
    (void)hipGetDevice(&dev);
    (void)hipDeviceGetAttribute(&cus, hipDeviceAttributeMultiprocessorCount, dev);
    (void)hipOccupancyMaxActiveBlocksPerMultiprocessor(&per_cu, mega, 256, 0);
    if (per_cu < 1) per_cu = 1;
    if (per_cu > 2) per_cu = 2;
    grid_blocks = cus * per_cu;
    if (n_in != 33 || ws_size < WS_END) { fprintf(stderr, "kernel_launch: bad inputs n_in %d ws %zu need %zu\n", n_in, ws_size, (size_t)WS_END); }
  }
  (void)hipMemsetAsync((char*)d_ws + OFF_BAR, 0, 16384, stream);
  Params p{};
  for (int i = 0; i < 33; ++i) p.in[i] = (const float*)d_in[i];
  p.out = (float*)d_out; p.ws = (char*)d_ws;
#if MK_PER_PHASE
  for (int ph = 0; ph < NPHASES; ++ph) {
    p.ph_lo = ph; p.ph_hi = ph + 1;
    hipLaunchKernelGGL(mega, dim3(grid_blocks), dim3(256), 0, stream, p);
  }
#else
  p.ph_lo = 0; p.ph_hi = NPHASES;
  void* args[] = {&p};
  hipError_t e = hipLaunchCooperativeKernel((void*)mega, dim3(grid_blocks), dim3(256), args, 0, stream);
  if (e != hipSuccess) fprintf(stderr, "cooperative launch failed: %s (grid %d)\n", hipGetErrorString(e), grid_blocks);
#endif
}
```

```cpp
#include <hip/hip_runtime.h>
#include <hip/hip_cooperative_groups.h>
#include <cstdio>
#include <cstdint>
namespace cg = cooperative_groups;

#ifndef MK_PER_PHASE
#define MK_PER_PHASE 0
#endif
#ifndef DBG_ONLY
#define DBG_ONLY -1
#endif
constexpr bool en(int t) { return DBG_ONLY < 0 || DBG_ONLY == t; }
#ifndef PROBE_DBL
#define PROBE_DBL 0
#endif
constexpr bool dbl(int t) { return ((PROBE_DBL >> t) & 1) != 0; }

#define DI __device__ __forceinline__
typedef unsigned short u16;
using bf16x8 = __attribute__((ext_vector_type(8))) short;
using s16x4  = __attribute__((ext_vector_type(4))) short;
using f32x16 = __attribute__((ext_vector_type(16))) float;
using u32x4  = __attribute__((ext_vector_type(4))) unsigned;
typedef unsigned u32x2_t __attribute__((ext_vector_type(2)));
#define MFMA32(a, b, c) __builtin_amdgcn_mfma_f32_32x32x16_bf16((a), (b), (c), 0, 0, 0)

constexpr int D = 1024, NB = 8, SEQ = 4096, CTX = 256;
constexpr int TL = NB * SEQ, TC = NB * CTX, TA = TL + TC;
constexpr int FF = 2816, KPOS = SEQ + CTX;
constexpr int LDS_BYTES = 77824;
constexpr int NPH_LAYER = 11;
constexpr int NPHASES = 1 + (11 + 10 + 11 + 10) + 1;

constexpr size_t OFF_HCTX = 0;
constexpr size_t OFF_MOD  = OFF_HCTX + (size_t)TC * D * 4;
constexpr size_t OFF_RSQ  = OFF_MOD + 4 * 9 * 6144 * 4;
constexpr size_t OFF_RSKV = OFF_RSQ + (size_t)TA * 4;
constexpr size_t OFF_PSUM = OFF_RSKV + (size_t)TA * 4;
constexpr size_t OFF_DBUF = OFF_PSUM + 272 * 1024 * 4;
constexpr size_t OFF_WIN  = OFF_DBUF + 64 * 68 * 128 * 4;
constexpr size_t OFF_WOUT = OFF_WIN + 4096 * 1024 * 2;
constexpr size_t OFF_WGU  = OFF_WOUT + 1024 * 1024 * 2;
constexpr size_t OFF_WDN  = OFF_WGU + 5632 * 1024 * 2;
constexpr size_t OFF_WUQ  = OFF_WDN + 1024 * 2816 * 2;
constexpr size_t OFF_WUKV = OFF_WUQ + 384 * 256 * 2;
constexpr size_t OFF_FR0  = OFF_WUKV + 768 * 128 * 2;
constexpr size_t OFF_FR1  = OFF_FR0 + 512 * 8192 * 2;
constexpr size_t OFF_FCTX = OFF_FR1 + 512 * 8192 * 2;
constexpr size_t OFF_ZA   = OFF_FCTX + 512 * 512 * 2;
constexpr size_t SZ_ZHG   = (size_t)TA * 2560 * 2;
constexpr size_t OFF_ZHY  = OFF_ZA + SZ_ZHG;
constexpr size_t SZ_ZA    = (size_t)TA * 4096 * 2;
constexpr size_t OFF_HN   = OFF_ZA + SZ_ZA;
constexpr size_t SZ_HN    = (size_t)TA * 1024 * 2;
constexpr size_t OFF_UT   = OFF_HN;
constexpr size_t OFF_UTC  = OFF_UT + (size_t)8 * 512 * 4096 * 2;
constexpr size_t OFF_X0T  = OFF_UTC + (size_t)8 * 512 * 256 * 2;
constexpr size_t OFF_X0TC = OFF_X0T + (size_t)8 * 512 * 4096 * 2;
constexpr size_t OFF_ST   = OFF_HN;
constexpr size_t SZ_ST    = (size_t)64 * 68 * 16384 * 2;
constexpr size_t OFF_MIXE = OFF_ZHY;
constexpr size_t OFF_YT   = OFF_ZHY + SZ_HN;
constexpr size_t OFF_YTC  = OFF_YT + (size_t)8 * 512 * 4096 * 2;
static_assert(OFF_YTC + (size_t)8 * 512 * 256 * 2 <= OFF_ZHY + (size_t)TA * 1536 * 2, "yt overflows z_hy");
constexpr size_t OFF_ZO   = OFF_ZA;
constexpr size_t OFF_UPQ  = OFF_ZA + (size_t)TA * 1952 * 2;
constexpr size_t OFF_UPKV = OFF_UPQ + (size_t)TA * 384 * 2;
constexpr size_t OFF_QA   = OFF_UPKV + (size_t)TA * 768 * 2;
constexpr size_t OFF_QAC  = OFF_QA + (size_t)8 * 8 * 4096 * 64 * 2;
constexpr size_t OFF_QM   = OFF_QAC + (size_t)8 * 8 * 256 * 64 * 2;
constexpr size_t OFF_QMC  = OFF_QM + (size_t)8 * 4 * 4096 * 96 * 2;
constexpr size_t OFF_QEND = OFF_QMC + (size_t)8 * 4 * 256 * 96 * 2;
static_assert(OFF_QEND <= OFF_HN, "odd-layer q buffers overflow region A");
constexpr size_t OFF_KA   = OFF_HN;
constexpr size_t OFF_VTA  = OFF_KA + (size_t)8 * 8 * KPOS * 64 * 2;
constexpr size_t OFF_KM   = OFF_VTA + (size_t)8 * 4 * 128 * KPOS * 2;
constexpr size_t OFF_VTM  = OFF_KM + (size_t)8 * 4 * KPOS * 96 * 2;
constexpr size_t OFF_OA   = OFF_ZA;
constexpr size_t OFF_MIXO = OFF_ZA + SZ_HN;
constexpr size_t OFF_ACT  = OFF_ZA;
constexpr size_t OFF_BAR  = OFF_HN + SZ_ST;
constexpr size_t OFF_W2   = OFF_BAR + 16384;
constexpr size_t W2_DELTA = OFF_W2 - OFF_WIN;
constexpr size_t OFF_ROPE = OFF_W2 + (OFF_ZA - OFF_WIN);
constexpr size_t WS_END   = OFF_ROPE + 2 * 1024 * 4;
static_assert(WS_END <= (size_t)536870912, "workspace too large");

struct Params {
  const float* in[33];
  float* out;
  char* ws;
  int ph_lo, ph_hi;
};

__device__ __forceinline__ size_t wofs(int layer) { return (layer & 1) ? W2_DELTA : (size_t)0; }
DI int tid_l() { int t = threadIdx.x; asm volatile("" : "+v"(t)); return t; }
DI int bid_l() { int t = blockIdx.x; asm volatile("" : "+s"(t)); return t; }
typedef __bf16 bf2_t __attribute__((ext_vector_type(2)));
typedef float f2_t __attribute__((ext_vector_type(2)));
DI unsigned pack2(float a, float b) { f2_t v = {a, b}; return __builtin_bit_cast(unsigned, __builtin_convertvector(v, bf2_t)); }
DI u16 f2bf(float x) { return (u16)(pack2(x, x) & 0xffffu); }
DI float bf2f(u16 v) { return __uint_as_float(((unsigned)v) << 16); }
DI float bflo(unsigned w) { return __uint_as_float(w << 16); }
DI float bfhi(unsigned w) { return __uint_as_float(w & 0xffff0000u); }
DI float wave_sum(float v) { for (int o = 32; o > 0; o >>= 1) v += __shfl_xor(v, o); return v; }
DI float sigm(float x) { return __builtin_amdgcn_rcpf(1.f + __expf(-x)); }
DI float siluf(float x) { return x * __builtin_amdgcn_rcpf(1.f + __expf(-x)); }
DI int crow(int r, int h) { return (r & 3) + 8 * (r >> 2) + 4 * h; }
DI int modrow(int row) { return row < TL ? (row >> 12) : 8; }
DI bf16x8 pack8(const f32x16& x, const int s) {
  u32x4 q = {pack2(x[8 * s], x[8 * s + 1]), pack2(x[8 * s + 2], x[8 * s + 3]), pack2(x[8 * s + 4], x[8 * s + 5]), pack2(x[8 * s + 6], x[8 * s + 7])};
  return __builtin_bit_cast(bf16x8, q);
}
DI int slot_of(int e32) { return ((e32 >> 2) & 3) * 8 + (e32 >> 4) * 4 + (e32 & 3); }
DI int elem_of(int slot) { return ((slot >> 2) & 1) * 16 + (slot >> 3) * 4 + (slot & 3); }
DI f32x16 zero16() { f32x16 z; for (int i = 0; i < 16; ++i) z[i] = 0.f; return z; }


#define XB_TMO      128
#define XB_XCNT(j)  (256  + 64 * (j))
#define XB_XSUB(j)  (1280 + 64 * (j))
#define XB_XGEN(j)  (2304 + 64 * (j))
#define XB_TOP      3328
#define XB_TOPGEN   3392
#define XCD_BAR_WORDS 3456
#define XB_SPIN_CAP (1u << 20)
#define LAS __attribute__((address_space(3)))
DI unsigned xb_ld(unsigned* p) { return __hip_atomic_load(p, __ATOMIC_RELAXED, __HIP_MEMORY_SCOPE_AGENT); }
DI unsigned xb_add(unsigned* p, unsigned v) { return __hip_atomic_fetch_add(p, v, __ATOMIC_RELAXED, __HIP_MEMORY_SCOPE_AGENT); }
DI unsigned xb_xcc_id() { return (unsigned)__builtin_amdgcn_s_getreg((3 << 11) | 20) & 0xFu; }
#define XB_SPIN(cond, bar) do { unsigned _sp = 0; while (cond) { __builtin_amdgcn_s_sleep(1); \
    if ((++_sp & 255u) == 0u) { if (xb_ld(&(bar)[XB_TMO])) break; if (_sp > XB_SPIN_CAP) { atomicAdd(&(bar)[XB_TMO], 1u); break; } } } } while (0)
struct XcdBarrier { unsigned* bar; unsigned x; volatile LAS unsigned* st; };
DI XcdBarrier xcd_barrier_post(unsigned* bar, volatile LAS unsigned* st) {
  XcdBarrier b; b.bar = bar; b.x = xb_xcc_id(); b.st = st;
  if (threadIdx.x == 0) (void)xb_add(&bar[XB_XCNT(b.x)], 1u);
  return b;
}
DI void xcd_barrier_complete(unsigned* bar, unsigned x, unsigned& nloc, unsigned& nx) {
  const unsigned G = gridDim.x * gridDim.y * gridDim.z;
  unsigned sum, cnt, mine, sp = 0u;
  for (;;) {
    sum = 0u; cnt = 0u; mine = 0u;
#pragma unroll
    for (unsigned j = 0; j < 16; ++j) { const unsigned c = xb_ld(&bar[XB_XCNT(j)]); sum += c; cnt += (c > 0u) ? 1u : 0u; mine = (j == x) ? c : mine; }
    if (sum == G) break;
    __builtin_amdgcn_s_sleep(1);
    if ((++sp & 255u) == 0u) { if (xb_ld(&bar[XB_TMO])) break; if (sp > XB_SPIN_CAP) { atomicAdd(&bar[XB_TMO], 1u); break; } }
  }
  nloc = mine > 0u ? mine : 1u; nx = cnt > 0u ? cnt : 1u;
}
DI void xcd_barrier(const XcdBarrier& b) {
  asm volatile("s_waitcnt vmcnt(0)" ::: "memory");
  __syncthreads();
  if (threadIdx.x == 0) {
    unsigned* bar = b.bar;
    __builtin_amdgcn_s_waitcnt(0);
    unsigned nloc = b.st[0], nx = b.st[1];
    if (nloc == 0u) { xcd_barrier_complete(bar, b.x, nloc, nx); b.st[0] = nloc; b.st[1] = nx; }
    const unsigned old = xb_add(&bar[XB_XSUB(b.x)], 1u);
    const unsigned gen = old / nloc;
    if (old + 1u == (gen + 1u) * nloc) {
      __builtin_amdgcn_fence(__ATOMIC_RELEASE, "agent");
      asm volatile("s_waitcnt vmcnt(0)" ::: "memory");
      const unsigned og = xb_add(&bar[XB_TOP], 1u);
      const unsigned tg = og / nx;
      if (og + 1u == (tg + 1u) * nx) xb_add(&bar[XB_TOPGEN], 1u);
      else XB_SPIN(xb_ld(&bar[XB_TOPGEN]) == tg, bar);
      __builtin_amdgcn_fence(__ATOMIC_ACQUIRE, "agent");
      xb_add(&bar[XB_XGEN(b.x)], 1u);
      asm volatile("s_waitcnt vmcnt(0)" ::: "memory");
    } else {
      XB_SPIN(xb_ld(&bar[XB_XGEN(b.x)]) == gen, bar);
      __builtin_amdgcn_fence(__ATOMIC_ACQUIRE, "agent");
      asm volatile("s_waitcnt vmcnt(0)" ::: "memory");
    }
  }
  __syncthreads();
}

struct GemmDesc { const u16* A; int lda; const u16* Bt; int ldb; int M; int Npad; int K; int mbase = 0; };

template <int MF, int BK, class Epi>
DI void gemm_phase_t(char* lds, const GemmDesc g, const Epi epi) {
  constexpr int BM = MF * 64, LS = BK + 8, CPR = BK / 8, RSTEP = 256 / CPR;
  constexpr int APT = BM * CPR / 256, BPT = 128 * CPR / 256, STG = (BM + 128) * LS, NKK = BK / 16;
  u16* sbase = (u16*)lds;
  const int tid = tid_l(), lane = tid & 63, w = tid >> 6, wm = w >> 1, wn = w & 1, l31 = lane & 31, h = lane >> 5;
  const int ntn = g.Npad / 128, ntm = g.M / BM, ntiles = ntm * ntn, nk = g.K / BK;
  const int lr = tid / CPR, lc = tid % CPR;
  for (int t = bid_l(); t < ntiles; t += gridDim.x) {
    const int tn = t % ntn, tm = t / ntn;
    const int m0 = tm * BM, n0 = tn * 128;
    const u16* Ap = g.A + (size_t)(m0 + lr) * g.lda + lc * 8;
    const u16* Bp = g.Bt + (size_t)(n0 + lr) * g.ldb + lc * 8;
    u32x4 ra[APT], rb[BPT];
#pragma unroll
    for (int j = 0; j < APT; ++j) ra[j] = *(const u32x4*)(Ap + (size_t)j * RSTEP * g.lda);
#pragma unroll
    for (int j = 0; j < BPT; ++j) rb[j] = *(const u32x4*)(Bp + (size_t)j * RSTEP * g.ldb);
#pragma unroll
    for (int j = 0; j < APT; ++j) *(u32x4*)(sbase + (lr + RSTEP * j) * LS + lc * 8) = ra[j];
#pragma unroll
    for (int j = 0; j < BPT; ++j) *(u32x4*)(sbase + BM * LS + (lr + RSTEP * j) * LS + lc * 8) = rb[j];
    if (nk > 1) {
#pragma unroll
      for (int j = 0; j < APT; ++j) ra[j] = *(const u32x4*)(Ap + (size_t)j * RSTEP * g.lda + BK);
#pragma unroll
      for (int j = 0; j < BPT; ++j) rb[j] = *(const u32x4*)(Bp + (size_t)j * RSTEP * g.ldb + BK);
    }
    f32x16 acc[MF][2];
#pragma unroll
    for (int i = 0; i < MF; ++i)
#pragma unroll
      for (int j = 0; j < 2; ++j) acc[i][j] = zero16();
    for (int kt = 0; kt < nk; ++kt) {
      __syncthreads();
      const u16* sA = sbase + (kt & 1) * STG;
      const u16* sB = sA + BM * LS;
      if (kt + 1 < nk) {
        u16* nA = sbase + ((kt + 1) & 1) * STG;
#pragma unroll
        for (int j = 0; j < APT; ++j) *(u32x4*)(nA + (lr + RSTEP * j) * LS + lc * 8) = ra[j];
#pragma unroll
        for (int j = 0; j < BPT; ++j) *(u32x4*)(nA + BM * LS + (lr + RSTEP * j) * LS + lc * 8) = rb[j];
        if (kt + 2 < nk) {
#pragma unroll
          for (int j = 0; j < APT; ++j) ra[j] = *(const u32x4*)(Ap + (size_t)j * RSTEP * g.lda + (kt + 2) * BK);
#pragma unroll
          for (int j = 0; j < BPT; ++j) rb[j] = *(const u32x4*)(Bp + (size_t)j * RSTEP * g.ldb + (kt + 2) * BK);
        }
      }
      bf16x8 af[NKK][MF], bfr[NKK][2];
#pragma unroll
      for (int kk = 0; kk < NKK; ++kk) {
#pragma unroll
        for (int ni = 0; ni < 2; ++ni) bfr[kk][ni] = *(const bf16x8*)(sB + (wn * 64 + ni * 32 + l31) * LS + kk * 16 + h * 8);
#pragma unroll
        for (int mi = 0; mi < MF; ++mi) af[kk][mi] = *(const bf16x8*)(sA + (wm * (MF * 32) + mi * 32 + l31) * LS + kk * 16 + h * 8);
      }
      __builtin_amdgcn_sched_barrier(0);
#pragma unroll
      for (int kk = 0; kk < NKK; ++kk)
#pragma unroll
        for (int mi = 0; mi < MF; ++mi)
#pragma unroll
          for (int ni = 0; ni < 2; ++ni) acc[mi][ni] = MFMA32(bfr[kk][ni], af[kk][mi], acc[mi][ni]);
    }
    epi(acc, g.mbase + m0 + wm * (MF * 32), n0 + wn * 64, l31, h);
  }
  __syncthreads();
}
template <class Epi>
DI void gemm_phase(char* lds, const GemmDesc g, const Epi epi) { gemm_phase_t<2, 64, Epi>(lds, g, epi); }

struct EpiStore {
  u16* C; int ldc; int N;
  template <int MF> DI void operator()(f32x16 (&acc)[MF][2], int mb, int nb, int l31, int h) const {
#pragma unroll
    for (int mi = 0; mi < MF; ++mi) {
      const int row = mb + mi * 32 + l31;
#pragma unroll
      for (int g4 = 0; g4 < 4; ++g4) {
        const int col0 = nb + 16 * g4 + 8 * h;
        if (col0 < N) *(u32x4*)(C + (size_t)row * ldc + col0) = (u32x4){pack2(acc[mi][0][4 * g4], acc[mi][0][4 * g4 + 1]), pack2(acc[mi][0][4 * g4 + 2], acc[mi][0][4 * g4 + 3]),
                                                                        pack2(acc[mi][1][4 * g4], acc[mi][1][4 * g4 + 1]), pack2(acc[mi][1][4 * g4 + 2], acc[mi][1][4 * g4 + 3])};
      }
    }
  }
};
struct EpiOddIn {
  u16* z; u16* Qa; u16* Qac; u16* Ka; const float* rope;
  template <int MF> DI void operator()(f32x16 (&acc)[MF][2], int mb, int nb, int l31, int h) const {
    if (nb >= 1024) {
#pragma unroll
      for (int mi = 0; mi < MF; ++mi) {
        const int row = mb + mi * 32 + l31;
#pragma unroll
        for (int g4 = 0; g4 < 4; ++g4) {
          const int col0 = nb + 16 * g4 + 8 * h;
          if (col0 < 1952) *(u32x4*)(z + (size_t)row * 1952 + col0) = (u32x4){pack2(acc[mi][0][4 * g4], acc[mi][0][4 * g4 + 1]), pack2(acc[mi][0][4 * g4 + 2], acc[mi][0][4 * g4 + 3]),
                                                                                pack2(acc[mi][1][4 * g4], acc[mi][1][4 * g4 + 1]), pack2(acc[mi][1][4 * g4 + 2], acc[mi][1][4 * g4 + 3])};
        }
      }
      return;
    }
    const int which = nb >> 9, head = ((nb >> 6) & 1) * 4 + ((nb >> 7) & 3);
#pragma unroll
    for (int mi = 0; mi < MF; ++mi) {
      const int row = mb + mi * 32 + l31;
      const bool isl = row < TL;
      const int b = isl ? row >> 12 : (row - TL) >> 8;
      const int t = isl ? row & 4095 : (row - TL) & 255;
      float x[4][8];
#pragma unroll
      for (int g4 = 0; g4 < 4; ++g4)
#pragma unroll
        for (int k = 0; k < 4; ++k) { x[g4][k] = acc[mi][0][4 * g4 + k]; x[g4][4 + k] = acc[mi][1][4 * g4 + k]; }
      if (isl) {
        const float* sr = rope + (t >> 6) * 16 + 8 * h; const float* sc = rope + (t & 63) * 16 + 8 * h;
        const float4 s1a = *(const float4*)(sr), s1b = *(const float4*)(sr + 4), c1a = *(const float4*)(sr + 1024), c1b = *(const float4*)(sr + 1028);
        const float4 s2a = *(const float4*)(sc), s2b = *(const float4*)(sc + 4), c2a = *(const float4*)(sc + 1024), c2b = *(const float4*)(sc + 1028);
        const float s1[8] = {s1a.x, s1a.y, s1a.z, s1a.w, s1b.x, s1b.y, s1b.z, s1b.w}, c1[8] = {c1a.x, c1a.y, c1a.z, c1a.w, c1b.x, c1b.y, c1b.z, c1b.w};
        const float s2[8] = {s2a.x, s2a.y, s2a.z, s2a.w, s2b.x, s2b.y, s2b.z, s2b.w}, c2[8] = {c2a.x, c2a.y, c2a.z, c2a.w, c2b.x, c2b.y, c2b.z, c2b.w};
#pragma unroll
        for (int k = 0; k < 8; ++k) {
          const float a = x[0][k], bq = x[1][k], cq = x[2][k], dq = x[3][k];
          x[0][k] = a * c1[k] - bq * s1[k]; x[1][k] = bq * c1[k] + a * s1[k];
          x[2][k] = cq * c2[k] - dq * s2[k]; x[3][k] = dq * c2[k] + cq * s2[k];
        }
      }
      u16* dst;
      if (which == 0) dst = isl ? Qa + ((size_t)(b * 8 + head) * 4096 + t) * 64 : Qac + ((size_t)(b * 8 + head) * 256 + t) * 64;
      else dst = Ka + ((size_t)(b * 8 + head) * KPOS + (isl ? t : 4096 + t)) * 64;
      dst += 8 * h;
#pragma unroll
      for (int g4 = 0; g4 < 4; ++g4)
        *(u32x4*)(dst + 16 * g4) = (u32x4){pack2(x[g4][0], x[g4][1]), pack2(x[g4][2], x[g4][3]), pack2(x[g4][4], x[g4][5]), pack2(x[g4][6], x[g4][7])};
    }
  }
};
struct EpiSplitEven {
  u16* zhg; u16* zhy;
  template <int MF> DI void operator()(f32x16 (&acc)[MF][2], int mb, int nb, int l31, int h) const {
#pragma unroll
    for (int mi = 0; mi < MF; ++mi) {
      const int row = mb + mi * 32 + l31;
#pragma unroll
      for (int g4 = 0; g4 < 4; ++g4) {
        const int col0 = nb + 16 * g4 + 8 * h;
        u16* dst = (col0 < 2560) ? zhg + (size_t)row * 2560 + col0 : zhy + (size_t)row * 1536 + (col0 - 2560);
        *(u32x4*)dst = (u32x4){pack2(acc[mi][0][4 * g4], acc[mi][0][4 * g4 + 1]), pack2(acc[mi][0][4 * g4 + 2], acc[mi][0][4 * g4 + 3]),
                               pack2(acc[mi][1][4 * g4], acc[mi][1][4 * g4 + 1]), pack2(acc[mi][1][4 * g4 + 2], acc[mi][1][4 * g4 + 3])};
      }
    }
  }
};
struct EpiResid {
  const float* res_lat; const float* res_ctx; float* out_lat; float* out_ctx; const float* gate;
  template <int MF> DI void operator()(f32x16 (&acc)[MF][2], int mb, int nb, int l31, int h) const {
#pragma unroll
    for (int mi = 0; mi < MF; ++mi) {
      const int row = mb + mi * 32 + l31;
      const float* gr = gate + (size_t)modrow(row) * 6144;
      const float* rp = row < TL ? res_lat + (size_t)row * D : res_ctx + (size_t)(row - TL) * D;
      float* op = row < TL ? out_lat + (size_t)row * D : out_ctx + (size_t)(row - TL) * D;
#pragma unroll
      for (int g4 = 0; g4 < 4; ++g4)
#pragma unroll
        for (int ni = 0; ni < 2; ++ni) {
          const int col0 = nb + 16 * g4 + 8 * h + 4 * ni;
          const float4 gt = *(const float4*)(gr + col0);
          const float4 rv = *(const float4*)(rp + col0);
          *(float4*)(op + col0) = make_float4(rv.x + gt.x * acc[mi][ni][4 * g4], rv.y + gt.y * acc[mi][ni][4 * g4 + 1], rv.z + gt.z * acc[mi][ni][4 * g4 + 2], rv.w + gt.w * acc[mi][ni][4 * g4 + 3]);
        }
    }
  }
};
struct EpiSwiglu {
  u16* act;
  template <int MF> DI void operator()(f32x16 (&acc)[MF][2], int mb, int nb, int l31, int h) const {
#pragma unroll
    for (int mi = 0; mi < MF; ++mi) {
      const int row = mb + mi * 32 + l31;
#pragma unroll
      for (int gp = 0; gp < 2; ++gp) {
        const int j0 = (nb >> 1) + 16 * h + 8 * gp;
        float v[8];
#pragma unroll
        for (int i = 0; i < 8; ++i) v[i] = siluf(acc[mi][0][8 * gp + i]) * acc[mi][1][8 * gp + i];
        *(u32x4*)(act + (size_t)row * FF + j0) = (u32x4){pack2(v[0], v[1]), pack2(v[2], v[3]), pack2(v[4], v[5]), pack2(v[6], v[7])};
      }
    }
  }
};

DI void ph_ada(const Params& p, char* lds) {
  float* sS = (float*)lds;
  float* sR = sS + 9 * 1024;
  const int tid = tid_l();
  const float* c = p.in[1]; const float* cc = p.in[3];
  for (int i = tid; i < 9 * 1024; i += 256) {
    const int r = i >> 10, k = i & 1023;
    const float v = r < 8 ? c[r * 1024 + k] : cc[k];
    sS[i] = v / (1.f + expf(-v));
  }
  __syncthreads();
  float* mod = (float*)(p.ws + OFF_MOD);
  for (int item = bid_l(); item < 4 * 96; item += gridDim.x) {
    const int l = item / 96, n0 = (item % 96) * 64, cq = (tid & 15) * 4, ks = tid >> 4;
    float acc[9][4];
#pragma unroll
    for (int r = 0; r < 9; ++r)
#pragma unroll
      for (int j = 0; j < 4; ++j) acc[r][j] = 0.f;
    const float* W = p.in[4] + (size_t)l * 1024 * 6144 + n0 + cq;
#pragma unroll 4
    for (int k = ks * 64; k < ks * 64 + 64; ++k) {
      const float4 wv = *(const float4*)(W + (size_t)k * 6144);
#pragma unroll
      for (int r = 0; r < 9; ++r) {
        const float sv = sS[r * 1024 + k];
        acc[r][0] += sv * wv.x; acc[r][1] += sv * wv.y; acc[r][2] += sv * wv.z; acc[r][3] += sv * wv.w;
      }
    }
#pragma unroll
    for (int r = 0; r < 9; ++r) *(float4*)(sR + (ks * 9 + r) * 64 + cq) = make_float4(acc[r][0], acc[r][1], acc[r][2], acc[r][3]);
    __syncthreads();
    for (int o = tid; o < 576; o += 256) {
      const int r = o >> 6, c2 = o & 63;
      float t = p.in[5][l * 6144 + n0 + c2];
#pragma unroll
      for (int q = 0; q < 16; ++q) t += sR[(q * 9 + r) * 64 + c2];
      mod[(size_t)(l * 9 + r) * 6144 + n0 + c2] = t;
    }
    __syncthreads();
  }
}

DI void convT_tile(char* lds, const float* src, int K, int Nsrc, u16* dst, int tk, int tn, int mode, const float* kscale) {
  float* sT = (float*)lds;
  const int tid = tid_l();
  const int k0 = tk * 64, n0 = tn * 64;
  {
    const int kk = tid >> 2, c16 = (tid & 3) * 16;
    int sc0 = n0 + c16;
    if (mode == 1) { const int blk = n0 >> 6; sc0 = (c16 < 32) ? (blk * 32 + c16) : (2816 + blk * 32 + (c16 - 32)); }
    const float ks = kscale ? kscale[k0 + kk] : 1.f;
    const bool ok = (mode == 1) || (n0 + c16 < Nsrc);
    const float* sp = src + (size_t)(k0 + kk) * Nsrc + sc0;
#pragma unroll
    for (int q = 0; q < 4; ++q) {
      float4 v = ok ? *(const float4*)(sp + q * 4) : make_float4(0.f, 0.f, 0.f, 0.f);
      sT[kk * 65 + c16 + q * 4 + 0] = v.x * ks; sT[kk * 65 + c16 + q * 4 + 1] = v.y * ks;
      sT[kk * 65 + c16 + q * 4 + 2] = v.z * ks; sT[kk * 65 + c16 + q * 4 + 3] = v.w * ks;
    }
  }
  __syncthreads();
  {
    const int n = tid >> 2, kq = (tid & 3) * 16;
    const int sg4 = (n >> 3) & 3, sh = (n >> 2) & 1, si = n & 3, sni = n >> 5;
    const int cs = (mode == 1) ? (n & 32) + 16 * sh + 4 * sg4 + si : 16 * sg4 + 8 * sh + 4 * sni + si;
    unsigned o[8];
#pragma unroll
    for (int q = 0; q < 8; ++q) o[q] = pack2(sT[(kq + 2 * q) * 65 + cs], sT[(kq + 2 * q + 1) * 65 + cs]);
    uint4* dp = (uint4*)(dst + (size_t)(n0 + n) * K + k0 + kq);
    dp[0] = make_uint4(o[0], o[1], o[2], o[3]);
    dp[1] = make_uint4(o[4], o[5], o[6], o[7]);
  }
  __syncthreads();
}

DI void filt_item(const Params& p, char* lds, int e, int idx, size_t wo) {
  float* zf = (float*)lds;
  float* h1 = zf + 16 * 33;
  float* h2 = h1 + 16 * 64;
  const int tid = tid_l();
  const bool lat = idx < 256;
  const int L = lat ? 4096 : 256;
  const int p0 = (lat ? idx : idx - 256) * 16;
  const float* w1 = p.in[16] + (size_t)e * 33 * 64; const float* b1 = p.in[17] + e * 64; const float* fr1 = p.in[18] + e * 64;
  const float* w2 = p.in[19] + (size_t)e * 64 * 64; const float* b2 = p.in[20] + e * 64; const float* fr2 = p.in[21] + e * 64;
  const float* w3 = p.in[22] + (size_t)e * 64 * 1024;
  for (int i = tid; i < 16 * 33; i += 256) {
    const int pp = i / 33, f = i % 33;
    const int pos = p0 + pp;
    const float tt = (float)pos / (float)(L - 1);
    const float wv = (6.283185307179586f * (float)pos) / (float)L;
    float v;
    if (f == 0) v = tt;
    else {
      const int j = (f - 1) & 15;
      const float band = 1e-4f + (float)j * ((15.f - 1e-4f) / 15.f);
      v = (f <= 16) ? cosf(band * wv) : -sinf(band * wv);
    }
    zf[i] = v;
  }
  __syncthreads();
  for (int i = tid; i < 1024; i += 256) {
    const int pp = i >> 6, j = i & 63;
    float s = b1[j];
#pragma unroll 3
    for (int f = 0; f < 33; ++f) s += zf[pp * 33 + f] * w1[f * 64 + j];
    h1[i] = sinf(fr1[j] * s);
  }
  __syncthreads();
  for (int i = tid; i < 1024; i += 256) {
    const int pp = i >> 6, j = i & 63;
    float s = b2[j];
#pragma unroll 4
    for (int k = 0; k < 64; ++k) s += h1[pp * 64 + k] * w2[k * 64 + j];
    h2[i] = sinf(fr2[j] * s);
  }
  __syncthreads();
  u16* R0 = (u16*)(p.ws + wo + OFF_FR0); u16* R1 = (u16*)(p.ws + wo + OFF_FR1); u16* FC = (u16*)(p.ws + wo + OFF_FCTX);
  float* psum = (float*)(p.ws + OFF_PSUM);
  const float d_lo = 4.605170185988091f / 1.5f, d_hi = 4.605170185988091f / 0.3f;
#pragma unroll 1
  for (int q = 0; q < 4; ++q) {
    const int n = tid + 256 * q;
    float acc[16];
#pragma unroll
    for (int pp = 0; pp < 16; ++pp) acc[pp] = 0.f;
#pragma unroll 2
    for (int k = 0; k < 64; ++k) {
      const float wv = w3[k * 1024 + n];
#pragma unroll
      for (int pp = 0; pp < 16; ++pp) acc[pp] += h2[pp * 64 + k] * wv;
    }
    const int ch = n & 511;
    const bool bwd = n >= 512;
    const float delta = d_lo + (float)ch * ((d_hi - d_lo) / 511.f);
    float asum = 0.f;
#pragma unroll
    for (int pp = 0; pp < 16; ++pp) {
      const int pos = p0 + pp;
      const float tt = (float)pos / (float)(L - 1);
      const float val = acc[pp] * expf(-tt * delta);
      const int lag = bwd ? -(pos + 1) : pos;
      const bool valid = !bwd || (pos <= L - 2);
      if (valid) {
        asum += fabsf(val);
        const u16 bv = f2bf(val);
        if (lat) {
          const int m = 8191 - (4096 + lag);
          R0[(size_t)ch * 8192 + m] = bv;
          if (m >= 1) R1[(size_t)ch * 8192 + m - 1] = bv;
        } else {
          FC[(size_t)ch * 512 + 256 + lag] = bv;
        }
      }
    }
    if (lat && bwd && p0 == 0) {   }
    psum[(size_t)idx * 1024 + n] = asum;
  }
  if (lat && p0 == 0) {
    for (int ch = tid; ch < 512; ch += 256) { R0[(size_t)ch * 8192 + 8191] = 0; R1[(size_t)ch * 8192 + 8191] = 0; R1[(size_t)ch * 8192 + 8190] = 0; }
  }
  if (!lat && p0 == 0) { for (int ch = tid; ch < 512; ch += 256) FC[(size_t)ch * 512] = 0; }
  __syncthreads();
}

DI void ph_norm(const float* src_lat, const float* src_ctx, int rows, const float* g, const float* modl, int i_shift, int i_scale, u16* dst) {
  const int lane = tid_l() & 63;
  const int wid = bid_l() * 4 + (tid_l() >> 6), nw = gridDim.x * 4;
  const int per = (rows + nw - 1) / nw;
  const int r0 = wid * per, r1 = (r0 + per < rows) ? r0 + per : rows;
  float gs[16], sh[16];
  int cur = -1;
  for (int row = r0; row < r1; ++row) {
    const int mrow = modrow(row);
    if (mrow != cur) {
      cur = mrow;
      const float* mr = modl + (size_t)mrow * 6144;
#pragma unroll
      for (int j = 0; j < 4; ++j) {
        const int c0 = lane * 4 + 256 * j;
        const float4 gg = *(const float4*)(g + c0);
        const float4 sc = *(const float4*)(mr + i_scale * 1024 + c0);
        const float4 s4 = *(const float4*)(mr + i_shift * 1024 + c0);
        gs[4 * j] = gg.x * (1.f + sc.x); gs[4 * j + 1] = gg.y * (1.f + sc.y); gs[4 * j + 2] = gg.z * (1.f + sc.z); gs[4 * j + 3] = gg.w * (1.f + sc.w);
        sh[4 * j] = s4.x; sh[4 * j + 1] = s4.y; sh[4 * j + 2] = s4.z; sh[4 * j + 3] = s4.w;
      }
    }
    const float* src = row < TL ? src_lat + (size_t)row * D : src_ctx + (size_t)(row - TL) * D;
    float4 v[4]; float ss = 0.f;
#pragma unroll
    for (int j = 0; j < 4; ++j) { v[j] = *(const float4*)(src + lane * 4 + 256 * j); ss += v[j].x * v[j].x + v[j].y * v[j].y + v[j].z * v[j].z + v[j].w * v[j].w; }
    ss = wave_sum(ss);
    const float rs = rsqrtf(ss * (1.f / 1024.f) + 1e-6f);
#pragma unroll
    for (int j = 0; j < 4; ++j) {
      const int c0 = lane * 4 + 256 * j;
      *(uint2*)(dst + (size_t)row * D + c0) = make_uint2(pack2(v[j].x * rs * gs[4 * j] + sh[4 * j], v[j].y * rs * gs[4 * j + 1] + sh[4 * j + 1]),
                                                         pack2(v[j].z * rs * gs[4 * j + 2] + sh[4 * j + 2], v[j].w * rs * gs[4 * j + 3] + sh[4 * j + 3]));
    }
  }
}

DI void ph_convert(const Params& p, char* lds, int layer, int b0) {
  const bool even = (layer & 1) == 0;
  const int e = layer >> 1;
  char* ws = p.ws + wofs(layer);
  const float* w_in  = even ? p.in[10] + (size_t)e * 1024 * 4096 : p.in[24] + (size_t)e * 1024 * 1952;
  const int n_in = even ? 4096 : 1952, n_in_pad = even ? 4096 : 2048;
  const float* w_out = even ? p.in[11] + (size_t)e * 1024 * 1024 : p.in[25] + (size_t)e * 1024 * 1024;
  const float* w_gu = p.in[8] + (size_t)layer * 1024 * 5632;
  const float* w_dn = p.in[9] + (size_t)layer * 2816 * 1024;
  const int s0 = 16 * (n_in_pad / 64);
  const int s1 = s0 + 16 * 16;
  const int s2 = s1 + 16 * 88;
  const int s3 = s2 + 44 * 16;
  const int s4 = s3 + (even ? 0 : 4 * 6);
  const int s5 = s4 + (even ? 0 : 2 * 12);
  const int s6 = s5 + (even ? 272 : 0);
  const int bid = bid_l();
  if (bid < b0) return;
  for (int it0 = bid - b0; it0 < s6; it0 += (int)gridDim.x - b0) {
    const int it = (it0 < s6 - s5) ? s5 + it0 : it0 - (s6 - s5);
    if (it >= s5) { filt_item(p, lds, e, it - s5, wofs(layer)); continue; }
    const float* src; int K, Nsrc, ntn, q, mode = 0; u16* dst; const float* ksc = nullptr;
    if (it < s0) { src = w_in; K = 1024; Nsrc = n_in; ntn = n_in_pad / 64; q = it; dst = (u16*)(ws + OFF_WIN); }
    else if (it < s1) { src = w_out; K = 1024; Nsrc = 1024; ntn = 16; q = it - s0; dst = (u16*)(ws + OFF_WOUT); }
    else if (it < s2) { src = w_gu; K = 1024; Nsrc = 5632; ntn = 88; q = it - s1; dst = (u16*)(ws + OFF_WGU); mode = 1; }
    else if (it < s3) { src = w_dn; K = 2816; Nsrc = 1024; ntn = 16; q = it - s2; dst = (u16*)(ws + OFF_WDN); }
    else if (it < s4) { src = p.in[29] + (size_t)e * 256 * 384; K = 256; Nsrc = 384; ntn = 6; q = it - s3; dst = (u16*)(ws + OFF_WUQ); ksc = p.in[28] + e * 256; }
    else { src = p.in[31] + (size_t)e * 128 * 768; K = 128; Nsrc = 768; ntn = 12; q = it - s4; dst = (u16*)(ws + OFF_WUKV); ksc = p.in[30] + e * 128; }
    convT_tile(lds, src, K, Nsrc, dst, q / ntn, q % ntn, mode, ksc);
  }
}
DI void ph_layer_start(const Params& p, char* lds, int layer) {
  char* ws = p.ws;
  const float* hl = layer == 0 ? p.in[0] : p.out;
  const float* hc = layer == 0 ? p.in[2] : (const float*)(ws + OFF_HCTX);
  ph_norm(hl, hc, TA, p.in[6] + layer * 1024, (const float*)(ws + OFF_MOD) + (size_t)layer * 9 * 6144, 0, 1, (u16*)(ws + OFF_HN));
}

DI void ph_hy_short(const Params& p, char* lds, int e) {
  u16* sU = (u16*)lds; u16* sX = sU + 64 * 72;
  const int tid = tid_l();
  const u16* zhy = (const u16*)(p.ws + OFF_ZHY);
  const float* sw = p.in[14] + (size_t)e * 3 * 1536; const float* sb = p.in[15] + e * 1536;
  const int cc = bid_l() & 7, rank = bid_l() >> 3, nbc = ((int)gridDim.x + 7 - cc) >> 3;
  float wa[3][8], wb[3][8], wc[3][8], bb[3][8];
#pragma unroll
  for (int sct = 0; sct < 3; ++sct) {
    const int col = sct * 512 + cc * 64 + (tid & 7) * 8;
#pragma unroll
    for (int q = 0; q < 2; ++q) {
      const float4 a = *(const float4*)(sw + col + 4 * q), b2 = *(const float4*)(sw + 1536 + col + 4 * q), c2 = *(const float4*)(sw + 3072 + col + 4 * q), d2 = *(const float4*)(sb + col + 4 * q);
      wa[sct][4 * q] = a.x; wa[sct][4 * q + 1] = a.y; wa[sct][4 * q + 2] = a.z; wa[sct][4 * q + 3] = a.w;
      wb[sct][4 * q] = b2.x; wb[sct][4 * q + 1] = b2.y; wb[sct][4 * q + 2] = b2.z; wb[sct][4 * q + 3] = b2.w;
      wc[sct][4 * q] = c2.x; wc[sct][4 * q + 1] = c2.y; wc[sct][4 * q + 2] = c2.z; wc[sct][4 * q + 3] = c2.w;
      bb[sct][4 * q] = d2.x; bb[sct][4 * q + 1] = d2.y; bb[sct][4 * q + 2] = d2.z; bb[sct][4 * q + 3] = d2.w;
    }
  }
  for (int jp = rank; jp < 512 + 32; jp += nbc) {
    int b, tt, L; size_t rowbase; u16 *ud, *xd;
    if (jp < 512) { b = jp >> 6; tt = jp & 63; L = 4096; rowbase = (size_t)b * 4096;
      ud = (u16*)(p.ws + OFF_UT) + (size_t)b * 512 * 4096; xd = (u16*)(p.ws + OFF_X0T) + (size_t)b * 512 * 4096; }
    else { const int q = jp - 512; b = q >> 2; tt = q & 3; L = 256; rowbase = (size_t)TL + (size_t)b * 256;
      ud = (u16*)(p.ws + OFF_UTC) + (size_t)b * 512 * 256; xd = (u16*)(p.ws + OFF_X0TC) + (size_t)b * 512 * 256; }
    {
      const int cg = tid & 7, tp = tid >> 3;
      const int ch0 = cc * 64 + cg * 8;
      const int t0 = tt * 64 + tp * 2;
      float zc[3][2][8];
#pragma unroll
      for (int sct = 0; sct < 3; ++sct) {
        const int col = sct * 512 + ch0;
        u32x4 zv[4];
#pragma unroll
        for (int k = 0; k < 4; ++k) {
          const int t = t0 - 1 + k;
          zv[k] = (t >= 0 && t < L) ? *(const u32x4*)(zhy + (rowbase + t) * 1536 + col) : (u32x4){0u, 0u, 0u, 0u};
        }
#pragma unroll
        for (int k = 0; k < 2; ++k)
#pragma unroll
          for (int i = 0; i < 8; ++i) {
            const float pv = (i & 1) ? bfhi(zv[k][i >> 1]) : bflo(zv[k][i >> 1]);
            const float cv = (i & 1) ? bfhi(zv[k + 1][i >> 1]) : bflo(zv[k + 1][i >> 1]);
            const float nv = (i & 1) ? bfhi(zv[k + 2][i >> 1]) : bflo(zv[k + 2][i >> 1]);
            zc[sct][k][i] = pv * wa[sct][i] + cv * wb[sct][i] + nv * wc[sct][i] + bb[sct][i];
          }
      }
#pragma unroll
      for (int k = 0; k < 2; ++k)
#pragma unroll
        for (int i = 0; i < 8; ++i) {
          sU[(cg * 8 + i) * 72 + tp * 2 + k] = f2bf(zc[1][k][i] * zc[2][k][i]);
          sX[(cg * 8 + i) * 72 + tp * 2 + k] = f2bf(zc[0][k][i]);
        }
    }
    __syncthreads();
    {
      const int cr = tid >> 2, tq2 = (tid & 3) * 16;
      const size_t o = (size_t)(cc * 64 + cr) * L + tt * 64 + tq2;
      const uint4* su = (const uint4*)(sU + cr * 72 + tq2); const uint4* sx = (const uint4*)(sX + cr * 72 + tq2);
      uint4* du = (uint4*)(ud + o); uint4* dx = (uint4*)(xd + o);
      du[0] = su[0]; du[1] = su[1]; dx[0] = sx[0]; dx[1] = sx[1];
    }
    __syncthreads();
  }
}

DI void ph_hy_long(const Params& p, char* lds, int e) {
  constexpr int UR = 5128;
  u16* sUu = (u16*)lds;
  u16* sF0 = sUu + 4 * UR;
  u16* sF1 = sF0 + 8224;
  float* sRed = (float*)(sF1 + 8200);
  const int tid = tid_l(), lane = tid & 63, w = tid >> 6, l31 = lane & 31, h = lane >> 5;
  const float* psum = (const float*)(p.ws + OFF_PSUM);
  const float* skip = p.in[23] + e * 512;
  {
    unsigned z0 = 0u;
    asm volatile("" : "+v"(z0));
    const u32x4 zz = {z0, z0, z0, z0};
    for (int i = tid; i < 4 * 129; i += 256) {
      const int b = i / 129, q = i % 129;
      const int off = q < 64 ? q * 8 : 512 + 4096 + (q - 64) * 8;
      *(u32x4*)(sUu + b * UR + off) = zz;
    }
  }
  __syncthreads();
  for (int it = bid_l(); it < 1024; it += gridDim.x) {
    const int c = it >> 1, bh = it & 1;
    {
      float v = psum[(size_t)tid * 1024 + c] + psum[(size_t)tid * 1024 + 512 + c];
      v = wave_sum(v);
      if (lane == 0) sRed[w] = v;
    }
    {
      const u16* ut = (const u16*)(p.ws + OFF_UT);
      for (int i = tid; i < 4 * 512; i += 256) {
        const int b = i >> 9, q = i & 511;
        *(u32x4*)(sUu + b * UR + 512 + q * 8) = *(const u32x4*)(ut + ((size_t)(bh * 4 + b) * 512 + c) * 4096 + q * 8);
      }
      const u16* R0 = (const u16*)(p.ws + OFF_FR0) + (size_t)c * 8192; const u16* R1 = (const u16*)(p.ws + OFF_FR1) + (size_t)c * 8192;
      for (int i = tid; i < 1024; i += 256) { *(u32x4*)(sF0 + i * 8) = *(const u32x4*)(R0 + i * 8); *(u32x4*)(sF1 + i * 8) = *(const u32x4*)(R1 + i * 8); }
    }
    __syncthreads();
    const float inv = 1.f / (sRed[0] + sRed[1] + sRed[2] + sRed[3]);
    f32x16 acc[2][2];
#pragma unroll
    for (int i = 0; i < 2; ++i)
#pragma unroll
      for (int j = 0; j < 2; ++j) acc[i][j] = zero16();
    const int ci = elem_of(l31);
    const int par = (4095 - ci) & 1;
    const u16* fl = (par ? sF1 : sF0) + (4095 - ci + 8 * h - par);
    const int Tl = l31 >> 2, bl = l31 & 3;
    const u16* ub = sUu + bl * UR + 512 + 64 * Tl + 8 * h;
    const int wsc = __builtin_amdgcn_readfirstlane(w);
#define HY_FRAG(ptr_) ({ const unsigned* fp_ = (const unsigned*)(ptr_); u32x4 q_ = {fp_[0], fp_[1], fp_[2], fp_[3]}; __builtin_bit_cast(bf16x8, q_); })
#define HY_BODY(V0_, V1_)                                                                                      \
    {                                                                                                          \
      const u16* fd = fl - 64 * dl;                                                                            \
      const u16* u0 = ub + 64 * (16 * wsc - dl);                                                               \
        \
      bf16x8 a0[4], a1[4];                                                                                     \
      _Pragma("unroll") for (int kk = 0; kk < 4; ++kk) a0[kk] = HY_FRAG(fd + 16 * kk);                         \
      a1[0] = HY_FRAG(fd - 32); a1[1] = HY_FRAG(fd - 16); a1[2] = a0[0]; a1[3] = a0[1];                        \
      _Pragma("unroll") for (int kk = 0; kk < 4; ++kk) {                                                       \
        if (V0_) { const bf16x8 bb = *(const bf16x8*)(u0 + kk * 16);       acc[0][0] = MFMA32(a0[kk], bb, acc[0][0]); acc[1][0] = MFMA32(a1[kk], bb, acc[1][0]); } \
        if (V1_) { const bf16x8 bb = *(const bf16x8*)(u0 + 512 + kk * 16); acc[0][1] = MFMA32(a0[kk], bb, acc[0][1]); acc[1][1] = MFMA32(a1[kk], bb, acc[1][1]); } \
      }                                                                                                        \
    }
    {
      const int a0 = 16 * wsc - 63 < -63 ? -63 : 16 * wsc - 63, a1 = 16 * wsc - 56;
      for (int dl = a0; dl <= a1; ++dl) HY_BODY(true, false)
      const int b0 = 16 * wsc - 55 < -63 ? -63 : 16 * wsc - 55, b1 = 16 * wsc + 7;
      for (int dl = b0; dl <= b1; ++dl) HY_BODY(true, true)
      const int c0 = 16 * wsc + 8, c1 = 16 * wsc + 15 > 63 ? 63 : 16 * wsc + 15;
      for (int dl = c0; dl <= c1; ++dl) HY_BODY(false, true)
    }
#undef HY_BODY
#undef HY_FRAG
    int Tl_e = Tl, h_e = h;
    asm volatile("" : "+v"(Tl_e), "+v"(h_e));
    const float sk = skip[c];
    const int b = bh * 4 + bl;
    const u16* x0t = (const u16*)(p.ws + OFF_X0T) + ((size_t)b * 512 + c) * 4096;
    u16* ytp = (u16*)(p.ws + OFF_YT) + ((size_t)b * 512 + c) * 4096;
#pragma unroll
    for (int mi = 0; mi < 2; ++mi)
#pragma unroll
      for (int nf = 0; nf < 2; ++nf) {
        const int T = 16 * w + 8 * nf + Tl_e;
        asm volatile("" ::: "memory");
#pragma unroll
        for (int gp = 0; gp < 2; ++gp) {
          const int t = 64 * T + mi * 32 + 16 * h_e + 8 * gp;
          const u32x4 uu = *(const u32x4*)(sUu + bl * UR + 512 + t);
          const u32x4 xx = *(const u32x4*)(x0t + t);
          float y[8];
#pragma unroll
          for (int q = 0; q < 4; ++q) {
            y[2 * q] = bflo(xx[q]) * (acc[mi][nf][8 * gp + 2 * q] * inv + sk * bflo(uu[q]));
            y[2 * q + 1] = bfhi(xx[q]) * (acc[mi][nf][8 * gp + 2 * q + 1] * inv + sk * bfhi(uu[q]));
          }
          *(u32x4*)(ytp + t) = (u32x4){pack2(y[0], y[1]), pack2(y[2], y[3]), pack2(y[4], y[5]), pack2(y[6], y[7])};
        }
      }
    __syncthreads();
  }
  {
    const u16* FC = (const u16*)(p.ws + OFF_FCTX);
    const u16* utc = (const u16*)(p.ws + OFF_UTC); const u16* x0c = (const u16*)(p.ws + OFF_X0TC); u16* ytc = (u16*)(p.ws + OFF_YTC);
    const int total = 8 * 512 * 32;
    for (int i = bid_l() * 256 + tid; i < total; i += gridDim.x * 256) {
      const int tb = i & 31, c = (i >> 5) & 511, b = i >> 14;
      float nrm = 0.f;
#pragma unroll 4
      for (int q = 256; q < 272; ++q) nrm += psum[(size_t)q * 1024 + c] + psum[(size_t)q * 1024 + 512 + c];
      const u16* uu = utc + ((size_t)b * 512 + c) * 256;
      const u16* ff = FC + (size_t)c * 512;
      float y[8];
#pragma unroll
      for (int k = 0; k < 8; ++k) y[k] = 0.f;
      u32x4 hi = *(const u32x4*)(ff + (32 + tb) * 8);
      for (int sb = 0; sb < 32; ++sb) {
        const u32x4 lo = *(const u32x4*)(ff + (31 + tb - sb) * 8);
        const u32x4 uv = *(const u32x4*)(uu + sb * 8);
        float f[16], u8[8];
#pragma unroll
        for (int q = 0; q < 4; ++q) { f[2 * q] = bflo(lo[q]); f[2 * q + 1] = bfhi(lo[q]); f[8 + 2 * q] = bflo(hi[q]); f[9 + 2 * q] = bfhi(hi[q]); u8[2 * q] = bflo(uv[q]); u8[2 * q + 1] = bfhi(uv[q]); }
#pragma unroll
        for (int k = 0; k < 8; ++k)
#pragma unroll
          for (int j = 0; j < 8; ++j) y[k] += f[8 + k - j] * u8[j];
        hi = lo;
      }
      const float inv = 1.f / nrm, sk = skip[c];
      const u32x4 ut = *(const u32x4*)(uu + tb * 8);
      const u32x4 xv = *(const u32x4*)(x0c + ((size_t)b * 512 + c) * 256 + tb * 8);
      float o[8];
#pragma unroll
      for (int q = 0; q < 4; ++q) {
        o[2 * q] = bflo(xv[q]) * (y[2 * q] * inv + sk * bflo(ut[q]));
        o[2 * q + 1] = bfhi(xv[q]) * (y[2 * q + 1] * inv + sk * bfhi(ut[q]));
      }
      *(u32x4*)(ytc + ((size_t)b * 512 + c) * 256 + tb * 8) = (u32x4){pack2(o[0], o[1]), pack2(o[2], o[3]), pack2(o[4], o[5]), pack2(o[6], o[7])};
    }
  }
}

DI float hg_lb(const Params& p, int e, int dir, int j) {
  if (e == 0) return 0.f;
  const float a0 = p.in[12][(0 * 2 + dir) * 512 + j], a1 = p.in[12][(1 * 2 + dir) * 512 + j];
  return 1.f / (1.f + expf(a0 - a1));
}
DI size_t hg_row(int b, int dir, int c, int s) {
  if (c < 4) { const int pp = 64 * c + s; return (size_t)TL + (size_t)b * 256 + (dir ? 255 - pp : pp); }
  const int pp = 64 * (c - 4) + s; return (size_t)b * 4096 + (dir ? 4095 - pp : pp);
}

DI void ph_hg1(const Params& p, char* lds, int e) {
  u16* sKe = (u16*)lds;
  u16* sVt = sKe + 128 * 72;
  u16* sF = sVt + 128 * 72;
  u16* sV = sF + 64 * 136;
  const int tid = tid_l(), lane = tid & 63, w = tid >> 6, l31 = lane & 31, h = lane >> 5;
  const u16* z = (const u16*)(p.ws + OFF_ZA);
  u16* st = (u16*)(p.ws + OFF_ST); float* dbuf = (float*)(p.ws + OFF_DBUF);
  {
    u16* sT = (u16*)lds;
    u16* mix = (u16*)(p.ws + OFF_MIXE);
    const int nlat = 8 * 64 * 8, nall = nlat + 8 * 4 * 8;
    for (int it = bid_l(); it < nall; it += gridDim.x) {
      int b, tt, cc, L; size_t rowbase; const u16* src;
      if (it < nlat) { b = it >> 9; tt = (it >> 3) & 63; cc = it & 7; L = 4096; rowbase = (size_t)b * 4096; src = (const u16*)(p.ws + OFF_YT) + (size_t)b * 512 * 4096; }
      else { const int q = it - nlat; b = q >> 5; tt = (q >> 3) & 3; cc = q & 7; L = 256; rowbase = (size_t)TL + (size_t)b * 256; src = (const u16*)(p.ws + OFF_YTC) + (size_t)b * 512 * 256; }
      {
        const int cr = tid >> 2, tq = (tid & 3) * 16;
        const u32x4* sp = (const u32x4*)(src + (size_t)(cc * 64 + cr) * L + tt * 64 + tq);
        *(u32x4*)(sT + cr * 72 + tq) = sp[0];
        *(u32x4*)(sT + cr * 72 + tq + 8) = sp[1];
      }
      __syncthreads();
      {
        const int t = tid >> 2, cq = (tid & 3) * 16;
        unsigned o[8];
#pragma unroll
        for (int q = 0; q < 8; ++q) o[q] = (unsigned)sT[(cq + 2 * q) * 72 + t] | ((unsigned)sT[(cq + 2 * q + 1) * 72 + t] << 16);
        u32x4* dp = (u32x4*)(mix + (rowbase + tt * 64 + t) * D + 512 + cc * 64 + cq);
        dp[0] = (u32x4){o[0], o[1], o[2], o[3]};
        dp[1] = (u32x4){o[4], o[5], o[6], o[7]};
      }
      __syncthreads();
    }
  }
  for (int it = bid_l(); it < 64 * 68; it += gridDim.x) {
    const int seq = it / 68, c = it % 68;
    const int dir = seq & 1, hh = (seq >> 1) & 3, b = seq >> 3;
#pragma unroll
    for (int j = 0; j < 4; ++j) {
      const int i = tid + 256 * j, r = i >> 4, ch = i & 15;
      const u16* zr = z + hg_row(b, dir, c, r) * 2560 + hh * 128 + ch * 8;
      *(u32x4*)(sF + r * 136 + ch * 8) = *(const u32x4*)(zr + 512 + dir * 512);
      *(u32x4*)(sV + r * 136 + ch * 8) = *(const u32x4*)(zr + 1536);
    }
    __syncthreads();
    if (tid < 128) {
      const int d = tid;
      const int dc = d & 63, dslot = (d & 64) + ((dc >> 2) & 1) * 32 + (dc >> 4) * 8 + ((dc >> 3) & 1) * 4 + (dc & 3);
      const float lb = hg_lb(p, e, dir, hh * 128 + d);
      float P = 1.f;
      for (int s = 63; s >= 0; --s) {
        const float zf = bf2f(sF[s * 136 + d]);
        const float f = lb + (1.f - lb) * sigm(zf);
        sKe[dslot * 72 + s] = f2bf((1.f - f) * P);
        P *= f;
      }
      dbuf[(size_t)(seq * 68 + c) * 128 + d] = P;
    } else {
      const int ee = tid - 128;
      for (int s = 0; s < 64; ++s) sVt[ee * 72 + s] = sV[s * 136 + ee];
    }
    __syncthreads();
    f32x16 acc[4];
#pragma unroll
    for (int i = 0; i < 4; ++i) acc[i] = zero16();
#pragma unroll
    for (int kk = 0; kk < 4; ++kk) {
      const bf16x8 af = *(const bf16x8*)(sVt + (32 * w + l31) * 72 + kk * 16 + 8 * h);
#pragma unroll
      for (int nf = 0; nf < 4; ++nf) {
        const bf16x8 bb = *(const bf16x8*)(sKe + (nf * 32 + l31) * 72 + kk * 16 + 8 * h);
        acc[nf] = MFMA32(bb, af, acc[nf]);
      }
    }
    u16* dst = st + (size_t)(seq * 68 + c) * 16384 + (32 * w + l31) * 128;
#pragma unroll
    for (int grp = 0; grp < 2; ++grp)
#pragma unroll
      for (int g4 = 0; g4 < 4; ++g4)
        *(u32x4*)(dst + grp * 64 + 16 * g4 + 8 * h) = (u32x4){pack2(acc[2 * grp][4 * g4], acc[2 * grp][4 * g4 + 1]), pack2(acc[2 * grp][4 * g4 + 2], acc[2 * grp][4 * g4 + 3]),
                                                              pack2(acc[2 * grp + 1][4 * g4], acc[2 * grp + 1][4 * g4 + 1]), pack2(acc[2 * grp + 1][4 * g4 + 2], acc[2 * grp + 1][4 * g4 + 3])};
    __syncthreads();
  }
}

DI void ph_hg2(const Params& p) {
  u16* st = (u16*)(p.ws + OFF_ST); const float* dbuf = (const float*)(p.ws + OFF_DBUF);
  for (int i = bid_l() * 256 + tid_l(); i < 64 * 128 * 16; i += gridDim.x * 256) {
    const int dg = i & 15, ee = (i >> 4) & 127, seq = i >> 11;
    float S[8];
#pragma unroll
    for (int j = 0; j < 8; ++j) S[j] = 0.f;
    u32x4* base = (u32x4*)(st + ((size_t)(seq * 68) * 128 + ee) * 128 + dg * 8);
    const float* dp = dbuf + (size_t)(seq * 68) * 128 + dg * 8;
    u32x4 l0 = base[0], l1 = base[2048], l2 = base[2 * 2048];
    for (int c = 0; c < 68; ++c) {
      u32x4 l3 = l2;
      if (c + 3 < 68) l3 = base[(size_t)(c + 3) * 2048];
      const float4 d0 = *(const float4*)(dp + c * 128);
      const float4 d1 = *(const float4*)(dp + c * 128 + 4);
      base[(size_t)c * 2048] = (u32x4){pack2(S[0], S[1]), pack2(S[2], S[3]), pack2(S[4], S[5]), pack2(S[6], S[7])};
      const float dd[8] = {d0.x, d0.y, d0.z, d0.w, d1.x, d1.y, d1.z, d1.w};
#pragma unroll
      for (int j = 0; j < 8; ++j) {
        const unsigned wv = l0[j >> 1];
        const float L = __uint_as_float((j & 1) ? (wv & 0xffff0000u) : (wv << 16));
        S[j] = dd[j] * S[j] + L;
      }
      l0 = l1; l1 = l2; l2 = l3;
    }
  }
}

DI void ph_hg3(const Params& p, char* lds, int e) {
  u16* sQx = (u16*)lds;
  u16* sKx = sQx + 64 * 136;
  u16* sQt = sKx + 64 * 136;
  u16* sVt = sQt + 64 * 136;
  float* sRef = (float*)(sVt + 128 * 72);
  float* sRed = sRef + 128;
  const int tid = tid_l(), lane = tid & 63, w = tid >> 6, l31 = lane & 31, h = lane >> 5;
  const u16* z = (const u16*)(p.ws + OFF_ZA);
  const u16* st = (const u16*)(p.ws + OFF_ST);
  u16* mix = (u16*)(p.ws + OFF_MIXE);
  const float* gn = p.in[13] + e * 128;
  for (int it = bid_l(); it < 8 * 4 * 68; it += gridDim.x) {
    const int tc = it % 68, hh = (it / 68) & 3, b = it / (68 * 4);
    const bool isl = tc < 64;
    const size_t rowbase = isl ? (size_t)b * 4096 + tc * 64 : (size_t)TL + (size_t)b * 256 + (tc - 64) * 64;
    {
#pragma unroll
      for (int j = 0; j < 4; ++j) {
        const int i = tid + 256 * j, r = i >> 4, ch = i & 15;
        *(u32x4*)(sQx + r * 136 + ch * 8) = *(const u32x4*)(z + (rowbase + r) * 2560 + 1536 + hh * 128 + ch * 8);
      }
      __syncthreads();
      const int ee = tid & 127, sh = tid >> 7;
      const int vslot = (ee & 96) + slot_of(ee & 31);
      for (int s = sh * 32; s < sh * 32 + 32; ++s) sVt[vslot * 72 + s] = sQx[s * 136 + ee];
      __syncthreads();
    }
    f32x16 o[2]; o[0] = zero16(); o[1] = zero16();
    for (int dir = 0; dir < 2; ++dir) {
      const int cs = isl ? (dir ? 4 + (63 - tc) : 4 + tc) : (dir ? 3 - (tc - 64) : (tc - 64));
      const int seq = (b * 4 + hh) * 2 + dir;
      const int d = tid & 127, part = tid >> 7;
      const float lb = hg_lb(p, e, dir, hh * 128 + d);
      const int fcol = 512 + dir * 512 + hh * 128 + d;
#pragma unroll
      for (int j = 0; j < 4; ++j) {
        const int i = tid + 256 * j, r = i >> 4, ch = i & 15;
        const u16* zr = z + (rowbase + r) * 2560 + hh * 128 + ch * 8;
        *(u32x4*)(sQx + r * 136 + ch * 8) = *(const u32x4*)(zr);
        *(u32x4*)(sKx + r * 136 + ch * 8) = *(const u32x4*)(zr + 512 + dir * 512);
      }
      __syncthreads();
      if (part == 0) {
        float x = 0.f;
        for (int pp = 31; pp >= 0; --pp) {
          const int t = dir ? 63 - pp : pp;
          const float f = lb + (1.f - lb) * sigm(bf2f(sKx[t * 136 + d]));
          const float xc = fminf(x, 80.f);
          const float q = bf2f(sQx[t * 136 + d]);
          sQx[t * 136 + d] = f2bf(q * __expf(xc));
          sKx[t * 136 + d] = f2bf((1.f - f) * __expf(-xc));
          x -= __logf(f);
        }
        sRef[d] = __expf(-x);
      } else {
        float run = 0.f;
        for (int pp = 32; pp < 64; ++pp) {
          const int t = dir ? 63 - pp : pp;
          const float f = lb + (1.f - lb) * sigm(bf2f(sKx[t * 136 + d]));
          run += __logf(f);
          const float xc = fmaxf(run, -80.f);
          const float q = bf2f(sQx[t * 136 + d]);
          sQx[t * 136 + d] = f2bf(q * __expf(xc));
          sKx[t * 136 + d] = f2bf((1.f - f) * __expf(-xc));
        }
      }
      __syncthreads();
      f32x16 at[2][2];
#pragma unroll
      for (int i = 0; i < 2; ++i)
#pragma unroll
        for (int j = 0; j < 2; ++j) at[i][j] = zero16();
#pragma unroll
      for (int kk = 0; kk < 8; ++kk) {
        bf16x8 ka[2], qb[2];
#pragma unroll
        for (int mf = 0; mf < 2; ++mf) ka[mf] = *(const bf16x8*)(sKx + (mf * 32 + l31) * 136 + kk * 16 + 8 * h);
#pragma unroll
        for (int nf = 0; nf < 2; ++nf) qb[nf] = *(const bf16x8*)(sQx + (nf * 32 + l31) * 136 + kk * 16 + 8 * h);
#pragma unroll
        for (int mf = 0; mf < 2; ++mf)
#pragma unroll
          for (int nf = 0; nf < 2; ++nf) at[mf][nf] = MFMA32(ka[mf], qb[nf], at[mf][nf]);
      }
#pragma unroll
      for (int mf = 0; mf < 2; ++mf)
#pragma unroll
        for (int nf = 0; nf < 2; ++nf)
#pragma unroll
          for (int r = 0; r < 16; ++r) {
            const int s = mf * 32 + crow(r, h), t = nf * 32 + l31;
            const bool valid = dir ? (s >= t) : (s <= t);
            at[mf][nf][r] = valid ? at[mf][nf][r] : 0.f;
          }
#pragma unroll
      for (int mf = 0; mf < 2; ++mf)
#pragma unroll
        for (int ks = 0; ks < 2; ++ks) {
          const int kb = mf * 32 + ks * 16 + 4 * h;
          const s16x4 lo = *(const s16x4*)(sVt + (32 * w + l31) * 72 + kb);
          const s16x4 hi = *(const s16x4*)(sVt + (32 * w + l31) * 72 + kb + 8);
          const bf16x8 vf = __builtin_shufflevector(lo, hi, 0, 1, 2, 3, 4, 5, 6, 7);
#pragma unroll
          for (int nf = 0; nf < 2; ++nf) o[nf] = MFMA32(vf, pack8(at[mf][nf], ks), o[nf]);
        }
      const u16* sp = st + ((size_t)(seq * 68 + cs) * 128 + 32 * w + elem_of(l31)) * 128 + 8 * h;
#pragma unroll
      for (int kk = 0; kk < 8; ++kk) {
        const u32x4 sraw = *(const u32x4*)(sp + kk * 16);
        const float4 e0 = *(const float4*)(sRef + kk * 16 + 8 * h), e1 = *(const float4*)(sRef + kk * 16 + 8 * h + 4);
        const u32x4 ssc = {pack2(bflo(sraw[0]) * e0.x, bfhi(sraw[0]) * e0.y), pack2(bflo(sraw[1]) * e0.z, bfhi(sraw[1]) * e0.w),
                           pack2(bflo(sraw[2]) * e1.x, bfhi(sraw[2]) * e1.y), pack2(bflo(sraw[3]) * e1.z, bfhi(sraw[3]) * e1.w)};
        const bf16x8 sf = __builtin_bit_cast(bf16x8, ssc);
#pragma unroll
        for (int nf = 0; nf < 2; ++nf) {
          const bf16x8 qb = *(const bf16x8*)(sQx + (nf * 32 + l31) * 136 + kk * 16 + 8 * h);
          o[nf] = MFMA32(sf, qb, o[nf]);
        }
      }
      __syncthreads();
    }
#pragma unroll
    for (int nf = 0; nf < 2; ++nf) {
      float ss = 0.f;
#pragma unroll
      for (int r = 0; r < 16; ++r) ss += o[nf][r] * o[nf][r];
      ss += __shfl_xor(ss, 32);
      if (h == 0) sRed[w * 64 + nf * 32 + l31] = ss;
    }
    __syncthreads();
#pragma unroll
    for (int nf = 0; nf < 2; ++nf) {
      const int t = nf * 32 + l31;
      const float tot = sRed[t] + sRed[64 + t] + sRed[128 + t] + sRed[192 + t];
      const float rs = rsqrtf(tot * (1.f / 128.f) + 1e-6f);
      const size_t row = rowbase + t;
#pragma unroll
      for (int gp = 0; gp < 2; ++gp) {
        const int e0 = 32 * w + 16 * h + 8 * gp;
        const u32x4 gz = *(const u32x4*)(z + row * 2560 + 2048 + hh * 128 + e0);
        const float4 na = *(const float4*)(gn + e0), nb4 = *(const float4*)(gn + e0 + 4);
        const float nv[8] = {na.x, na.y, na.z, na.w, nb4.x, nb4.y, nb4.z, nb4.w};
        float v[8];
#pragma unroll
        for (int q = 0; q < 4; ++q) {
          v[2 * q] = o[nf][8 * gp + 2 * q] * rs * nv[2 * q] * siluf(bflo(gz[q]));
          v[2 * q + 1] = o[nf][8 * gp + 2 * q + 1] * rs * nv[2 * q + 1] * siluf(bfhi(gz[q]));
        }
        *(u32x4*)(mix + row * D + hh * 128 + e0) = (u32x4){pack2(v[0], v[1]), pack2(v[2], v[3]), pack2(v[4], v[5]), pack2(v[6], v[7])};
      }
    }
    __syncthreads();
  }
}

DI void vt_tile(u16* sT, const u16* src, int ld, const float* rscale, u16* dst) {
  const int tid = tid_l();
#pragma unroll
  for (int j = 0; j < 4; ++j) {
    const int i = tid + 256 * j, r = i >> 4, ch = i & 15;
    u32x4 v = *(const u32x4*)(src + (size_t)r * ld + ch * 8);
    if (rscale) {
      const float sc = rscale[r];
      v = (u32x4){pack2(bflo(v[0]) * sc, bfhi(v[0]) * sc), pack2(bflo(v[1]) * sc, bfhi(v[1]) * sc), pack2(bflo(v[2]) * sc, bfhi(v[2]) * sc), pack2(bflo(v[3]) * sc, bfhi(v[3]) * sc)};
    }
    *(u32x4*)(sT + r * 136 + ch * 8) = v;
  }
  __syncthreads();
  {
    const int ee = tid >> 1, ph = tid & 1;
    unsigned o[16];
#pragma unroll
    for (int q = 0; q < 16; ++q) o[q] = (unsigned)sT[(ph * 32 + 2 * q) * 136 + ee] | ((unsigned)sT[(ph * 32 + 2 * q + 1) * 136 + ee] << 16);
    u32x4* dp = (u32x4*)(dst + (size_t)ee * KPOS + ph * 32);
#pragma unroll
    for (int q = 0; q < 4; ++q) dp[q] = (u32x4){o[4 * q], o[4 * q + 1], o[4 * q + 2], o[4 * q + 3]};
  }
  __syncthreads();
}

DI void ph_odd_prepA(const Params& p, char* lds) {
  const int tid = tid_l(), lane = tid & 63;
  float* tS = (float*)lds;
  float* tC = tS + 1024;
  u16* sT = (u16*)(tC + 1024);
  const u16* z = (const u16*)(p.ws + OFF_ZO);
  u16* Qa = (u16*)(p.ws + OFF_QA); u16* Qac = (u16*)(p.ws + OFF_QAC); u16* Ka = (u16*)(p.ws + OFF_KA);
  float* rsq = (float*)(p.ws + OFF_RSQ); float* rskv = (float*)(p.ws + OFF_RSKV);
  {
    const int wid = bid_l() * 4 + (tid >> 6), nw = gridDim.x * 4;
    for (int row = wid; row < TA; row += nw) {
      const u16* zr = z + (size_t)row * 1952;
      const uint2 v = *(const uint2*)(zr + 1536 + lane * 4);
      const unsigned v2 = *(const unsigned*)(zr + 1792 + lane * 2);
      const float a0 = bflo(v.x), a1 = bfhi(v.x), a2 = bflo(v.y), a3 = bfhi(v.y), c0 = bflo(v2), c1 = bfhi(v2);
      const float sq = wave_sum(a0 * a0 + a1 * a1 + a2 * a2 + a3 * a3);
      const float sk = wave_sum(c0 * c0 + c1 * c1);
      if (lane == 0) { rsq[row] = rsqrtf(sq * (1.f / 256.f) + 1e-6f); rskv[row] = rsqrtf(sk * (1.f / 128.f) + 1e-6f); }
    }
  }
  {
    u16* Vta = (u16*)(p.ws + OFF_VTA);
    for (int it = bid_l(); it < 8 * 4 * 68; it += gridDim.x) {
      const int pt = it % 68, bh = it / 68, b = bh >> 2, hh = bh & 3;
      const int pos0 = pt * 64;
      const size_t rb = pos0 < 4096 ? (size_t)b * 4096 + pos0 : (size_t)TL + (size_t)b * 256 + (pos0 - 4096);
      vt_tile(sT, z + rb * 1952 + 1024 + hh * 128, 1952, nullptr, Vta + (size_t)bh * 128 * KPOS + pos0);
    }
  }
  {
    GemmDesc g1{z + 1536, 1952, (const u16*)(p.ws + W2_DELTA + OFF_WUQ), 256, TA, 384, 256};
    gemm_phase(lds, g1, EpiStore{(u16*)(p.ws + OFF_UPQ), 384, 384});
    GemmDesc g2{z + 1792, 1952, (const u16*)(p.ws + W2_DELTA + OFF_WUKV), 128, TA, 768, 128};
    gemm_phase(lds, g2, EpiStore{(u16*)(p.ws + OFF_UPKV), 768, 768});
  }
}

DI void ph_odd_prepB(const Params& p, char* lds) {
  const int tid = tid_l();
  float* tS = (float*)lds;
  float* tC = tS + 512;
  u16* sT = (u16*)(tC + 512);
  const u16* z = (const u16*)(p.ws + OFF_ZO);
  const u16* upq = (const u16*)(p.ws + OFF_UPQ); const u16* upkv = (const u16*)(p.ws + OFF_UPKV);
  const float* rsq = (const float*)(p.ws + OFF_RSQ); const float* rskv = (const float*)(p.ws + OFF_RSKV);
  u16* Qm = (u16*)(p.ws + OFF_QM); u16* Qmc = (u16*)(p.ws + OFF_QMC); u16* Km = (u16*)(p.ws + OFF_KM); u16* Vtm = (u16*)(p.ws + OFF_VTM);
  for (int i = tid; i < 512; i += 256) {
    const float inv = exp2f(-(float)(i & 7) * (13.287712379549449f / 8.f));
    const float a = (float)(i >> 3) * inv;
    tS[i] = sinf(a); tC[i] = cosf(a);
  }
  __syncthreads();
  for (int u = bid_l() * 256 + tid; u < TA * 96; u += gridDim.x * 256) {
    const int row = u / 96, chunk = u - row * 96;
    const bool isk = chunk >= 48;
    const int c2 = isk ? chunk - 48 : chunk;
    const int hm = c2 / 12, cc = c2 - hm * 12;
    const bool isl = row < TL;
    const int b = isl ? row >> 12 : (row - TL) >> 8;
    const int t = isl ? row & 4095 : (row - TL) & 255;
    const float rq = rsq[row], rk = rskv[row];
    u32x4 o;
    if (cc < 8) {
      const u32x4 v = isk ? *(const u32x4*)(upkv + (size_t)row * 768 + hm * 192 + cc * 8) : *(const u32x4*)(upq + (size_t)row * 384 + hm * 96 + cc * 8);
      const float sc = isk ? rk : rq;
#pragma unroll
      for (int q = 0; q < 4; ++q) o[q] = pack2(bflo(v[q]) * sc, bfhi(v[q]) * sc);
    } else {
      const int rc = cc - 8, grp = rc >> 1, second = rc & 1;
      u32x4 x1, x2; float sc;
      if (isk) { const u16* kr = z + (size_t)row * 1952 + 1920 + grp * 16; x1 = *(const u32x4*)(kr); x2 = *(const u32x4*)(kr + 8); sc = 1.f; }
      else { const u16* qr = upq + (size_t)row * 384 + hm * 96 + 64 + grp * 16; x1 = *(const u32x4*)(qr); x2 = *(const u32x4*)(qr + 8); sc = rq; }
      if (isl) {
        const int pos = grp ? (t & 63) : (t >> 6);
        const float* sp = tS + pos * 8; const float* cp = tC + pos * 8;
#pragma unroll
        for (int q = 0; q < 4; ++q) {
          const float a0 = bflo(x1[q]) * sc, a1 = bfhi(x1[q]) * sc, b0 = bflo(x2[q]) * sc, b1 = bfhi(x2[q]) * sc;
          const float s0 = sp[2 * q], s1 = sp[2 * q + 1], c0 = cp[2 * q], c1 = cp[2 * q + 1];
          o[q] = second ? pack2(b0 * c0 + a0 * s0, b1 * c1 + a1 * s1) : pack2(a0 * c0 - b0 * s0, a1 * c1 - b1 * s1);
        }
      } else {
        const u32x4 xs = second ? x2 : x1;
#pragma unroll
        for (int q = 0; q < 4; ++q) o[q] = pack2(bflo(xs[q]) * sc, bfhi(xs[q]) * sc);
      }
    }
    u16* dst;
    if (isk) dst = Km + ((size_t)(b * 4 + hm) * KPOS + (isl ? t : 4096 + t)) * 96 + cc * 8;
    else dst = isl ? Qm + ((size_t)(b * 4 + hm) * 4096 + t) * 96 + cc * 8 : Qmc + ((size_t)(b * 4 + hm) * 256 + t) * 96 + cc * 8;
    *(u32x4*)dst = o;
  }
  for (int it = bid_l(); it < 8 * 4 * 68; it += gridDim.x) {
    const int pt = it % 68, bh = it / 68, b = bh >> 2, hm = bh & 3;
    const int pos0 = pt * 64;
    const size_t rb = pos0 < 4096 ? (size_t)b * 4096 + pos0 : (size_t)TL + (size_t)b * 256 + (pos0 - 4096);
    vt_tile(sT, upkv + rb * 768 + hm * 192 + 64, 768, rskv + rb, Vtm + (size_t)bh * 128 * KPOS + pos0);
  }
}

template <int DQ>
DI void attn_item(char* lds, const u16* __restrict__ Qb, const u16* __restrict__ Kb, const u16* __restrict__ Vtb,
                  int q0, int kt_lo, int kt_hi, float sc, u16* __restrict__ Ob, int ldo) {
  constexpr int KS = DQ + 8, KCH = DQ / 8, KPT = 64 * KCH / 256, NKK = DQ / 16;
  u16* sK = (u16*)lds;
  u16* sV = sK + 64 * KS;
  const int tid = tid_l(), lane = tid & 63, w = tid >> 6, l31 = lane & 31, h = lane >> 5;
  bf16x8 qf[NKK];
  {
    const u16* qrow = Qb + (size_t)(q0 + w * 32 + l31) * DQ + h * 8;
#pragma unroll
    for (int kk = 0; kk < NKK; ++kk) qf[kk] = *(const bf16x8*)(qrow + kk * 16);
  }
  u32x4 rk[KPT], rv[4];
#define ATT_LOAD(kt_)                                                                                   \
  {                                                                                                     \
    _Pragma("unroll") for (int j = 0; j < KPT; ++j) {                                                   \
      const int idx = tid + 256 * j; const int r = idx / KCH, cch = idx % KCH;                          \
      rk[j] = *(const u32x4*)(Kb + (size_t)((kt_) * 64 + r) * DQ + cch * 8);                            \
    }                                                                                                   \
    _Pragma("unroll") for (int j = 0; j < 4; ++j) {                                                     \
      const int idx = tid + 256 * j; const int ee = idx >> 3, cch = idx & 7;                            \
      rv[j] = *(const u32x4*)(Vtb + (size_t)ee * KPOS + (kt_) * 64 + cch * 8);                          \
    }                                                                                                   \
  }
  f32x16 o[4];
#pragma unroll
  for (int i = 0; i < 4; ++i) o[i] = zero16();
  float m_run = -INFINITY, l_run = 0.f;
  constexpr int STG = 64 * KS + 128 * 72;
#define ATT_STORE(st_)                                                                                  \
  {                                                                                                     \
    u16* dK = (u16*)lds + (st_) * STG; u16* dV = dK + 64 * KS;                                          \
    _Pragma("unroll") for (int j = 0; j < KPT; ++j) { const int idx = tid + 256 * j; const int r = idx / KCH, cch = idx % KCH; *(u32x4*)(dK + r * KS + cch * 8) = rk[j]; } \
    _Pragma("unroll") for (int j = 0; j < 4; ++j) { const int idx = tid + 256 * j; const int ee = idx >> 3, cch = idx & 7; u16* vr_ = dV + ((ee & 96) + slot_of(ee & 31)) * 72 + (cch >> 1) * 16 + (cch & 1) * 4; *(u32x2_t*)(vr_) = (u32x2_t){rv[j][0], rv[j][1]}; *(u32x2_t*)(vr_ + 8) = (u32x2_t){rv[j][2], rv[j][3]}; } \
  }
  ATT_LOAD(kt_lo)
  ATT_STORE(0)
  if (kt_lo + 1 < kt_hi) ATT_LOAD(kt_lo + 1)
  for (int kt = kt_lo; kt < kt_hi; ++kt) {
    __syncthreads();
    const int cur = (kt - kt_lo) & 1;
    sK = (u16*)lds + cur * STG; sV = sK + 64 * KS;
    if (kt + 1 < kt_hi) {
      ATT_STORE(cur ^ 1)
      if (kt + 2 < kt_hi) ATT_LOAD(kt + 2)
    }
    f32x16 s0 = zero16(), s1 = zero16();
#pragma unroll
    for (int kk = 0; kk < NKK; ++kk) {
      const bf16x8 k0 = *(const bf16x8*)(sK + l31 * KS + kk * 16 + h * 8);
      const bf16x8 k1 = *(const bf16x8*)(sK + (32 + l31) * KS + kk * 16 + h * 8);
      s0 = MFMA32(k0, qf[kk], s0);
      s1 = MFMA32(k1, qf[kk], s1);
    }
    float mx = fmaxf(fmaxf(s0[0], s0[1]), s0[2]);
#pragma unroll
    for (int r = 3; r < 15; r += 2) mx = fmaxf(fmaxf(mx, s0[r]), s0[r + 1]);
    mx = fmaxf(fmaxf(mx, s0[15]), s1[0]);
#pragma unroll
    for (int r = 1; r < 15; r += 2) mx = fmaxf(fmaxf(mx, s1[r]), s1[r + 1]);
    mx = fmaxf(mx, s1[15]);
    mx = fmaxf(mx, __shfl_xor(mx, 32));
    const float m_new = fmaxf(m_run, mx * sc);
    if (__builtin_amdgcn_ballot_w64(m_new > m_run) != 0ull) {
      const float alpha = __builtin_amdgcn_exp2f(m_run - m_new);
      m_run = m_new;
      l_run *= alpha;
#pragma unroll
      for (int ef = 0; ef < 4; ++ef) o[ef] = o[ef] * alpha;
    }
    s0 = s0 * sc - m_new;
    s1 = s1 * sc - m_new;
#pragma unroll
    for (int r = 0; r < 16; ++r) { s0[r] = __builtin_amdgcn_exp2f(s0[r]); s1[r] = __builtin_amdgcn_exp2f(s1[r]); }
    const f32x16 sp = s0 + s1;
    const float ps = ((sp[0] + sp[1]) + (sp[2] + sp[3])) + ((sp[4] + sp[5]) + (sp[6] + sp[7])) + ((sp[8] + sp[9]) + (sp[10] + sp[11])) + ((sp[12] + sp[13]) + (sp[14] + sp[15]));
    l_run += ps;
#pragma unroll
    for (int mf = 0; mf < 2; ++mf)
#pragma unroll
      for (int ks = 0; ks < 2; ++ks) {
        const bf16x8 pb = mf ? pack8(s1, ks) : pack8(s0, ks);
        const int kb = (mf * 2 + ks) * 16 + 8 * h;
#pragma unroll
        for (int ef = 0; ef < 4; ++ef) {
          const bf16x8 vf = *(const bf16x8*)(sV + (ef * 32 + l31) * 72 + kb);
          o[ef] = MFMA32(vf, pb, o[ef]);
        }
      }
  }
#undef ATT_LOAD
#undef ATT_STORE
  const float lt = l_run + __shfl_xor(l_run, 32);
  const float inv = 1.f / lt;
  u16* orow = Ob + (size_t)(q0 + w * 32 + l31) * ldo;
#pragma unroll
  for (int ef = 0; ef < 4; ++ef)
#pragma unroll
    for (int gp = 0; gp < 2; ++gp) {
      const int e0 = ef * 32 + 16 * h + 8 * gp;
      *(u32x4*)(orow + e0) = (u32x4){pack2(o[ef][8 * gp] * inv, o[ef][8 * gp + 1] * inv), pack2(o[ef][8 * gp + 2] * inv, o[ef][8 * gp + 3] * inv),
                                     pack2(o[ef][8 * gp + 4] * inv, o[ef][8 * gp + 5] * inv), pack2(o[ef][8 * gp + 6] * inv, o[ef][8 * gp + 7] * inv)};
    }
  __syncthreads();
}

DI void ph_attn(const Params& p, char* lds, bool need_ctx) {
  char* ws = p.ws;
  u16* oa = (u16*)(ws + OFF_OA); u16* mix = (u16*)(ws + OFF_MIXO);
  const int n_lat = 8 * 12 * 32, n_all = n_lat + (need_ctx ? 8 * 12 * 2 : 0);
  const float sa = 0.125f * 1.4426950408889634f;
  const float sm = 0.10206207261596575f * 1.4426950408889634f;
  for (int it = bid_l(); it < n_all; it += gridDim.x) {
    int b, head, qb; bool isl;
    if (it < n_lat) {
      isl = true;
      int pr;
      if (gridDim.x == 512) {
        const int bid = it & 511, rnd = it >> 9, xcd = bid & 7, slot = bid >> 3;
        pr = rnd * 16 + xcd * 2 + (slot >> 5); qb = slot & 31;
      } else { qb = it & 31; pr = it >> 5; }
      head = 11 - (pr % 12); b = pr / 12;
    }
    else { isl = false; const int q = it - n_lat; qb = q & 1; const int r = q >> 1; head = 11 - (r % 12); b = r / 12; }
    const int kt_lo = isl ? 0 : 64, kt_hi = 68;
    const size_t orow0 = isl ? (size_t)b * 4096 : (size_t)TL + (size_t)b * 256;
    if (head >= 8) {
      const int hm = head - 8;
      const u16* Q = isl ? (const u16*)(ws + OFF_QM) + (size_t)(b * 4 + hm) * 4096 * 96 : (const u16*)(ws + OFF_QMC) + (size_t)(b * 4 + hm) * 256 * 96;
      const u16* K = (const u16*)(ws + OFF_KM) + (size_t)(b * 4 + hm) * KPOS * 96;
      const u16* V = (const u16*)(ws + OFF_VTM) + (size_t)(b * 4 + hm) * 128 * KPOS;
      attn_item<96>(lds, Q, K, V, qb * 128, kt_lo, kt_hi, sm, mix + orow0 * D + 512 + hm * 128, D);
    } else {
      const u16* Q = isl ? (const u16*)(ws + OFF_QA) + (size_t)(b * 8 + head) * 4096 * 64 : (const u16*)(ws + OFF_QAC) + (size_t)(b * 8 + head) * 256 * 64;
      const u16* K = (const u16*)(ws + OFF_KA) + (size_t)(b * 8 + head) * KPOS * 64;
      const u16* V = (const u16*)(ws + OFF_VTA) + (size_t)(b * 4 + (head & 3)) * 128 * KPOS;
      attn_item<64>(lds, Q, K, V, qb * 128, kt_lo, kt_hi, sa, oa + orow0 * D + head * 128, D);
    }
  }
}

DI void ph_da_readout(const Params& p, int layer, int rows) {
  const int o = layer >> 1;
  const int lane = tid_l() & 63;
  const int wid = bid_l() * 4 + (tid_l() >> 6), nw = gridDim.x * 4;
  const float* lp = p.in[26] + o * 256;
  const float lam_init = 0.8f - 0.6f * expf(-0.3f * (float)layer);
  const float d1 = wave_sum(lp[lane] * lp[64 + lane]), d2 = wave_sum(lp[128 + lane] * lp[192 + lane]);
  const float lam = expf(d1) - expf(d2) + lam_init;
  const int hh = lane >> 4, e0 = (lane & 15) * 8;
  const float* sg = p.in[27] + o * 128 + e0;
  const float4 ga = *(const float4*)(sg), gb = *(const float4*)(sg + 4);
  const float gv[8] = {ga.x, ga.y, ga.z, ga.w, gb.x, gb.y, gb.z, gb.w};
  const u16* oa = (const u16*)(p.ws + OFF_OA); u16* mix = (u16*)(p.ws + OFF_MIXO);
  const float post = 1.f - lam_init;
  for (int row = wid; row < rows; row += nw) {
    const u32x4 a = *(const u32x4*)(oa + (size_t)row * D + hh * 128 + e0);
    const u32x4 bq = *(const u32x4*)(oa + (size_t)row * D + (4 + hh) * 128 + e0);
    float x[8]; float ss = 0.f;
#pragma unroll
    for (int q = 0; q < 4; ++q) {
      x[2 * q] = bflo(a[q]) - lam * bflo(bq[q]);
      x[2 * q + 1] = bfhi(a[q]) - lam * bfhi(bq[q]);
      ss += x[2 * q] * x[2 * q] + x[2 * q + 1] * x[2 * q + 1];
    }
    ss += __shfl_xor(ss, 1); ss += __shfl_xor(ss, 2); ss += __shfl_xor(ss, 4); ss += __shfl_xor(ss, 8);
    const float rs = rsqrtf(ss * (1.f / 128.f) + 1e-6f) * post;
    *(u32x4*)(mix + (size_t)row * D + hh * 128 + e0) = (u32x4){pack2(x[0] * rs * gv[0], x[1] * rs * gv[1]), pack2(x[2] * rs * gv[2], x[3] * rs * gv[3]),
                                                              pack2(x[4] * rs * gv[4], x[5] * rs * gv[5]), pack2(x[6] * rs * gv[6], x[7] * rs * gv[7])};
  }
}

DI void ph_final(const Params& p) {
  const int lane = tid_l() & 63;
  const int wid = bid_l() * 4 + (tid_l() >> 6), nw = gridDim.x * 4;
  const float* g = p.in[32];
  float4 gq[4];
#pragma unroll
  for (int j = 0; j < 4; ++j) gq[j] = *(const float4*)(g + lane * 4 + 256 * j);
  for (int row = wid; row < TL; row += nw) {
    float* src = p.out + (size_t)row * D;
    float4 v[4]; float ss = 0.f;
#pragma unroll
    for (int j = 0; j < 4; ++j) { v[j] = *(const float4*)(src + lane * 4 + 256 * j); ss += v[j].x * v[j].x + v[j].y * v[j].y + v[j].z * v[j].z + v[j].w * v[j].w; }
    ss = wave_sum(ss);
    const float rs = rsqrtf(ss * (1.f / 1024.f) + 1e-6f);
#pragma unroll
    for (int j = 0; j < 4; ++j) {
      const float4 gg = gq[j];
      *(float4*)(src + lane * 4 + 256 * j) = make_float4(v[j].x * rs * gg.x, v[j].y * rs * gg.y, v[j].z * rs * gg.z, v[j].w * rs * gg.w);
    }
  }
}

DI void run_phase(const Params& p, char* lds, int ph) {
  char* ws = p.ws;
  if (ph == 0) { if (en(0)) {
      if (bid_l() == 0) { float* rt = (float*)(ws + OFF_ROPE);
        for (int i = tid_l(); i < 1024; i += 256) { const float inv = exp2f(-(float)(i & 15) * (13.287712379549449f / 16.f)); const float a = (float)(i >> 4) * inv; rt[i] = sinf(a); rt[1024 + i] = cosf(a); } }
      ph_ada(p, lds); ph_convert(p, lds, 0, 0); } return; }
  if (ph == NPHASES - 1) { if (en(17)) ph_final(p); return; }
  int layer, sub;
  { const int q = ph - 1;
    if (q < 11) { layer = 0; sub = q; } else if (q < 21) { layer = 1; sub = q - 11; } else if (q < 32) { layer = 2; sub = q - 21; } else { layer = 3; sub = q - 32; }
    if ((layer & 1) && sub >= 6) sub += 1; }
  const bool even = (layer & 1) == 0;
  const int e = layer >> 1;
  const bool need_ctx = layer < 3;
  const int rows = need_ctx ? TA : TL;
  const float* modl = (const float*)(ws + OFF_MOD) + (size_t)layer * 9 * 6144;
  const float* res_lat = layer == 0 ? p.in[0] : p.out;
  const float* res_ctx = layer == 0 ? p.in[2] : (const float*)(ws + OFF_HCTX);
  switch (sub) {
    case 0: if (en(1)) { ph_layer_start(p, lds, layer); if (dbl(1)) ph_layer_start(p, lds, layer); } break;
    case 1:
      if (even) { if (en(2)) { GemmDesc g{(const u16*)(ws + OFF_HN), 1024, (const u16*)(ws + wofs(layer) + OFF_WIN), 1024, TA, 4096, 1024};
        gemm_phase_t<4, 32>(lds, g, EpiSplitEven{(u16*)(ws + OFF_ZA), (u16*)(ws + OFF_ZHY)}); } }
      else { if (en(3)) { GemmDesc g{(const u16*)(ws + OFF_HN), 1024, (const u16*)(ws + wofs(layer) + OFF_WIN), 1024, TA, 2048, 1024};
        gemm_phase(lds, g, EpiOddIn{(u16*)(ws + OFF_ZO), (u16*)(ws + OFF_QA), (u16*)(ws + OFF_QAC), (u16*)(ws + OFF_KA), (const float*)(ws + OFF_ROPE)}); } }
      break;
    case 2: if (even) { if (en(4)) { ph_hy_short(p, lds, e); if (dbl(4)) ph_hy_short(p, lds, e); } } else { if (en(5)) { ph_odd_prepA(p, lds); if (dbl(5)) ph_odd_prepA(p, lds); } } break;
    case 3: if (even) { if (en(6)) { ph_hy_long(p, lds, e); if (dbl(6)) ph_hy_long(p, lds, e); } } else { if (en(7)) { ph_odd_prepB(p, lds); if (dbl(7)) ph_odd_prepB(p, lds); } } break;
    case 4: if (even) { if (en(8)) { ph_hg1(p, lds, e); if (dbl(8)) ph_hg1(p, lds, e); } } else { if (en(9)) { ph_attn(p, lds, need_ctx); if (dbl(9)) ph_attn(p, lds, need_ctx); } } break;
    case 5: if (even) { if (en(10)) ph_hg2(p); } else { if (en(11)) { ph_da_readout(p, layer, rows); if (dbl(11)) ph_da_readout(p, layer, rows); } } break;
    case 6: if (even) { if (en(12)) { ph_hg3(p, lds, e); if (dbl(12)) ph_hg3(p, lds, e); } } break;
    case 7: if (en(13)) {
      const u16* Amix = (const u16*)(ws + (even ? OFF_MIXE : OFF_MIXO));
      const EpiResid ep{res_lat, res_ctx, p.out, (float*)(ws + OFF_HCTX), modl + 2 * 1024};
      GemmDesc g{Amix, 1024, (const u16*)(ws + wofs(layer) + OFF_WOUT), 1024, TL, 1024, 1024};
      gemm_phase(lds, g, ep);
      if (need_ctx) {
        GemmDesc gc{Amix + (size_t)TL * 1024, 1024, (const u16*)(ws + wofs(layer) + OFF_WOUT), 1024, TC, 1024, 1024, TL};
        gemm_phase_t<1, 64>(lds, gc, ep);
      }
    } break;
    case 8: if (en(14)) ph_norm(p.out, (const float*)(ws + OFF_HCTX), rows, p.in[7] + layer * 1024, modl, 3, 4, (u16*)(ws + OFF_HN)); break;
    case 9: if (en(15)) {
      GemmDesc g{(const u16*)(ws + OFF_HN), 1024, (const u16*)(ws + wofs(layer) + OFF_WGU), 1024, rows, 5632, 1024};
      gemm_phase_t<4, 32>(lds, g, EpiSwiglu{(u16*)(ws + OFF_ACT)});
    } break;
    case 10: if (en(16)) {
      const EpiResid ep{p.out, (const float*)(ws + OFF_HCTX), p.out, (float*)(ws + OFF_HCTX), modl + 5 * 1024};
      GemmDesc g{(const u16*)(ws + OFF_ACT), FF, (const u16*)(ws + wofs(layer) + OFF_WDN), FF, TL, 1024, FF};
      gemm_phase(lds, g, ep);
      if (need_ctx) {
        GemmDesc gc{(const u16*)(ws + OFF_ACT) + (size_t)TL * FF, FF, (const u16*)(ws + wofs(layer) + OFF_WDN), FF, TC, 1024, FF, TL};
        gemm_phase_t<1, 64>(lds, gc, ep);
      }
      if (layer < 3) {
        const int nt = ((TC / 64) * 8) % (int)gridDim.x;
        ph_convert(p, lds, layer + 1, nt);
      }
    } break;
  }
}

__global__ void __launch_bounds__(256, 2) mega(Params p) {
  __shared__ __attribute__((aligned(16))) char lds[LDS_BYTES];
  __shared__ uint4 xb_words;
  cg::grid_group grid = cg::this_grid();
  if (threadIdx.x == 0) xb_words = make_uint4(0u, 0u, 0u, 0u);
  __syncthreads();
  const XcdBarrier xb = xcd_barrier_post((unsigned*)(p.ws + OFF_BAR), (volatile LAS unsigned*)&xb_words);
  const int ph_lo = p.ph_lo, ph_hi = p.ph_hi;
  for (int ph = ph_lo; ph < ph_hi; ++ph) {
    const __attribute__((address_space(4))) Params* pp = (const __attribute__((address_space(4))) Params*)__builtin_amdgcn_kernarg_segment_ptr();
    asm volatile("" : "+s"(pp));
    Params q;
    q.out = pp->out; q.ws = pp->ws; q.ph_lo = ph_lo; q.ph_hi = ph_hi;
#pragma unroll
    for (int i = 0; i < 33; ++i) q.in[i] = pp->in[i];
    run_phase(q, lds, ph);
    if (ph + 1 < ph_hi) {
      if (ph_lo == 0x7fffffff) grid.sync();
      xcd_barrier(xb);
    }
  }
}

extern "C" void kernel_launch(void* const* d_in, const int* in_sizes, int n_in, void* d_out, int out_size, void* d_ws, size_t ws_size, hipStream_t stream) {
  static int grid_blocks = 0;
  if (!grid_blocks) {
    int dev = 0, cus = 0, per_cu = 0;
    (void)hipGetDevice(&dev);
    (void)hipDeviceGetAttribute(&cus, hipDeviceAttributeMultiprocessorCount, dev);
    (void)hipOccupancyMaxActiveBlocksPerMultiprocessor(&per_cu, mega, 256, 0);
    if (per_cu < 1) per_cu = 1;
    if (per_cu > 2) per_cu = 2;
    grid_blocks = cus * per_cu;
    if (n_in != 33 || ws_size < WS_END) { fprintf(stderr, "kernel_launch: bad inputs n_in %d ws %zu need %zu\n", n_in, ws_size, (size_t)WS_END); }
  }
  (void)hipMemsetAsync((char*)d_ws + OFF_BAR, 0, 16384, stream);
  Params p{};
  for (int i = 0; i < 33; ++i) p.in[i] = (const float*)d_in[i];
  p.out = (float*)d_out; p.ws = (char*)d_ws;
#if MK_PER_PHASE
  for (int ph = 0; ph < NPHASES; ++ph) {
    p.ph_lo = ph; p.ph_hi = ph + 1;
    hipLaunchKernelGGL(mega, dim3(grid_blocks), dim3(256), 0, stream, p);
  }
#else
  p.ph_lo = 0; p.ph_hi = NPHASES;
  void* args[] = {&p};
  hipError_t e = hipLaunchCooperativeKernel((void*)mega, dim3(grid_blocks), dim3(256), args, 0, stream);
  if (e != hipSuccess) fprintf(stderr, "cooperative launch failed: %s (grid %d)\n", hipGetErrorString(e), grid_blocks);
#endif
}
```
